# Optimizing an MI355X kernel written in HIP

```python
import jax, jax.numpy as jnp
from jax import lax
import numpy as np

D_MODEL = 2048
BATCH = 8
SEQ = 4096
DEPTH = 4

N_MIXERS = 3
N_MLSTM_LAYERS = (DEPTH + 2) // 3
N_ATTN_LAYERS = (DEPTH + 1) // 3
N_RWKV_LAYERS = DEPTH // 3

D_FF = 5632
NORM_EPS = 1e-6

MLSTM_HEADS = 8
MLSTM_DQK = D_MODEL // (2 * MLSTM_HEADS)
MLSTM_DV = D_MODEL // MLSTM_HEADS
MLSTM_CHUNK = 64
MLSTM_SPLITS = (MLSTM_HEADS * MLSTM_DQK, 2 * MLSTM_HEADS * MLSTM_DQK,
                2 * MLSTM_HEADS * MLSTM_DQK + MLSTM_HEADS * MLSTM_DV,
                2 * MLSTM_HEADS * MLSTM_DQK + 2 * MLSTM_HEADS * MLSTM_DV,
                2 * MLSTM_HEADS * MLSTM_DQK + 2 * MLSTM_HEADS * MLSTM_DV + MLSTM_HEADS)
MLSTM_IN_COLS = 2 * MLSTM_HEADS * MLSTM_DQK + 2 * MLSTM_HEADS * MLSTM_DV + 2 * MLSTM_HEADS

ATTN_HEAD_DIM = 64
ATTN_Q_HEADS = D_MODEL // ATTN_HEAD_DIM
ATTN_GROUP = 8
ATTN_KV_HEADS = ATTN_Q_HEADS // ATTN_GROUP
ATTN_WINDOW = 128
ATTN_BLOCK = 128
ROPE_DIM = ATTN_HEAD_DIM // 4
ROPE_THETA = 500000.0
ATTN_QKV_COLS = (ATTN_Q_HEADS + 2 * ATTN_KV_HEADS) * ATTN_HEAD_DIM

RWKV_HEAD = 64
RWKV_HEADS = D_MODEL // RWKV_HEAD
RWKV_DECAY_LORA = 96
RWKV_AAA_LORA = 96
RWKV_GATE_LORA = 256
RWKV_LN_EPS = 64e-5

kernel_name = "hybrid_mlstm_swa_rwkv7_macaron"


def rmsnorm(x, gain):
    xf = x.astype(jnp.float32)
    y = xf * lax.rsqrt(jnp.mean(xf * xf, axis=-1, keepdims=True) + NORM_EPS)
    return (y * gain.astype(jnp.float32)).astype(x.dtype)


def swiglu(h, w_gu, w_down):
    gate, up = jnp.split(h @ w_gu, 2, axis=-1)
    return (jax.nn.silu(gate) * up) @ w_down


def rope_partial(x, cos, sin):
    half = ROPE_DIM // 2
    xf = x[..., :ROPE_DIM].astype(jnp.float32)
    x1, x2 = xf[..., :half], xf[..., half:]
    rot = jnp.concatenate([x1 * cos - x2 * sin, x2 * cos + x1 * sin], axis=-1).astype(x.dtype)
    return jnp.concatenate([rot, x[..., ROPE_DIM:]], axis=-1)


def mlstm_chunk_step(carry, xs):
    c_state, n_state, m_state = carry
    q, k, v, log_i, log_f = xs
    L = q.shape[2]
    causal = jnp.tril(jnp.ones((L, L), dtype=bool))
    b = jnp.cumsum(log_f, axis=-1)
    g = b[..., -1]
    log_d = jnp.where(causal, b[..., :, None] - b[..., None, :] + log_i[..., None, :], -jnp.inf)
    log_inter = b + m_state[..., None]
    m_out = jnp.maximum(log_inter, jnp.max(log_d, axis=-1))
    d_mat = jnp.exp(log_d - m_out[..., None])
    w_inter = jnp.exp(log_inter - m_out)
    s = jnp.einsum('bhtd,bhsd->bhts', q, k) * d_mat
    num = jnp.einsum('bhts,bhsv->bhtv', s, v) + w_inter[..., None] * jnp.einsum('bhvd,bhtd->bhtv', c_state, q)
    den = jnp.sum(s, axis=-1) + w_inter * jnp.einsum('bhd,bhtd->bht', n_state, q)
    h = num / jnp.maximum(jnp.abs(den), jnp.exp(-m_out))[..., None]
    log_w = g[..., None] - b + log_i
    m_new = jnp.maximum(g + m_state, jnp.max(log_w, axis=-1))
    w = jnp.exp(log_w - m_new[..., None])
    decay = jnp.exp(g + m_state - m_new)
    c_new = decay[..., None, None] * c_state + jnp.einsum('bhsv,bhsd->bhvd', v * w[..., None], k)
    n_new = decay[..., None] * n_state + jnp.einsum('bhs,bhsd->bhd', w, k)
    return (c_new, n_new, m_new), h


def mlstm_mixer(h, w_in, b_gate, head_gain, w_out):
    B, S, _ = h.shape
    H, DK, DV, L = MLSTM_HEADS, MLSTM_DQK, MLSTM_DV, MLSTM_CHUNK
    nc = S // L
    q, k, v, o, ig, fg = jnp.split(h @ w_in, MLSTM_SPLITS, axis=-1)

    def to_chunks(t, dh):
        return t.astype(jnp.float32).reshape(B, nc, L, H, dh).transpose(1, 0, 3, 2, 4)

    qc = to_chunks(q, DK)
    kc = to_chunks(k, DK) * (DK ** -0.5)
    vc = to_chunks(v, DV)
    bg = b_gate.astype(jnp.float32)
    log_i = (ig.astype(jnp.float32) + bg[0]).reshape(B, nc, L, H).transpose(1, 0, 3, 2)
    log_f = jax.nn.log_sigmoid(fg.astype(jnp.float32) + bg[1]).reshape(B, nc, L, H).transpose(1, 0, 3, 2)
    init = (jnp.zeros((B, H, DV, DK), jnp.float32), jnp.zeros((B, H, DK), jnp.float32),
            jnp.zeros((B, H), jnp.float32))
    _, hc = lax.scan(mlstm_chunk_step, init, (qc, kc, vc, log_i, log_f))
    hs = hc.transpose(1, 0, 3, 2, 4).reshape(B, S, H, DV)
    hs = rmsnorm(hs, head_gain).astype(h.dtype)
    return (hs.reshape(B, S, H * DV) * jax.nn.sigmoid(o)) @ w_out


def swa_sink_attention(h, positions, w_qkv, q_gain, k_gain, sinks, w_o):
    B, S, _ = h.shape
    HQ, HKV, G, DH, BLK = ATTN_Q_HEADS, ATTN_KV_HEADS, ATTN_GROUP, ATTN_HEAD_DIM, ATTN_BLOCK
    nb = S // BLK
    q, k, v = jnp.split(h @ w_qkv, (HQ * DH, (HQ + HKV) * DH), axis=-1)
    q = q.reshape(B, S, HQ, DH)
    k = k.reshape(B, S, HKV, DH)
    v = v.reshape(B, S, HKV, DH)
    inv_freq = ROPE_THETA ** (-jnp.arange(0, ROPE_DIM, 2, dtype=jnp.float32) / ROPE_DIM)
    ang = positions.astype(jnp.float32)[..., None] * inv_freq
    cos, sin = jnp.cos(ang)[:, :, None, :], jnp.sin(ang)[:, :, None, :]
    q = rope_partial(rmsnorm(q, q_gain), cos, sin)
    k = rope_partial(rmsnorm(k, k_gain), cos, sin)
    qb = q.reshape(B, nb, BLK, HKV, G, DH).transpose(1, 0, 2, 3, 4, 5)

    def banded(t):
        tp = jnp.pad(t, ((0, 0), (BLK, 0), (0, 0), (0, 0))).reshape(B, nb + 1, BLK, HKV, DH)
        return jnp.concatenate([tp[:, :-1], tp[:, 1:]], axis=2).transpose(1, 0, 2, 3, 4)

    kb, vb = banded(k), banded(v)
    qi = jnp.arange(BLK)[:, None] + BLK
    kj = jnp.arange(2 * BLK)[None, :]
    local_ok = (qi >= kj) & (qi - kj < ATTN_WINDOW)
    key_ok = local_ok[None] & ((jnp.arange(nb) > 0)[:, None, None] | (kj >= BLK)[None])
    sink_logit = sinks.astype(jnp.float32).reshape(HKV, G)[None, :, :, None, None]
    scale = DH ** -0.5

    def block(args):
        q_blk, k_blk, v_blk, ok = args
        s = jnp.einsum('bqhgd,bkhd->bhgqk', q_blk, k_blk).astype(jnp.float32) * scale
        s = jnp.where(ok, s, -jnp.inf)
        sink_col = jnp.broadcast_to(sink_logit, s.shape[:-1] + (1,))
        p = jax.nn.softmax(jnp.concatenate([s, sink_col], axis=-1), axis=-1)[..., :-1]
        return jnp.einsum('bhgqk,bkhd->bqhgd', p.astype(v_blk.dtype), v_blk)

    ob = lax.map(block, (qb, kb, vb, key_ok))
    o = ob.transpose(1, 0, 2, 3, 4, 5).reshape(B, S, HQ * DH)
    return o @ w_o


def rwkv7_step(state, xs):
    r, w, k, v, a_vec, b_vec = xs
    sa = jnp.einsum('bhvk,bhk->bhv', state, a_vec)
    state = state * w[:, :, None, :] + sa[..., None] * b_vec[:, :, None, :] + v[..., None] * k[:, :, None, :]
    y = jnp.einsum('bhvk,bhk->bhv', state, r)
    return state, y


def rwkv7_mixer(h, mix, w_rkv, w0, w_la, w_lb, a0, a_la, a_lb, g_la, g_lb, k_k, k_a, r_k, ln_w, ln_b, w_o):
    B, S, D = h.shape
    H, N = RWKV_HEADS, RWKV_HEAD
    dx = jnp.pad(h, ((0, 0), (1, 0), (0, 0)))[:, :-1] - h
    xr, xw, xk, xv, xa, xg = [h + dx * mix[i] for i in range(6)]
    r = xr @ w_rkv[0]
    k = xk @ w_rkv[1]
    v = xv @ w_rkv[2]
    log_w = -jax.nn.softplus(-(w0 + jnp.tanh(xw @ w_la) @ w_lb)) - 0.5
    a = jax.nn.sigmoid(a0 + (xa @ a_la) @ a_lb)
    g = jax.nn.sigmoid(xg @ g_la) @ g_lb

    def heads(t):
        return t.astype(jnp.float32).reshape(B, S, H, N)

    kk = heads(k * k_k)
    kk = kk / jnp.maximum(jnp.sqrt(jnp.sum(kk * kk, axis=-1, keepdims=True)), 1e-12)
    k = k * (1.0 + (a - 1.0) * k_a)
    r_h, k_h, v_h, a_h = heads(r), heads(k), heads(v), heads(a)
    decay = jnp.exp(-jnp.exp(heads(log_w)))

    def to_time(t):
        return t.transpose(1, 0, 2, 3)

    xs = tuple(map(to_time, (r_h, decay, k_h, v_h, -kk, kk * a_h)))
    _, y = lax.scan(rwkv7_step, jnp.zeros((B, H, N, N), jnp.float32), xs)
    y = to_time(y)
    mu = jnp.mean(y, axis=-1, keepdims=True)
    var = jnp.mean(jnp.square(y - mu), axis=-1, keepdims=True)
    y = (y - mu) * lax.rsqrt(var + RWKV_LN_EPS) * ln_w.astype(jnp.float32).reshape(H, N) \
        + ln_b.astype(jnp.float32).reshape(H, N)
    y = y + jnp.sum(r_h * k_h * r_k.astype(jnp.float32), axis=-1, keepdims=True) * v_h
    return (y.reshape(B, S, D).astype(h.dtype) * g) @ w_o


def setup_inputs(seed: int = 0) -> dict:
    key = jax.random.key(seed)
    ks = iter(jax.random.split(key, 64))
    D, F = D_MODEL, D_FF
    NA, NB_, NC = N_MLSTM_LAYERS, N_ATTN_LAYERS, N_RWKV_LAYERS

    def nrm(shape, scale):
        return jax.random.normal(next(ks), shape, jnp.float32) * scale

    def gain(shape):
        return 1.0 + nrm(shape, 0.02)

    x = nrm((BATCH, SEQ, D), 1.0)
    positions = jnp.arange(SEQ, dtype=jnp.int32)[None, :] + jax.random.randint(
        next(ks), (BATCH, 1), 0, 4096, dtype=jnp.int32)
    inp = {
        "x": x,
        "positions": positions,
        "ffn1_norm": gain((DEPTH, D)),
        "ffn1_w_gu": nrm((DEPTH, D, 2 * F), D ** -0.5),
        "ffn1_w_down": nrm((DEPTH, F, D), F ** -0.5),
        "mixer_norm": gain((DEPTH, D)),
        "ffn2_norm": gain((DEPTH, D)),
        "ffn2_w_gu": nrm((DEPTH, D, 2 * F), D ** -0.5),
        "ffn2_w_down": nrm((DEPTH, F, D), F ** -0.5),
        "mlstm_w_in": nrm((NA, D, MLSTM_IN_COLS), D ** -0.5),
        "mlstm_b_gate": jnp.stack([nrm((NA, MLSTM_HEADS), 0.1),
                                   jnp.linspace(3.0, 6.0, MLSTM_HEADS)[None, :] + nrm((NA, MLSTM_HEADS), 0.1)], axis=1),
        "mlstm_head_gain": gain((NA, MLSTM_HEADS, MLSTM_DV)),
        "mlstm_w_out": nrm((NA, MLSTM_HEADS * MLSTM_DV, D), (MLSTM_HEADS * MLSTM_DV) ** -0.5),
        "attn_w_qkv": nrm((NB_, D, ATTN_QKV_COLS), D ** -0.5),
        "attn_q_gain": gain((NB_, ATTN_HEAD_DIM)),
        "attn_k_gain": gain((NB_, ATTN_HEAD_DIM)),
        "attn_sinks": nrm((NB_, ATTN_Q_HEADS), 0.5),
        "attn_w_o": nrm((NB_, ATTN_Q_HEADS * ATTN_HEAD_DIM, D), (ATTN_Q_HEADS * ATTN_HEAD_DIM) ** -0.5),
        "rwkv_mix": jax.random.uniform(next(ks), (NC, 6, D), jnp.float32),
        "rwkv_w_rkv": nrm((NC, 3, D, D), D ** -0.5),
        "rwkv_w0": jnp.linspace(-6.5, -1.5, D)[None, :] + nrm((NC, D), 0.1),
        "rwkv_w_lora_a": nrm((NC, D, RWKV_DECAY_LORA), D ** -0.5),
        "rwkv_w_lora_b": nrm((NC, RWKV_DECAY_LORA, D), 0.1 * RWKV_DECAY_LORA ** -0.5),
        "rwkv_a0": nrm((NC, D), 0.1),
        "rwkv_a_lora_a": nrm((NC, D, RWKV_AAA_LORA), D ** -0.5),
        "rwkv_a_lora_b": nrm((NC, RWKV_AAA_LORA, D), RWKV_AAA_LORA ** -0.5),
        "rwkv_g_lora_a": nrm((NC, D, RWKV_GATE_LORA), D ** -0.5),
        "rwkv_g_lora_b": nrm((NC, RWKV_GATE_LORA, D), RWKV_GATE_LORA ** -0.5),
        "rwkv_k_k": 0.85 + nrm((NC, D), 0.02),
        "rwkv_k_a": 1.0 + nrm((NC, D), 0.02),
        "rwkv_r_k": nrm((NC, RWKV_HEADS, RWKV_HEAD), 0.1),
        "rwkv_ln_w": gain((NC, D)),
        "rwkv_ln_b": nrm((NC, D), 0.02),
        "rwkv_w_o": nrm((NC, D, D), D ** -0.5),
    }
    return inp


def reference(x, positions, ffn1_norm, ffn1_w_gu, ffn1_w_down, mixer_norm, ffn2_norm, ffn2_w_gu, ffn2_w_down,
              mlstm_w_in, mlstm_b_gate, mlstm_head_gain, mlstm_w_out,
              attn_w_qkv, attn_q_gain, attn_k_gain, attn_sinks, attn_w_o,
              rwkv_mix, rwkv_w_rkv, rwkv_w0, rwkv_w_lora_a, rwkv_w_lora_b, rwkv_a0, rwkv_a_lora_a, rwkv_a_lora_b,
              rwkv_g_lora_a, rwkv_g_lora_b, rwkv_k_k, rwkv_k_a, rwkv_r_k, rwkv_ln_w, rwkv_ln_b, rwkv_w_o):
    for i in range(DEPTH):
        x = x + 0.5 * swiglu(rmsnorm(x, ffn1_norm[i]), ffn1_w_gu[i], ffn1_w_down[i])
        hn = rmsnorm(x, mixer_norm[i])
        kind, j = i % N_MIXERS, i // N_MIXERS
        if kind == 0:
            y = mlstm_mixer(hn, mlstm_w_in[j], mlstm_b_gate[j], mlstm_head_gain[j], mlstm_w_out[j])
        elif kind == 1:
            y = swa_sink_attention(hn, positions, attn_w_qkv[j], attn_q_gain[j], attn_k_gain[j],
                                   attn_sinks[j], attn_w_o[j])
        else:
            y = rwkv7_mixer(hn, rwkv_mix[j], rwkv_w_rkv[j], rwkv_w0[j], rwkv_w_lora_a[j], rwkv_w_lora_b[j],
                            rwkv_a0[j], rwkv_a_lora_a[j], rwkv_a_lora_b[j], rwkv_g_lora_a[j], rwkv_g_lora_b[j],
                            rwkv_k_k[j], rwkv_k_a[j], rwkv_r_k[j], rwkv_ln_w[j], rwkv_ln_b[j], rwkv_w_o[j])
        x = x + y
        x = x + 0.5 * swiglu(rmsnorm(x, ffn2_norm[i]), ffn2_w_gu[i], ffn2_w_down[i])
    return x
```

```cpp
#include <hip/hip_runtime.h>
#include <cstdio>
#include <cstdint>
#define I8_MIX_MASK 0xA
namespace pg8 {
#define PG8_LAS __attribute__((address_space(3)))
typedef unsigned short bf16_t;
typedef short bf16x8 __attribute__((ext_vector_type(8)));
typedef float f32x4 __attribute__((ext_vector_type(4)));
typedef unsigned u32x4 __attribute__((ext_vector_type(4)));
constexpr int BM = 256, BK = 64, HALF = 128, HTB = HALF * BK * 2  , STAGE_BYTES = 8 * HTB, NXCD = 8, WGM = 8;

__host__ __device__ __forceinline__ int lds_byte(int r, int c) { const int st = (r >> 4) * 2 + (c >> 5), rr = r & 15, cc = c & 31, ob = rr * 64 + cc * 2; return st * 1024 + (ob ^ (((ob >> 9) & 1) << 5)); }
__host__ __device__ __forceinline__ void stage_rc(int b, int& R, int& C) { const int st = b / 1024, sb = b % 1024, swz = sb ^ (((sb >> 9) & 1) << 5); R = (st >> 1) * 16 + swz / 64; C = (st & 1) * 32 + (swz % 64) / 2; }
__host__ __device__ __forceinline__ int perm32(int rho) { const int n = rho >> 4, i = rho & 15; return 8 * (i >> 2) + 4 * n + (i & 3); }

typedef int i32x8 __attribute__((ext_vector_type(8)));
__device__ __forceinline__ i32x8 ld32(const PG8_LAS unsigned char* p) { typedef int i32x4_ __attribute__((ext_vector_type(4))); const i32x4_ lo = *(const PG8_LAS i32x4_*)p, hi = *(const PG8_LAS i32x4_*)(p + 16); return __builtin_shufflevector(lo, hi, 0, 1, 2, 3, 4, 5, 6, 7); }
struct Unit { int pm, pn; };
struct Gemm { const bf16_t* A; const bf16_t* Bt; int lda, ldb, K; };

struct StaticOrder {
    int nM, nN, nwg, G, c, wgm;
    __host__ __device__ void init(int M, int N, int G_, int c_, int wgm_ = WGM) { nM = M / BM; nN = N / BM; nwg = nM * nN; G = G_; c = c_; wgm = wgm_; }
    __host__ __device__ bool next(int i, Unit& u) const {
        const long L = (long)i * G + c; if (L >= nwg) return false;
        int wgid = (int)L; { const int q = nwg / NXCD, r = nwg % NXCD, xcd = wgid % NXCD, off = wgid / NXCD; wgid = (xcd < r ? xcd * (q + 1) : r * (q + 1) + (xcd - r) * q) + off; }
        const int nig = wgm * nN, gid = wgid / nig, fm = gid * wgm, gsz = (nM - fm) < wgm ? (nM - fm) : wgm;
        u.pm = fm + ((wgid % nig) % gsz); u.pn = (wgid % nig) / gsz; return true;
    }
    __device__ __forceinline__ void a_ready(const Unit&) const {}
    __device__ __forceinline__ void done(const Unit&) const {}
};

typedef __bf16 bf16v2_t __attribute__((ext_vector_type(2)));
__device__ __forceinline__ unsigned cvt_pk_bf16(float lo, float hi) { bf16v2_t v; v.x = (__bf16)lo; v.y = (__bf16)hi; return __builtin_bit_cast(unsigned, v); }
__device__ __forceinline__ float fast_sigmoid(float x) { return __builtin_amdgcn_rcpf(1.0f + __expf(-x)); }
constexpr int MROWS_TILES = 128;

constexpr float H8_SCALE = 4.0f, W8_SCALE = 64.0f, X8_SCALE = 16.0f;
struct RowTab { const PG8_LAS float* tab; const PG8_LAS int* tags;
    __device__ __forceinline__ int slot(int pm) const { int s = 0;
#pragma unroll
        for (int k = 0; k < 8; ++k) if (tags[k] == pm) s = k;
        return __builtin_amdgcn_readfirstlane(s); } };
template <bool F8, bool IN8 = false>
struct EpiSwiGLU {
    static constexpr bool PERM = true, AFTER_DRAIN = false;
    void* O; int ldc; float isc; RowTab rt; const float* cstep;
    __device__ __forceinline__ void operator()(const f32x4 (&acc)[2][2][4][2], const Unit& u, int wr, int wc, int fr, int fq) const {
        const int row0 = u.pm * BM + wr * 64 + fr, col0 = u.pn * HALF + wc * 32 + 8 * fq; const int sl = IN8 ? rt.slot(u.pm) : 0;
        f32x4 cg[2], cu[2];
#pragma unroll
        for (int n = 0; n < 2; ++n) { cg[n] = IN8 ? *(const f32x4*)(cstep + u.pn * BM + wc * 32 + 8 * fq + 4 * n) : (f32x4){1.f, 1.f, 1.f, 1.f}; cu[n] = IN8 ? *(const f32x4*)(cstep + u.pn * BM + HALF + wc * 32 + 8 * fq + 4 * n) : (f32x4){1.f, 1.f, 1.f, 1.f}; }
#pragma unroll
        for (int ai = 0; ai < 2; ++ai)
#pragma unroll
            for (int m = 0; m < 4; ++m) { const size_t off = (size_t)(row0 + ai * HALF + m * 16) * ldc + col0;
                const float rs = IN8 ? rt.tab[sl * 256 + wr * 64 + ai * HALF + m * 16 + fr] : isc;
                float o[8];
#pragma unroll
                for (int n = 0; n < 2; ++n)
#pragma unroll
                    for (int e = 0; e < 4; ++e) { const float ga = acc[ai][0][m][n][e], ua = acc[ai][1][m][n][e];
                        const float g = (IN8 ? (float)__float_as_int(ga) * cg[n][e] : ga) * rs, up = (IN8 ? (float)__float_as_int(ua) * cu[n][e] : ua) * rs; o[4 * n + e] = g * fast_sigmoid(g) * up; }
                if (F8) { unsigned w0 = 0u, w1 = 0u;
#pragma unroll
                    for (int e = 0; e < 8; ++e) o[e] = __builtin_amdgcn_fmed3f(o[e] * H8_SCALE, -448.0f, 448.0f);
                    w0 = __builtin_amdgcn_cvt_pk_fp8_f32(o[0], o[1], w0, false); w0 = __builtin_amdgcn_cvt_pk_fp8_f32(o[2], o[3], w0, true);
                    w1 = __builtin_amdgcn_cvt_pk_fp8_f32(o[4], o[5], w1, false); w1 = __builtin_amdgcn_cvt_pk_fp8_f32(o[6], o[7], w1, true);
                    typedef unsigned u32x2_ __attribute__((ext_vector_type(2))); *(u32x2_*)((unsigned char*)O + off) = (u32x2_){w0, w1}; }
                else { u32x4 w; w.x = cvt_pk_bf16(o[0], o[1]); w.y = cvt_pk_bf16(o[2], o[3]); w.z = cvt_pk_bf16(o[4], o[5]); w.w = cvt_pk_bf16(o[6], o[7]);
                    __builtin_nontemporal_store(w, (u32x4*)((bf16_t*)O + off)); } }
    }
};
typedef _Float16 h16x8_t __attribute__((ext_vector_type(8)));
template <bool BB, bool OB>
struct EpiResid {
    static constexpr bool PERM = true, AFTER_DRAIN = false;
    const void* base; void* out; int ldc; float s;
    __device__ __forceinline__ void operator()(const f32x4 (&acc)[2][2][4][2], const Unit& u, int wr, int wc, int fr, int fq) const {
        const int row0 = u.pm * BM + wr * 64 + fr, col0 = u.pn * BM + wc * 32 + 8 * fq;
#pragma unroll
        for (int ai = 0; ai < 2; ++ai) {
            if constexpr (BB) {
                h16x8_t wv[4][2];
#pragma unroll
                for (int m = 0; m < 4; ++m)
#pragma unroll
                    for (int bj = 0; bj < 2; ++bj) wv[m][bj] = *(const h16x8_t*)((const bf16_t*)base + (size_t)(row0 + ai * HALF + m * 16) * ldc + col0 + bj * HALF);
#pragma unroll
                for (int m = 0; m < 4; ++m) { const size_t off = (size_t)(row0 + ai * HALF + m * 16) * ldc + col0;
#pragma unroll
                    for (int bj = 0; bj < 2; ++bj) { const h16x8_t w = wv[m][bj];
                        const f32x4 b0 = (f32x4){(float)w[0], (float)w[1], (float)w[2], (float)w[3]}, b1 = (f32x4){(float)w[4], (float)w[5], (float)w[6], (float)w[7]};
                        const f32x4 o0 = b0 + acc[ai][bj][m][0] * s, o1 = b1 + acc[ai][bj][m][1] * s;
                        if (OB) { h16x8_t wo; wo[0] = (_Float16)o0[0]; wo[1] = (_Float16)o0[1]; wo[2] = (_Float16)o0[2]; wo[3] = (_Float16)o0[3]; wo[4] = (_Float16)o1[0]; wo[5] = (_Float16)o1[1]; wo[6] = (_Float16)o1[2]; wo[7] = (_Float16)o1[3];
                            *(h16x8_t*)((bf16_t*)out + off + bj * HALF) = wo; }
                        else { *(f32x4*)((float*)out + off + bj * HALF) = o0; *(f32x4*)((float*)out + off + bj * HALF + 4) = o1; } } }
            } else {
#pragma unroll
                for (int m = 0; m < 4; ++m) { const size_t off = (size_t)(row0 + ai * HALF + m * 16) * ldc + col0; f32x4 bb[2][2];
#pragma unroll
                    for (int bj = 0; bj < 2; ++bj) { bb[bj][0] = *(const f32x4*)((const float*)base + off + bj * HALF); bb[bj][1] = *(const f32x4*)((const float*)base + off + bj * HALF + 4); }
#pragma unroll
                    for (int bj = 0; bj < 2; ++bj) { const f32x4 o0 = bb[bj][0] + acc[ai][bj][m][0] * s, o1 = bb[bj][1] + acc[ai][bj][m][1] * s;
                        if (OB) { h16x8_t wo; wo[0] = (_Float16)o0[0]; wo[1] = (_Float16)o0[1]; wo[2] = (_Float16)o0[2]; wo[3] = (_Float16)o0[3]; wo[4] = (_Float16)o1[0]; wo[5] = (_Float16)o1[1]; wo[6] = (_Float16)o1[2]; wo[7] = (_Float16)o1[3];
                            *(h16x8_t*)((bf16_t*)out + off + bj * HALF) = wo; }
                        else { *(f32x4*)((float*)out + off + bj * HALF) = o0; *(f32x4*)((float*)out + off + bj * HALF + 4) = o1; } } }
            }
        }
    }
};
__device__ __forceinline__ f32x4 i32bits_to_f32(f32x4 v) { return (f32x4){(float)__float_as_int(v.x), (float)__float_as_int(v.y), (float)__float_as_int(v.z), (float)__float_as_int(v.w)}; }
template <bool IN8 = false>
struct EpiStore {
    static constexpr bool PERM = true, AFTER_DRAIN = false;
    bf16_t* O; int ldc; int gate_tile; float* G; RowTab rt; const float* cstep;
    __device__ __forceinline__ void operator()(const f32x4 (&acc)[2][2][4][2], const Unit& u, int wr, int wc, int fr, int fq) const {
        const int row0 = u.pm * BM + wr * 64 + fr, colt = u.pn * BM, cl = wc * 32 + 8 * fq; const int sl = IN8 ? rt.slot(u.pm) : 0;
        f32x4 cs[2][2];
#pragma unroll
        for (int bj = 0; bj < 2; ++bj)
#pragma unroll
            for (int n = 0; n < 2; ++n) cs[bj][n] = IN8 ? *(const f32x4*)(cstep + colt + bj * HALF + cl + 4 * n) : (f32x4){1.f, 1.f, 1.f, 1.f};
        if (u.pn >= gate_tile) {
            if (wc == 0 && fq < 2) {
#pragma unroll
                for (int ai = 0; ai < 2; ++ai)
#pragma unroll
                    for (int m = 0; m < 4; ++m) { const int rl = wr * 64 + ai * HALF + m * 16 + fr; float* gp = G + (size_t)(u.pm * BM + rl) * 16 + 8 * fq;
                        if (IN8) { const float rs = rt.tab[sl * 256 + rl]; *(f32x4*)gp = i32bits_to_f32(acc[ai][0][m][0]) * cs[0][0] * rs; *(f32x4*)(gp + 4) = i32bits_to_f32(acc[ai][0][m][1]) * cs[0][1] * rs; }
                        else { *(f32x4*)gp = acc[ai][0][m][0]; *(f32x4*)(gp + 4) = acc[ai][0][m][1]; } }
            }
            return;
        }
#pragma unroll
        for (int ai = 0; ai < 2; ++ai)
#pragma unroll
            for (int m = 0; m < 4; ++m) { const int rl = wr * 64 + ai * HALF + m * 16 + fr; bf16_t* rowp = O + (size_t)(u.pm * BM + rl) * ldc + colt + cl;
                const float rs = IN8 ? rt.tab[sl * 256 + rl] : 1.0f;
#pragma unroll
                for (int bj = 0; bj < 2; ++bj) { f32x4 v0 = acc[ai][bj][m][0], v1 = acc[ai][bj][m][1];
                    if (IN8) { v0 = i32bits_to_f32(v0) * cs[bj][0] * rs; v1 = i32bits_to_f32(v1) * cs[bj][1] * rs; }
                    u32x4 w; w.x = cvt_pk_bf16(v0[0], v0[1]); w.y = cvt_pk_bf16(v0[2], v0[3]); w.z = cvt_pk_bf16(v1[0], v1[1]); w.w = cvt_pk_bf16(v1[2], v1[3]);
                    *(u32x4*)(rowp + bj * HALF) = w; } }
    }
};
struct EpiRwkv1 {
    static constexpr bool PERM = true, AFTER_DRAIN = false;
    bf16_t* RKV; bf16_t* L; int Mrows;
    __device__ __forceinline__ void operator()(const f32x4 (&acc)[2][2][4][2], const Unit& u, int wr, int wc, int fr, int fq) const {
        const int pml = u.pm & (MROWS_TILES - 1), row0 = pml * BM + wr * 64 + fr, cl = wc * 32 + 8 * fq;
        bf16_t* base; int ldc, colt, mode;
        if (u.pn < 24) { base = RKV + (size_t)(u.pn >> 3) * Mrows * 2048; ldc = 2048; colt = (u.pn & 7) * BM; mode = 0; }
        else { base = L + (size_t)(u.pn - 24) * Mrows * 256; ldc = 256; colt = 0; mode = u.pn - 23; }
#pragma unroll
        for (int ai = 0; ai < 2; ++ai)
#pragma unroll
            for (int m = 0; m < 4; ++m) { bf16_t* rowp = base + (size_t)(row0 + ai * HALF + m * 16) * ldc + colt + cl;
#pragma unroll
                for (int bj = 0; bj < 2; ++bj) { float o[8];
#pragma unroll
                    for (int n = 0; n < 2; ++n)
#pragma unroll
                        for (int e = 0; e < 4; ++e) { float v = acc[ai][bj][m][n][e];
                            if (mode == 1) { const float t = __expf(-2.0f * fabsf(v)); const float th = (1.0f - t) * __builtin_amdgcn_rcpf(1.0f + t); v = v < 0.f ? -th : th; }
                            else if (mode == 3) v = fast_sigmoid(v);
                            o[4 * n + e] = v; }
                    u32x4 w; w.x = cvt_pk_bf16(o[0], o[1]); w.y = cvt_pk_bf16(o[2], o[3]); w.z = cvt_pk_bf16(o[4], o[5]); w.w = cvt_pk_bf16(o[6], o[7]);
                    *(u32x4*)(rowp + bj * HALF) = w; } }
    }
};
struct EpiRwkv2 {
    static constexpr bool PERM = true, AFTER_DRAIN = false;
    float* DEC; bf16_t* AG; bf16_t* GG; const float* w0; const float* a0;
    __device__ __forceinline__ void operator()(const f32x4 (&acc)[2][2][4][2], const Unit& u, int wr, int wc, int fr, int fq) const {
        const int pml = u.pm & (MROWS_TILES - 1), row0 = pml * BM + wr * 64 + fr, seg = u.pn >> 3, col0 = (u.pn & 7) * BM + wc * 32 + 8 * fq;
        const float* bias = seg == 0 ? w0 : a0;
        f32x4 bv[2][2];
#pragma unroll
        for (int bj = 0; bj < 2; ++bj)
#pragma unroll
            for (int n = 0; n < 2; ++n) bv[bj][n] = seg < 2 ? *(const f32x4*)(bias + col0 + bj * HALF + 4 * n) : (f32x4){0.f, 0.f, 0.f, 0.f};
#pragma unroll
        for (int ai = 0; ai < 2; ++ai)
#pragma unroll
            for (int m = 0; m < 4; ++m) { const size_t ro = (size_t)(row0 + ai * HALF + m * 16) * 2048;
#pragma unroll
                for (int bj = 0; bj < 2; ++bj) { const int col = col0 + bj * HALF; const f32x4 v0 = acc[ai][bj][m][0] + bv[bj][0], v1 = acc[ai][bj][m][1] + bv[bj][1];
                    if (seg == 0) { *(f32x4*)(DEC + ro + col) = v0; *(f32x4*)(DEC + ro + col + 4) = v1; }
                    else { u32x4 w; w.x = cvt_pk_bf16(v0[0], v0[1]); w.y = cvt_pk_bf16(v0[2], v0[3]); w.z = cvt_pk_bf16(v1[0], v1[1]); w.w = cvt_pk_bf16(v1[2], v1[3]);
                        *(u32x4*)((seg == 1 ? AG : GG) + ro + col) = w; } } }
    }
};
struct RwkvOrder1 { StaticOrder b;
    __device__ bool next(int i, Unit& u) const { if (!b.next(i, u)) return false; const int seg = u.pn < 24 ? (u.pn >> 3) : u.pn - 21; u.pm += ((0x541320 >> (4 * seg)) & 7) * MROWS_TILES; return true; }
    __device__ __forceinline__ void a_ready(const Unit&) const {}
    __device__ __forceinline__ void done(const Unit&) const {} };
struct RwkvOrder2 { StaticOrder b;
    __device__ bool next(int i, Unit& u) const { if (!b.next(i, u)) return false; u.pm += (u.pn >> 3) * MROWS_TILES; return true; }
    __device__ __forceinline__ void a_ready(const Unit&) const {}
    __device__ __forceinline__ void done(const Unit&) const {} };

template <class Epi, class Sched, bool ALIGN_EPI = false, bool SP2 = false, int DT = 0>
__device__ __forceinline__ void gemm_phase(PG8_LAS unsigned char* lds, const Gemm g, const Sched& S, const Epi& E, const int tid_in) {
    const int tid = tid_in, wid = __builtin_amdgcn_readfirstlane(tid >> 6), lane = tid & 63, wr = wid >> 2, wc = wid & 3, fr = lane & 15, fq = lane >> 4;
    int K_ = g.K; asm volatile("" : "+s"(K_));
    const int K = K_, nt = K / BK;
    unsigned voffA[2], voffB[2];
#pragma unroll
    for (int i = 0; i < 2; ++i) { int R, C; stage_rc(tid * 16 + i * 8192, R, C); const int Rb = Epi::PERM ? ((R & ~31) + perm32(R & 31)) : R;
        voffA[i] = (unsigned)(R * g.lda + C) * 2u; voffB[i] = (unsigned)(Rb * g.ldb + C) * 2u; }
    const size_t kstep = (size_t)(BK * 2);
    const size_t hstepA = (size_t)HALF * g.lda * 2, hstepB = (size_t)HALF * g.ldb * 2;
    const size_t tstepA = 2 * hstepA, tstepB = 2 * hstepB;
    const unsigned ldsw = (unsigned)wid * 1024u;
    const int aoff = lds_byte(wr * 64 + fr, fq * (DT == 1 ? 16 : 8)), boff = lds_byte(wc * 32 + fr, fq * (DT == 1 ? 16 : 8));
#define PG8_SA(b, h) (((b) * 2 + (h)) * HTB)
#define PG8_SB(b, h) ((4 + (b) * 2 + (h)) * HTB)
#define PG8_STAGE(bufoff, gbase, voff) do { _Pragma("unroll") for (int _i = 0; _i < 2; ++_i) \
        __builtin_amdgcn_global_load_lds((const unsigned*)((const char*)(gbase) + (voff)[_i]), (PG8_LAS unsigned*)(lds + (bufoff) + ldsw + _i * 8192), 16, 0, 0); } while (0)
#define PG8_LDA(dst, b, h) do { if constexpr (DT != 1) { _Pragma("unroll") for (int m = 0; m < 4; ++m) _Pragma("unroll") for (int k = 0; k < 2; ++k) dst[m][k] = *(const PG8_LAS bf16x8*)(lds + PG8_SA(b, h) + aoff + m * 2048 + k * 1024); } \
        else { _Pragma("unroll") for (int m = 0; m < 4; ++m) dst##8[m] = ld32(lds + PG8_SA(b, h) + aoff + m * 2048); } } while (0)
#define PG8_LDB(dst, b, h) do { if constexpr (DT != 1) { _Pragma("unroll") for (int n = 0; n < 2; ++n) _Pragma("unroll") for (int k = 0; k < 2; ++k) dst[n][k] = *(const PG8_LAS bf16x8*)(lds + PG8_SB(b, h) + boff + n * 2048 + k * 1024); } \
        else { _Pragma("unroll") for (int n = 0; n < 2; ++n) dst##8[n] = ld32(lds + PG8_SB(b, h) + boff + n * 2048); } } while (0)
#define PG8_MMA(ai, bj, At, Bt) do { __builtin_amdgcn_s_setprio(1); \
        if constexpr (DT == 0) { _Pragma("unroll") for (int m = 0; m < 4; ++m) _Pragma("unroll") for (int n = 0; n < 2; ++n) _Pragma("unroll") for (int k = 0; k < 2; ++k) \
            acc[ai][bj][m][n] = __builtin_amdgcn_mfma_f32_16x16x32_bf16(Bt[n][k], At[m][k], acc[ai][bj][m][n], 0, 0, 0); } \
        else if constexpr (DT == 2) { typedef int i32x4_ __attribute__((ext_vector_type(4))); _Pragma("unroll") for (int m = 0; m < 4; ++m) _Pragma("unroll") for (int n = 0; n < 2; ++n) _Pragma("unroll") for (int k = 0; k < 2; ++k) \
            acc[ai][bj][m][n] = __builtin_bit_cast(f32x4, __builtin_amdgcn_mfma_i32_16x16x64_i8(__builtin_bit_cast(i32x4_, Bt[n][k]), __builtin_bit_cast(i32x4_, At[m][k]), __builtin_bit_cast(i32x4_, acc[ai][bj][m][n]), 0, 0, 0)); } \
        else { _Pragma("unroll") for (int m = 0; m < 4; ++m) _Pragma("unroll") for (int n = 0; n < 2; ++n) \
            { constexpr int O_ = 0; const int o_ = (m * 2 + n) * 4; f32x4 c_ = {accq[ai][bj][o_], accq[ai][bj][o_ + 1], accq[ai][bj][o_ + 2], accq[ai][bj][o_ + 3]}; (void)O_; \
              c_ = __builtin_amdgcn_mfma_scale_f32_16x16x128_f8f6f4(Bt##8[n], At##8[m], c_, 0, 0, 0, 0x7F7F7F7F, 0, 0x7F7F7F7F); \
              accq[ai][bj][o_] = c_[0]; accq[ai][bj][o_ + 1] = c_[1]; accq[ai][bj][o_ + 2] = c_[2]; accq[ai][bj][o_ + 3] = c_[3]; } } \
        __builtin_amdgcn_s_setprio(0); } while (0)
#define PG8_WAIT_V(n) asm volatile("s_waitcnt vmcnt(" #n ")" ::: "memory")
#define PG8_WAIT_L(n) asm volatile("s_waitcnt lgkmcnt(" #n ")" ::: "memory")
#define PG8_BAR __builtin_amdgcn_s_barrier()
#define PG8_SCHED __builtin_amdgcn_sched_barrier(0)
    Unit cur, nxt; int ui = 0;
    if (!S.next(0, cur)) return;
    f32x4 acc[2][2][4][2];
    typedef float f32x32 __attribute__((ext_vector_type(32)));
    f32x32 accq[2][2];
    if constexpr (DT == 1) {
#pragma unroll
        for (int a = 0; a < 2; ++a)
#pragma unroll
            for (int b = 0; b < 2; ++b)
#pragma unroll
                for (int i = 0; i < 32; ++i) accq[a][b][i] = 0.f; }
#pragma unroll
    for (int a = 0; a < 2; ++a)
#pragma unroll
        for (int b = 0; b < 2; ++b)
#pragma unroll
            for (int m = 0; m < 4; ++m)
#pragma unroll
                for (int n = 0; n < 2; ++n) acc[a][b][m][n] = (f32x4){0.f, 0.f, 0.f, 0.f};
    bf16x8 At[4][2], B0[2][2], B1[2][2];
    i32x8 At8[4], B08[2], B18[2];
    const char* cA = (const char*)g.A + (size_t)cur.pm * tstepA; const char* cB = (const char*)g.Bt + (size_t)cur.pn * tstepB;
    S.a_ready(cur);
    if constexpr (SP2) {
        PG8_STAGE(PG8_SB(0, 0), cB, voffB); PG8_STAGE(PG8_SB(0, 1), cB + hstepB, voffB); PG8_STAGE(PG8_SA(0, 0), cA, voffA); PG8_STAGE(PG8_SA(0, 1), cA + hstepA, voffA);
        if (wr == 1) PG8_BAR;
        PG8_WAIT_V(2); PG8_BAR;
        PG8_STAGE(PG8_SB(1, 0), cB + kstep, voffB); PG8_STAGE(PG8_SA(1, 0), cA + kstep, voffA); PG8_STAGE(PG8_SB(1, 1), cB + hstepB + kstep, voffB);
        PG8_WAIT_V(6); PG8_BAR;
    } else {
        PG8_STAGE(PG8_SB(0, 0), cB, voffB); PG8_STAGE(PG8_SA(0, 0), cA, voffA); PG8_STAGE(PG8_SB(0, 1), cB + hstepB, voffB); PG8_STAGE(PG8_SA(0, 1), cA + hstepA, voffA);
        if (wr == 1) PG8_BAR;
        PG8_WAIT_V(4); PG8_BAR;
        PG8_STAGE(PG8_SB(1, 0), cB + kstep, voffB); PG8_STAGE(PG8_SA(1, 0), cA + kstep, voffA); PG8_STAGE(PG8_SB(1, 1), cB + hstepB + kstep, voffB);
        PG8_WAIT_V(6); PG8_BAR;
    }
    for (;;) {
        const bool has_next = S.next(ui + 1, nxt);
        const char* nA = has_next ? (const char*)g.A + (size_t)nxt.pm * tstepA : cA; const char* nB = has_next ? (const char*)g.Bt + (size_t)nxt.pn * tstepB : cB;
        for (int t = 0; t < nt; t += 2) {
            const bool last = (t == nt - 2);
            const char* a1 = cA + (size_t)(t + 1) * kstep;
            const char* a2 = last ? nA : cA + (size_t)(t + 2) * kstep; const char* b2 = last ? nB : cB + (size_t)(t + 2) * kstep;
            const char* a3 = a2 + kstep; const char* b3 = b2 + kstep;
            if (last && has_next) S.a_ready(nxt);
            if constexpr (SP2) {
            PG8_LDB(B0, 0, 0); PG8_LDB(B1, 0, 1); PG8_SCHED; PG8_LDA(At, 0, 0); PG8_STAGE(PG8_SA(1, 1), a1 + hstepA, voffA);
            PG8_WAIT_V(8); PG8_WAIT_L(0); PG8_BAR; PG8_MMA(0, 0, At, B0); PG8_MMA(0, 1, At, B1); PG8_BAR; PG8_SCHED;
            PG8_LDA(At, 0, 1); PG8_STAGE(PG8_SB(0, 0), b2, voffB); PG8_STAGE(PG8_SB(0, 1), b2 + hstepB, voffB); PG8_STAGE(PG8_SA(0, 0), a2, voffA);
            PG8_WAIT_V(8); PG8_WAIT_L(0); PG8_BAR; PG8_MMA(1, 0, At, B0); PG8_MMA(1, 1, At, B1); PG8_BAR; PG8_SCHED;
            PG8_LDB(B0, 1, 0); PG8_LDB(B1, 1, 1); PG8_SCHED; PG8_LDA(At, 1, 0); PG8_STAGE(PG8_SA(0, 1), a2 + hstepA, voffA);
            PG8_WAIT_V(8); PG8_WAIT_L(0); PG8_BAR; PG8_MMA(0, 0, At, B0); PG8_MMA(0, 1, At, B1); PG8_BAR; PG8_SCHED;
            PG8_LDA(At, 1, 1); PG8_STAGE(PG8_SB(1, 0), b3, voffB); PG8_STAGE(PG8_SB(1, 1), b3 + hstepB, voffB); PG8_STAGE(PG8_SA(1, 0), a3, voffA);
            PG8_WAIT_V(8); PG8_WAIT_L(0); PG8_BAR; PG8_MMA(1, 0, At, B0); PG8_MMA(1, 1, At, B1); PG8_BAR; PG8_SCHED;
            } else {
            PG8_LDB(B0, 0, 0); PG8_SCHED; PG8_LDA(At, 0, 0); PG8_STAGE(PG8_SA(1, 1), a1 + hstepA, voffA);
            PG8_WAIT_L(8); PG8_BAR; PG8_WAIT_L(0); PG8_MMA(0, 0, At, B0); PG8_BAR; PG8_SCHED;
            PG8_LDB(B1, 0, 1); PG8_STAGE(PG8_SB(0, 0), b2, voffB);
            PG8_BAR; PG8_WAIT_L(0); PG8_MMA(0, 1, At, B1); PG8_BAR;
            PG8_LDA(At, 0, 1); PG8_STAGE(PG8_SA(0, 0), a2, voffA);
            PG8_BAR; PG8_WAIT_L(0); PG8_MMA(1, 0, At, B0); PG8_BAR; PG8_SCHED;
            PG8_STAGE(PG8_SB(0, 1), b2 + hstepB, voffB);
            PG8_WAIT_V(6); PG8_BAR; PG8_MMA(1, 1, At, B1); PG8_BAR;
            PG8_LDB(B0, 1, 0); PG8_SCHED; PG8_LDA(At, 1, 0); PG8_STAGE(PG8_SA(0, 1), a2 + hstepA, voffA);
            PG8_WAIT_L(8); PG8_BAR; PG8_WAIT_L(0); PG8_MMA(0, 0, At, B0); PG8_BAR; PG8_SCHED;
            PG8_LDB(B1, 1, 1); PG8_STAGE(PG8_SB(1, 0), b3, voffB);
            PG8_BAR; PG8_WAIT_L(0); PG8_MMA(0, 1, At, B1); PG8_BAR;
            PG8_LDA(At, 1, 1); PG8_STAGE(PG8_SA(1, 0), a3, voffA);
            PG8_BAR; PG8_WAIT_L(0); PG8_MMA(1, 0, At, B0); PG8_BAR; PG8_SCHED;
            PG8_STAGE(PG8_SB(1, 1), b3 + hstepB, voffB);
            PG8_WAIT_V(6); PG8_BAR; PG8_MMA(1, 1, At, B1); PG8_BAR;
            }
        }
        if constexpr (ALIGN_EPI) { if (wr == 0) PG8_BAR; }
        if constexpr (DT == 1) {
#pragma unroll
            for (int a = 0; a < 2; ++a)
#pragma unroll
                for (int b = 0; b < 2; ++b)
#pragma unroll
                    for (int m = 0; m < 4; ++m)
#pragma unroll
                        for (int n = 0; n < 2; ++n) { const int o_ = (m * 2 + n) * 4; acc[a][b][m][n] = (f32x4){accq[a][b][o_], accq[a][b][o_ + 1], accq[a][b][o_ + 2], accq[a][b][o_ + 3]}; } }
        if constexpr (!Epi::AFTER_DRAIN) { E(acc, cur, wr, wc, fr, fq); S.done(cur); }
        if (!has_next) break;
#pragma unroll
        for (int a = 0; a < 2; ++a)
#pragma unroll
            for (int b = 0; b < 2; ++b)
#pragma unroll
                for (int m = 0; m < 4; ++m)
#pragma unroll
                    for (int n = 0; n < 2; ++n) acc[a][b][m][n] = (f32x4){0.f, 0.f, 0.f, 0.f};
        if constexpr (DT == 1) {
#pragma unroll
            for (int a = 0; a < 2; ++a)
#pragma unroll
                for (int b = 0; b < 2; ++b)
#pragma unroll
                    for (int i = 0; i < 32; ++i) accq[a][b][i] = 0.f; }
        cur = nxt; cA = nA; cB = nB; ++ui;
        if constexpr (ALIGN_EPI) { if (wr == 1) PG8_BAR; }
    }
    PG8_WAIT_V(0);
    if constexpr (!ALIGN_EPI) { if (wr == 0) PG8_BAR; }
    PG8_BAR;
    if constexpr (Epi::AFTER_DRAIN) { E.fused(acc, cur, wr, wc, fr, fq, lds, wid, lane); S.done(cur); }
#undef PG8_SA
#undef PG8_SB
#undef PG8_STAGE
#undef PG8_LDA
#undef PG8_LDB
#undef PG8_MMA
#undef PG8_WAIT_V
#undef PG8_WAIT_L
#undef PG8_BAR
#undef PG8_SCHED
}
}

constexpr int NWAVES = 8, NTHREADS = 512;
constexpr int DM = 2048, NBATCH = 8, SEQ = 4096, MTOK = NBATCH * SEQ, FF = 5632, DEPTH = 4;
constexpr float NORM_EPS = 1e-6f;
constexpr int ML_H = 8, ML_DK = 128, ML_DV = 256, ML_L = 64, ML_NC = SEQ / ML_L, ML_INCOLS = 6160, ML_NPAD = 6400, ML_ITEMS = NBATCH * ML_H * ML_NC;
constexpr int AT_DH = 64, AT_HQ = 32, AT_HKV = 4, AT_G = 8, AT_BLK = 128, AT_NB = SEQ / AT_BLK, AT_COLS = 2560, AT_UNITS = NBATCH * AT_NB * AT_HKV;
constexpr int RW_H = 32, RW_N = 64, RW_T = 32, RW_NBLK = SEQ / RW_T;
constexpr float RW_LN_EPS = 64e-5f;
enum { I_X = 0, I_POS, I_F1N, I_F1GU, I_F1DN, I_MN, I_F2N, I_F2GU, I_F2DN, I_MLWIN, I_MLBG, I_MLHG, I_MLWOUT, I_ATQKV, I_ATQG, I_ATKG, I_ATSINK, I_ATWO,
       I_RWMIX, I_RWRKV, I_RWW0, I_RWWLA, I_RWWLB, I_RWA0, I_RWALA, I_RWALB, I_RWGLA, I_RWGLB, I_RWKK, I_RWKA, I_RWRK, I_RWLNW, I_RWLNB, I_RWWO, N_IN };
constexpr size_t MiB = 1u << 20;
constexpr size_t WS_CTL = 0, CTL_ZERO_BYTES = 1 * MiB;
constexpr size_t WS_ROPE = 2 * MiB;
constexpr size_t WS_GATES = 4 * MiB;
constexpr size_t WS_STAT = 6 * MiB;
constexpr size_t WS_MST = 6 * MiB + 65536;
constexpr size_t WS_NV = 8 * MiB;
constexpr size_t WS_ROWQ = 10 * MiB;
constexpr int CW_CMAX = 65536;
constexpr int CW_CMAX2 = 65536 + 8 * 11264;
constexpr size_t WS_CSTEP2 = 11 * MiB + 512 * 1024;
constexpr size_t WS_CSTEP = 11 * MiB;
constexpr size_t WS_WGU1 = 16 * MiB, WS_WDN1 = 60 * MiB, WS_WGU2 = 82 * MiB, WS_WDN2 = 126 * MiB, WS_WMIX = 148 * MiB;
constexpr size_t WS_XN = 192 * MiB;
constexpr size_t WS_BIG = 320 * MiB;
constexpr size_t WS_END = WS_BIG + 1152 * MiB;
constexpr int CW_BAR = 4096;

#define GAS __attribute__((address_space(1)))
#define LAS __attribute__((address_space(3)))
typedef unsigned short bf16;
typedef unsigned v4u __attribute__((ext_vector_type(4)));
typedef unsigned v2u __attribute__((ext_vector_type(2)));
typedef float f32x4 __attribute__((ext_vector_type(4)));
typedef float f32x2 __attribute__((ext_vector_type(2)));
typedef float f32x16 __attribute__((ext_vector_type(16)));
typedef short bf16x8 __attribute__((ext_vector_type(8)));
typedef short s16x4 __attribute__((ext_vector_type(4)));
#define LDS_WAIT() asm volatile("s_waitcnt lgkmcnt(0)" ::: "memory")
#define VM_WAIT() asm volatile("s_waitcnt vmcnt(0)" ::: "memory")
#define MFMA32(a, b, c) __builtin_amdgcn_mfma_f32_32x32x16_bf16((a), (b), (c), 0, 0, 0)
__device__ __forceinline__ unsigned pk2(float lo, float hi) { return pg8::cvt_pk_bf16(lo, hi); }
__device__ __forceinline__ float bf2f(unsigned short h) { return __builtin_bit_cast(float, (unsigned)h << 16); }
__device__ __forceinline__ float bflo(unsigned w) { return __builtin_bit_cast(float, w << 16); }
__device__ __forceinline__ float bfhi(unsigned w) { return __builtin_bit_cast(float, w & 0xffff0000u); }
__device__ __forceinline__ unsigned short f2bf(float f) { return (unsigned short)(pk2(f, 0.f) & 0xffffu); }
__device__ __forceinline__ float wave_sum(float v) {
#pragma unroll
    for (int o = 1; o < 64; o <<= 1) v += __shfl_xor(v, o);
    return v;
}
__device__ __forceinline__ float wave_max(float v) {
#pragma unroll
    for (int o = 1; o < 64; o <<= 1) v = fmaxf(v, __shfl_xor(v, o));
    return v;
}

template <int CTRL, int RM> __device__ __forceinline__ float dpp_upd(float x) { return __builtin_bit_cast(float, __builtin_amdgcn_update_dpp(0, __builtin_bit_cast(int, x), CTRL, RM, 0xf, false)); }
__device__ __forceinline__ float wave_sum_dpp(float x) {
    x += dpp_upd<0xB1, 0xf>(x); x += dpp_upd<0x4E, 0xf>(x); x += dpp_upd<0x141, 0xf>(x); x += dpp_upd<0x140, 0xf>(x);
    x += dpp_upd<0x142, 0xa>(x); x += dpp_upd<0x143, 0xc>(x);
    return __builtin_bit_cast(float, __builtin_amdgcn_readlane(__builtin_bit_cast(int, x), 63));
}
__device__ __forceinline__ int crow(int reg, int h) { return (reg & 3) + 8 * (reg >> 2) + 4 * h; }
#define XB_TMO      128
#define XB_XCNT(j)  (256  + 64 * (j))
#define XB_XSUB(j)  (1280 + 64 * (j))
#define XB_XGEN(j)  (2304 + 64 * (j))
#define XB_TOP      3328
#define XB_TOPGEN   3392
#define XCD_BAR_WORDS 3456
#define XB_SPIN_CAP (1u << 18)

__device__ __forceinline__ unsigned xb_ld(unsigned* p)              { return __hip_atomic_load(p, __ATOMIC_RELAXED, __HIP_MEMORY_SCOPE_AGENT); }
__device__ __forceinline__ unsigned xb_add(unsigned* p, unsigned v) { return __hip_atomic_fetch_add(p, v, __ATOMIC_RELAXED, __HIP_MEMORY_SCOPE_AGENT); }
__device__ __forceinline__ unsigned xb_xcc_id() { return (unsigned)__builtin_amdgcn_s_getreg((3 << 11) | 20) & 0xFu; }
#define XB_SPIN(cond, bar) do { unsigned _sp = 0; while (cond) { __builtin_amdgcn_s_sleep(1); \
    if ((++_sp & 255u) == 0u) { if (xb_ld(&(bar)[XB_TMO])) break; if (_sp > XB_SPIN_CAP) { atomicAdd(&(bar)[XB_TMO], 1u); break; } } } } while (0)

struct XcdBarrier {
    unsigned* bar; unsigned x;
    volatile LAS unsigned* st;
};

__device__ __forceinline__ XcdBarrier xcd_barrier_post(unsigned* bar, volatile LAS unsigned* st) {
    XcdBarrier b; b.bar = bar; b.x = xb_xcc_id(); b.st = st;
    if (threadIdx.x == 0) (void)xb_add(&bar[XB_XCNT(b.x)], 1u);
    return b;
}
__device__ __forceinline__ void xcd_barrier_complete(unsigned* bar, unsigned x, unsigned& nloc, unsigned& nx) {
    const unsigned G = gridDim.x * gridDim.y * gridDim.z;
    unsigned sum, cnt, mine, sp = 0u;
    for (;;) {
        sum = 0u; cnt = 0u; mine = 0u;
#pragma unroll
        for (unsigned j = 0; j < 16; ++j) { const unsigned c = xb_ld(&bar[XB_XCNT(j)]); sum += c; cnt += (c > 0u) ? 1u : 0u; mine = (j == x) ? c : mine; }
        if (sum == G) break;
        __builtin_amdgcn_s_sleep(1);
        if ((++sp & 255u) == 0u) { if (xb_ld(&bar[XB_TMO])) break; if (sp > XB_SPIN_CAP) { atomicAdd(&bar[XB_TMO], 1u); break; } }
    }
    nloc = mine > 0u ? mine : 1u; nx = cnt > 0u ? cnt : 1u;
}

__device__ __forceinline__ void xcd_barrier(const XcdBarrier& b) {
    asm volatile("s_waitcnt vmcnt(0)" ::: "memory");
    __syncthreads();
    if (threadIdx.x == 0) {
        unsigned* bar = b.bar;
        __builtin_amdgcn_s_waitcnt(0);
        unsigned nloc = b.st[0], nx = b.st[1];
        if (nloc == 0u) { xcd_barrier_complete(bar, b.x, nloc, nx); b.st[0] = nloc; b.st[1] = nx; }
        const unsigned old = xb_add(&bar[XB_XSUB(b.x)], 1u);
        const unsigned gen = old / nloc;
        if (old + 1u == (gen + 1u) * nloc) {
            __builtin_amdgcn_fence(__ATOMIC_RELEASE, "agent");
            asm volatile("s_waitcnt vmcnt(0)" ::: "memory");
            const unsigned og = xb_add(&bar[XB_TOP], 1u);
            const unsigned tg = og / nx;
            if (og + 1u == (tg + 1u) * nx) xb_add(&bar[XB_TOPGEN], 1u);
            else XB_SPIN(xb_ld(&bar[XB_TOPGEN]) == tg, bar);
            __builtin_amdgcn_fence(__ATOMIC_ACQUIRE, "agent");
            xb_add(&bar[XB_XGEN(b.x)], 1u);
            asm volatile("s_waitcnt vmcnt(0)" ::: "memory");
        } else {
            XB_SPIN(xb_ld(&bar[XB_XGEN(b.x)]) == gen, bar);
            __builtin_amdgcn_fence(__ATOMIC_ACQUIRE, "agent");
            asm volatile("s_waitcnt vmcnt(0)" ::: "memory");
        }
    }
    __syncthreads();
}

struct Args { const float* in[N_IN]; float* out; unsigned char* ws; int ph_lo, ph_hi; };
struct Frame { LAS unsigned char* lds; int tid, lane, wave, G, bid; };

__device__ __forceinline__ void transpose_item(const float* W, int ldw, bf16* WT, int ldt, int k0, int n0, int dst_row0, LAS float* scr, int lane) {
#pragma unroll 8
    for (int i = 0; i < 32; ++i) { const int kk = 2 * i + (lane >> 5); scr[kk * 33 + (lane & 31)] = W[(size_t)(k0 + kk) * ldw + n0 + (lane & 31)]; }
    LDS_WAIT(); asm volatile("" ::: "memory");
    const int c = lane & 7;
#pragma unroll
    for (int j = 0; j < 4; ++j) { const int n = (lane >> 3) + 8 * j; const LAS float* s = scr + (8 * c) * 33 + n;
        v4u o; o.x = pk2(s[0 * 33], s[1 * 33]); o.y = pk2(s[2 * 33], s[3 * 33]); o.z = pk2(s[4 * 33], s[5 * 33]); o.w = pk2(s[6 * 33], s[7 * 33]);
        *(v4u*)(WT + (size_t)(dst_row0 + n) * ldt + k0 + 8 * c) = o; }
    LDS_WAIT(); asm volatile("" ::: "memory");
}
__device__ __forceinline__ void transpose_item_f8(const float* W, int ldw, unsigned char* WT, int ldt, int k0, int n0, int dst_row0, LAS float* scr, int lane, float scale) {
#pragma unroll 8
    for (int i = 0; i < 32; ++i) { const int kk = 2 * i + (lane >> 5); scr[kk * 33 + (lane & 31)] = __builtin_amdgcn_fmed3f(W[(size_t)(k0 + kk) * ldw + n0 + (lane & 31)] * scale, -448.f, 448.f); }
    LDS_WAIT(); asm volatile("" ::: "memory");
    const int c = lane & 7;
#pragma unroll
    for (int j = 0; j < 4; ++j) { const int n = (lane >> 3) + 8 * j; const LAS float* s = scr + (8 * c) * 33 + n; unsigned w0 = 0u, w1 = 0u;
        w0 = __builtin_amdgcn_cvt_pk_fp8_f32(s[0 * 33], s[1 * 33], w0, false); w0 = __builtin_amdgcn_cvt_pk_fp8_f32(s[2 * 33], s[3 * 33], w0, true);
        w1 = __builtin_amdgcn_cvt_pk_fp8_f32(s[4 * 33], s[5 * 33], w1, false); w1 = __builtin_amdgcn_cvt_pk_fp8_f32(s[6 * 33], s[7 * 33], w1, true);
        *(v2u*)(WT + (size_t)(dst_row0 + n) * ldt + k0 + 8 * c) = (v2u){w0, w1}; }
    LDS_WAIT(); asm volatile("" ::: "memory");
}
__device__ __forceinline__ void colmax_pass(Frame& F, const float* W, int K, int N, int ldw, unsigned* cmax) {
    const int nit = N * (K / 128);
    for (int it = F.bid * NTHREADS + F.tid; it < nit; it += F.G * NTHREADS) { const int n = it % N, k0 = (it / N) * 128; const float* p = W + (size_t)k0 * ldw + n; float m = 0.f;
#pragma unroll 8
        for (int k = 0; k < 128; ++k) m = fmaxf(m, fabsf(p[(size_t)k * ldw]));
        atomicMax(cmax + n, __builtin_bit_cast(unsigned, m)); }
}
__device__ __forceinline__ void colmax_wide(Frame& F, const float* W, int K, int N, unsigned* cmax, int ldw = 0) {
    LAS float* red = (LAS float*)F.lds;
    const int ncb = N / 256, nit = ncb * (K / 128), pitch = ldw ? ldw : N;
    for (int it = F.bid; it < nit; it += F.G) { const int cb = it % ncb, k0 = (it / ncb) * 128 + F.wave * 16;
        const f32x4* p = (const f32x4*)(W + (size_t)k0 * pitch + cb * 256) + F.lane; f32x4 m = {0.f, 0.f, 0.f, 0.f};
#pragma unroll
        for (int k = 0; k < 16; ++k) { const f32x4 v = p[(size_t)k * (pitch / 4)]; m.x = fmaxf(m.x, fabsf(v.x)); m.y = fmaxf(m.y, fabsf(v.y)); m.z = fmaxf(m.z, fabsf(v.z)); m.w = fmaxf(m.w, fabsf(v.w)); }
        *(LAS f32x4*)(red + F.wave * 256 + 4 * F.lane) = m;
        __syncthreads();
        if (F.tid < 256) { float r = red[F.tid];
#pragma unroll
            for (int w = 1; w < 8; ++w) r = fmaxf(r, red[w * 256 + F.tid]);
            atomicMax(cmax + cb * 256 + F.tid, __builtin_bit_cast(unsigned, r)); }
        __syncthreads(); }
}
__device__ __forceinline__ unsigned pack_i8x4(float a, float b, float c, float d) {
    const int ia = (int)rintf(a), ib = (int)rintf(b), ic = (int)rintf(c), id = (int)rintf(d);
    return (unsigned)(ia & 0xff) | ((unsigned)(ib & 0xff) << 8) | ((unsigned)(ic & 0xff) << 16) | ((unsigned)(id & 0xff) << 24);
}
__device__ __forceinline__ void conv_small_i8(Frame& F, const float* W, int ldw, int col_off, int K, int Nsrc, unsigned char* WT, int rows, const unsigned* cmax, float* cstep) {
    const int gt = F.bid * NTHREADS + F.tid, NT = F.G * NTHREADS;
    for (int idx = gt; idx < rows * (K / 4); idx += NT) { const int n = idx / (K / 4), k = 4 * (idx - n * (K / 4)); unsigned w = 0u;
        if (n < Nsrc) { const float cm = fmaxf(__builtin_bit_cast(float, __hip_atomic_load(cmax + col_off + n, __ATOMIC_RELAXED, __HIP_MEMORY_SCOPE_AGENT)), 1e-30f), sc = 127.0f / cm; const float* p = W + (size_t)k * ldw + col_off + n;
            w = pack_i8x4(p[0] * sc, p[ldw] * sc, p[2 * (size_t)ldw] * sc, p[3 * (size_t)ldw] * sc); if (k == 0) cstep[col_off + n] = cm * (1.0f / 127.0f); }
        else if (k == 0) cstep[col_off + n] = 1.0f;
        *(unsigned*)(WT + (size_t)n * K + k) = w; }
}
template <int MAP>
__device__ __forceinline__ void conv_T_i8(Frame& F, const float* W, int K, int N, int ldw, unsigned char* WT, const unsigned* cmax, float* cstep) {
    LAS float* scr = (LAS float*)(F.lds + F.wave * 16384);
    const int gw = F.bid * NWAVES + F.wave, NGW = F.G * NWAVES, nblk = N / 32, nitems = (K / 64) * nblk, lane = F.lane;
    for (int it = gw; it < nitems; it += NGW) { const int n0 = 32 * (it % nblk), k0 = 64 * (it / nblk); const int jj = n0 < FF ? n0 : n0 - FF; const int dr = MAP == 1 ? (jj >> 7) * 256 + (n0 < FF ? 0 : 128) + (jj & 127) : n0;
        const float cm = fmaxf(__builtin_bit_cast(float, __hip_atomic_load(cmax + n0 + (lane & 31), __ATOMIC_RELAXED, __HIP_MEMORY_SCOPE_AGENT)), 1e-30f), scale = 127.0f / cm;
        if (k0 == 0 && lane < 32) cstep[dr + lane] = cm * (1.0f / 127.0f);
#pragma unroll 8
        for (int i = 0; i < 32; ++i) { const int kk = 2 * i + (lane >> 5); scr[kk * 33 + (lane & 31)] = W[(size_t)(k0 + kk) * ldw + n0 + (lane & 31)] * scale; }
        LDS_WAIT(); asm volatile("" ::: "memory");
        const int c = lane & 7;
#pragma unroll
        for (int j = 0; j < 4; ++j) { const int n = (lane >> 3) + 8 * j; const LAS float* s = scr + (8 * c) * 33 + n;
            *(v2u*)(WT + (size_t)(dr + n) * K + k0 + 8 * c) = (v2u){pack_i8x4(s[0 * 33], s[1 * 33], s[2 * 33], s[3 * 33]), pack_i8x4(s[4 * 33], s[5 * 33], s[6 * 33], s[7 * 33])}; }
        LDS_WAIT(); asm volatile("" ::: "memory"); }
}
template <int MAP>
__device__ __forceinline__ void conv_T_f8(Frame& F, const float* W, int K, int N, unsigned char* WT, float scale) {
    LAS float* scr = (LAS float*)(F.lds + F.wave * 16384);
    const int gw = F.bid * NWAVES + F.wave, NGW = F.G * NWAVES, nblk = N / 32, nitems = (K / 64) * nblk;
    for (int it = gw; it < nitems; it += NGW) { const int n0 = 32 * (it % nblk); int dr = n0;
        if (MAP == 1) { const int jj = n0 < FF ? n0 : n0 - FF; dr = (jj >> 7) * 256 + (n0 < FF ? 0 : 128) + (jj & 127); }
        transpose_item_f8(W, N, WT, K, 64 * (it / nblk), n0, dr, scr, F.lane, scale); }
}
template <int MAP>
__device__ __forceinline__ void conv_T(Frame& F, const float* W, int K, int Nuse, int ldw, bf16* WT, int row_off) {
    LAS float* scr = (LAS float*)(F.lds + F.wave * 16384);
    const int gw = F.bid * NWAVES + F.wave, NGW = F.G * NWAVES, nblk = Nuse / 32, nitems = (K / 64) * nblk;
    for (int it = gw; it < nitems; it += NGW) { const int kb = it / nblk, n0 = 32 * (it % nblk); int dr;
        if (MAP == 1) { const int jj = n0 < FF ? n0 : n0 - FF; dr = (jj >> 7) * 256 + (n0 < FF ? 0 : 128) + (jj & 127); } else dr = row_off + n0;
        transpose_item(W, ldw, WT, K, 64 * kb, n0, dr, scr, F.lane); }
}
__device__ __forceinline__ void conv_small(Frame& F, const float* W, int ldw, int col_off, int Ksrc, int Nsrc, bf16* WT, int rows, int cols) {
    const int gt = F.bid * NTHREADS + F.tid, NT = F.G * NTHREADS;
    for (int idx = gt; idx < rows * cols; idx += NT) { const int n = idx / cols, k = idx - n * cols; const float v = (n < Nsrc && k < Ksrc) ? W[(size_t)k * ldw + col_off + n] : 0.f; WT[idx] = f2bf(v); }
}
template <class AT_>
__device__ __forceinline__ void conv_phase(const AT_& a, Frame& F, int l, bool f8dn1, bool f8dn2, bool f8gu1, bool f8gu2, bool i8gu1, bool i8gu2, bool i8mix) {
    unsigned char* ws = a.ws;
    if (i8gu1) conv_T_i8<1>(F, a.in[I_F1GU] + (size_t)l * DM * 2 * FF, DM, 2 * FF, 2 * FF, ws + WS_WGU1, (const unsigned*)(ws + WS_CTL) + CW_CMAX + (2 * l) * 2 * FF, (float*)(ws + WS_CSTEP) + (2 * l) * 2 * FF);
    else if (f8gu1) conv_T_f8<1>(F, a.in[I_F1GU] + (size_t)l * DM * 2 * FF, DM, 2 * FF, ws + WS_WGU1, pg8::W8_SCALE);
    else conv_T<1>(F, a.in[I_F1GU] + (size_t)l * DM * 2 * FF, DM, 2 * FF, 2 * FF, (bf16*)(ws + WS_WGU1), 0);
    if (f8dn1) conv_T_f8<0>(F, a.in[I_F1DN] + (size_t)l * FF * DM, FF, DM, ws + WS_WDN1, pg8::W8_SCALE);
    else conv_T<0>(F, a.in[I_F1DN] + (size_t)l * FF * DM, FF, DM, DM, (bf16*)(ws + WS_WDN1), 0);
    if (i8gu2) conv_T_i8<1>(F, a.in[I_F2GU] + (size_t)l * DM * 2 * FF, DM, 2 * FF, 2 * FF, ws + WS_WGU2, (const unsigned*)(ws + WS_CTL) + CW_CMAX + (2 * l + 1) * 2 * FF, (float*)(ws + WS_CSTEP) + (2 * l + 1) * 2 * FF);
    else if (f8gu2) conv_T_f8<1>(F, a.in[I_F2GU] + (size_t)l * DM * 2 * FF, DM, 2 * FF, ws + WS_WGU2, pg8::W8_SCALE);
    else conv_T<1>(F, a.in[I_F2GU] + (size_t)l * DM * 2 * FF, DM, 2 * FF, 2 * FF, (bf16*)(ws + WS_WGU2), 0);
    if (f8dn2) conv_T_f8<0>(F, a.in[I_F2DN] + (size_t)l * FF * DM, FF, DM, ws + WS_WDN2, pg8::W8_SCALE);
    else conv_T<0>(F, a.in[I_F2DN] + (size_t)l * FF * DM, FF, DM, DM, (bf16*)(ws + WS_WDN2), 0);
    bf16* WA = (bf16*)(ws + WS_WMIX); bf16* WO = (bf16*)(ws + WS_WMIX + 26 * MiB);
    const int kind = l % 3, j = l / 3;
    if (kind == 0) {
        const float* win = a.in[I_MLWIN] + (size_t)j * DM * ML_INCOLS;
        if (i8mix) { const unsigned* cm = (const unsigned*)(ws + WS_CTL) + CW_CMAX2 + 6400 * l; float* cs = (float*)(ws + WS_CSTEP2) + 6400 * l;
            conv_T_i8<0>(F, win, DM, 6144, ML_INCOLS, (unsigned char*)WA, cm, cs);
            conv_small_i8(F, win, ML_INCOLS, 6144, DM, 16, (unsigned char*)WA + (size_t)6144 * DM, 256, cm, cs); }
        else { conv_T<0>(F, win, DM, 6144, ML_INCOLS, WA, 0);
        conv_small(F, win, ML_INCOLS, 6144, DM, 16, WA + (size_t)6144 * DM, 256, DM); }
        conv_T<0>(F, a.in[I_MLWOUT] + (size_t)j * DM * DM, DM, DM, DM, WO, 0);
    } else if (kind == 1) {
        if (i8mix) conv_T_i8<0>(F, a.in[I_ATQKV] + (size_t)j * DM * AT_COLS, DM, AT_COLS, AT_COLS, (unsigned char*)WA, (const unsigned*)(ws + WS_CTL) + CW_CMAX2 + 6400 * l, (float*)(ws + WS_CSTEP2) + 6400 * l);
        else conv_T<0>(F, a.in[I_ATQKV] + (size_t)j * DM * AT_COLS, DM, AT_COLS, AT_COLS, WA, 0);
        conv_T<0>(F, a.in[I_ATWO] + (size_t)j * DM * DM, DM, DM, DM, WO, 0);
    } else {
        for (int z = 0; z < 3; ++z) conv_T<0>(F, a.in[I_RWRKV] + ((size_t)j * 3 + z) * DM * DM, DM, DM, DM, WA, z * DM);
        bf16* WLA = WA + (size_t)6144 * DM;
        conv_small(F, a.in[I_RWWLA] + (size_t)j * DM * 96, 96, 0, DM, 96, WLA, 256, DM);
        conv_small(F, a.in[I_RWALA] + (size_t)j * DM * 96, 96, 0, DM, 96, WLA + (size_t)256 * DM, 256, DM);
        conv_small(F, a.in[I_RWGLA] + (size_t)j * DM * 256, 256, 0, DM, 256, WLA + (size_t)512 * DM, 256, DM);
        bf16* WLB = (bf16*)(ws + WS_WMIX + 28 * MiB);
        conv_small(F, a.in[I_RWWLB] + (size_t)j * 96 * DM, DM, 0, 96, DM, WLB, DM, 256);
        conv_small(F, a.in[I_RWALB] + (size_t)j * 96 * DM, DM, 0, 96, DM, WLB + (size_t)DM * 256, DM, 256);
        conv_small(F, a.in[I_RWGLB] + (size_t)j * 256 * DM, DM, 0, 256, DM, WLB + (size_t)2 * DM * 256, DM, 256);
        conv_T<0>(F, a.in[I_RWWO] + (size_t)j * DM * DM, DM, DM, DM, (bf16*)(ws + WS_WMIX + 32 * MiB), 0);
    }
}

template <bool SB> __device__ __forceinline__ void load_row(const void* xin, size_t row, int lane, f32x4 (&v)[8]) {
    if (SB) { typedef _Float16 h16x4_t __attribute__((ext_vector_type(4))); const h16x4_t* xr = (const h16x4_t*)((const bf16*)xin + row * DM) + lane;
#pragma unroll
        for (int q = 0; q < 8; ++q) { const h16x4_t w = xr[64 * q]; v[q] = (f32x4){(float)w[0], (float)w[1], (float)w[2], (float)w[3]}; } }
    else { const f32x4* xr = (const f32x4*)((const float*)xin + row * DM) + lane;
#pragma unroll
        for (int q = 0; q < 8; ++q) v[q] = xr[64 * q]; }
}
template <int MODE, bool SB, int F8 = 0, class AT_>
__device__ __forceinline__ void norm_phase(const AT_& a, Frame& F, const void* xin, const float* gain, int j) {
    unsigned char* ws = a.ws; const int lane = F.lane;
    const int gw = F.bid * NWAVES + F.wave, NGW = F.G * NWAVES;
    f32x4 gn[8];
#pragma unroll
    for (int q = 0; q < 8; ++q) gn[q] = *(const f32x4*)(gain + 4 * lane + 256 * q);
    if (MODE != 2) {
        bf16* xn = (bf16*)(ws + WS_XN);
        for (int row = gw; row < MTOK; row += NGW) {
            f32x4 v[8]; float ss = 0.f; load_row<SB>(xin, (size_t)row, lane, v);
#pragma unroll
            for (int q = 0; q < 8; ++q) ss += (v[q].x * v[q].x + v[q].y * v[q].y) + (v[q].z * v[q].z + v[q].w * v[q].w);
            const float rstd = 1.0f / sqrtf(wave_sum(ss) * (1.0f / DM) + NORM_EPS);
            if (F8 == 2) { unsigned* o4 = (unsigned*)((unsigned char*)xn + (size_t)row * DM) + lane; float mx = 0.f;
#pragma unroll
                for (int q = 0; q < 8; ++q) { v[q] = v[q] * rstd * gn[q]; mx = fmaxf(fmaxf(mx, fmaxf(fabsf(v[q].x), fabsf(v[q].y))), fmaxf(fabsf(v[q].z), fabsf(v[q].w))); }
                mx = fmaxf(wave_max(mx), 1e-30f); const float qs = 127.0f / mx;
#pragma unroll
                for (int q = 0; q < 8; ++q) o4[64 * q] = pack_i8x4(v[q].x * qs, v[q].y * qs, v[q].z * qs, v[q].w * qs);
                if (lane == 0) ((float*)(ws + WS_ROWQ))[row] = mx * (1.0f / 127.0f); }
            else if (F8 == 1) { unsigned* o4 = (unsigned*)((unsigned char*)xn + (size_t)row * DM) + lane;
#pragma unroll
                for (int q = 0; q < 8; ++q) { const f32x4 y = v[q] * (rstd * pg8::X8_SCALE) * gn[q]; unsigned w = 0u;
                    w = __builtin_amdgcn_cvt_pk_fp8_f32(__builtin_amdgcn_fmed3f(y.x, -448.f, 448.f), __builtin_amdgcn_fmed3f(y.y, -448.f, 448.f), w, false);
                    w = __builtin_amdgcn_cvt_pk_fp8_f32(__builtin_amdgcn_fmed3f(y.z, -448.f, 448.f), __builtin_amdgcn_fmed3f(y.w, -448.f, 448.f), w, true); o4[64 * q] = w; } }
            else { v2u* o8 = (v2u*)(xn + (size_t)row * DM) + lane;
#pragma unroll
                for (int q = 0; q < 8; ++q) { const f32x4 y = v[q] * rstd * gn[q]; v2u w; w.x = pk2(y.x, y.y); w.y = pk2(y.z, y.w); o8[64 * q] = w; } }
            if (MODE == 1 && lane < 8) {
                const int pos = ((const int*)a.in[I_POS])[row];
                const float inv_freq = powf(500000.0f, -(float)(2 * lane) / 16.0f); const float ang = (float)pos * inv_freq;
                const double rev = (double)ang * 0.15915494309189535; const float fr = (float)(rev - floor(rev));
                float* rp = (float*)(ws + WS_ROPE) + (size_t)row * 16; rp[lane] = __builtin_amdgcn_cosf(fr); rp[8 + lane] = __builtin_amdgcn_sinf(fr);
            }
        }
    } else {
        LAS float* mixs = (LAS float*)F.lds; const float* mix = a.in[I_RWMIX] + (size_t)j * 6 * DM;
        for (int i = F.tid; i < 6 * DM; i += NTHREADS) mixs[i] = mix[i];
        __syncthreads();
        bf16* xm = (bf16*)(ws + WS_BIG);
        for (int blk = gw; blk < MTOK / 16; blk += NGW) {
            const int row0 = blk * 16; f32x4 prev[8];
            if ((row0 % SEQ) == 0) {
#pragma unroll
                for (int q = 0; q < 8; ++q) prev[q] = (f32x4){0.f, 0.f, 0.f, 0.f};
            } else {
                float ss = 0.f; load_row<SB>(xin, (size_t)(row0 - 1), lane, prev);
#pragma unroll
                for (int q = 0; q < 8; ++q) ss += (prev[q].x * prev[q].x + prev[q].y * prev[q].y) + (prev[q].z * prev[q].z + prev[q].w * prev[q].w);
                const float rstd = 1.0f / sqrtf(wave_sum(ss) * (1.0f / DM) + NORM_EPS);
#pragma unroll
                for (int q = 0; q < 8; ++q) prev[q] = prev[q] * rstd * gn[q];
            }
            for (int rr = 0; rr < 16; ++rr) {
                const int row = row0 + rr; f32x4 v[8]; float ss = 0.f; load_row<SB>(xin, (size_t)row, lane, v);
#pragma unroll
                for (int q = 0; q < 8; ++q) ss += (v[q].x * v[q].x + v[q].y * v[q].y) + (v[q].z * v[q].z + v[q].w * v[q].w);
                const float rstd = 1.0f / sqrtf(wave_sum(ss) * (1.0f / DM) + NORM_EPS);
#pragma unroll
                for (int q = 0; q < 8; ++q) v[q] = v[q] * rstd * gn[q];
#pragma unroll 1
                for (int z = 0; z < 6; ++z) { v2u* o8 = (v2u*)(xm + ((size_t)z * MTOK + row) * DM) + lane;
#pragma unroll
                    for (int q = 0; q < 8; ++q) { const f32x4 mx = *(const LAS f32x4*)(mixs + z * DM + 4 * lane + 256 * q); const f32x4 y = v[q] + (prev[q] - v[q]) * mx;
                        v2u w; w.x = pk2(y.x, y.y); w.y = pk2(y.z, y.w); o8[64 * q] = w; } }
#pragma unroll
                for (int q = 0; q < 8; ++q) prev[q] = v[q];
            }
        }
    }
}
__device__ __forceinline__ float log_sigmoid(float x) { return fminf(x, 0.f) - __logf(1.0f + __expf(-fabsf(x))); }
__device__ __forceinline__ float wave_incl_scan(float v, int lane) {
#pragma unroll
    for (int o = 1; o < 64; o <<= 1) { const float n = __shfl_up(v, o); if (lane >= o) v += n; }
    return v;
}
#define WG_BAR() do { asm volatile("s_waitcnt lgkmcnt(0)" ::: "memory"); __builtin_amdgcn_s_barrier(); asm volatile("" ::: "memory"); } while (0)
template <class AT_>
__device__ __forceinline__ void mlstm_phase_ab(const AT_& a, Frame& F, int j) {
    unsigned char* ws = a.ws; const int tid = F.tid, lane = F.lane, w = F.wave, r = lane & 31, hh = lane >> 5;
    const bf16* QKVO = (const bf16*)(ws + WS_BIG); const float* GT = (const float*)(ws + WS_GATES);
    bf16* UC = (bf16*)(ws + WS_BIG + 384 * MiB); float* NV = (float*)(ws + WS_NV); float* MST = (float*)(ws + WS_MST);
    const float* bg = a.in[I_MLBG] + j * 16;
    LAS bf16* Vwt = (LAS bf16*)F.lds; LAS bf16* Kt = (LAS bf16*)(F.lds + 9216);
    LAS float* WQ = (LAS float*)(F.lds + 65536); LAS float* GS = (LAS float*)(F.lds + 65536 + 16384);
    const float kscale = 0.08838834764831845f;
    const int vb = w & 1, kb = w >> 1;
    for (int u = F.bid; u < NBATCH * ML_H * 4; u += F.G) {
        const int qd = (u >> 3) & 3, bh = (u & 7) + 8 * (u >> 5), b = bh >> 3, h = bh & 7;
        const float bgi = bg[h], bgf = bg[8 + h];
        v4u xvA, xvB, xvC, xvD, xkA0, xkA1, xkB0, xkB1, xkC0, xkC1, xkD0, xkD1;
#define MLAB_LOAD(CC, XV, XK0, XK1) do { const bf16* rowp = QKVO + (size_t)(b * SEQ + (CC) * ML_L + lane) * 6144; \
            XV = *(const v4u*)(rowp + 2048 + h * 256 + 64 * qd + 8 * w); XK0 = *(const v4u*)(rowp + 1024 + h * 128 + 8 * w); XK1 = *(const v4u*)(rowp + 1024 + h * 128 + 8 * (w + 8)); } while (0)
        MLAB_LOAD(0, xvA, xkA0, xkA1); MLAB_LOAD(1, xvB, xkB0, xkB1); MLAB_LOAD(2, xvC, xkC0, xkC1); MLAB_LOAD(3, xvD, xkD0, xkD1);
#pragma unroll
        for (int k = 0; k < 8; ++k) { const int cc = 8 * w + k; const size_t t = (size_t)(b * SEQ + cc * ML_L + lane) * 16;
            const float li = GT[t + h] + bgi; const float lf = log_sigmoid(GT[t + 8 + h] + bgf);
            const float bs = wave_incl_scan(lf, lane); const float g = __shfl(bs, 63); const float lw = g - bs + li; const float am = wave_max(lw);
            WQ[cc * 64 + lane] = __expf(lw - am);
            if (lane == 0) { GS[2 * cc] = g; GS[2 * cc + 1] = am; } }
        f32x16 Cst; float m = 0.f, nn = 0.f;
#pragma unroll
        for (int i = 0; i < 16; ++i) Cst[i] = 0.f;
        WG_BAR();
#define MLAB_CHUNK(CC, XV, XK0, XK1) do { const int c_ = (CC), it = bh * ML_NC + c_; LAS bf16* Vw = Vwt + (c_ & 1) * 14336; LAS bf16* Kk = Kt + (c_ & 1) * 14336; const LAS float* wqc = WQ + c_ * 64; \
            {   const float wsv = wqc[lane];        \
                _Pragma("unroll") for (int e = 0; e < 4; ++e) { const unsigned wd = XV[e]; Vw[(8 * w + 2 * e) * 72 + lane] = f2bf(bflo(wd) * wsv); Vw[(8 * w + 2 * e + 1) * 72 + lane] = f2bf(bfhi(wd) * wsv); } \
                _Pragma("unroll") for (int e = 0; e < 4; ++e) { const unsigned wd = XK0[e]; Kk[(8 * w + 2 * e) * 72 + lane] = f2bf(bflo(wd) * kscale); Kk[(8 * w + 2 * e + 1) * 72 + lane] = f2bf(bfhi(wd) * kscale); } \
                _Pragma("unroll") for (int e = 0; e < 4; ++e) { const unsigned wd = XK1[e]; Kk[(8 * (w + 8) + 2 * e) * 72 + lane] = f2bf(bflo(wd) * kscale); Kk[(8 * (w + 8) + 2 * e + 1) * 72 + lane] = f2bf(bfhi(wd) * kscale); } } \
            WG_BAR(); \
            if (c_ + 4 < ML_NC) MLAB_LOAD(c_ + 4, XV, XK0, XK1); \
            const float g = GS[2 * c_], am = GS[2 * c_ + 1]; \
            float uu = 0.f; \
            if (tid < 128) { \
                _Pragma("unroll") for (int s8 = 0; s8 < 8; ++s8) { const v4u kk = *(const LAS v4u*)(Kk + tid * 72 + 8 * s8); const f32x4 wa = *(const LAS f32x4*)(wqc + 8 * s8), wb = *(const LAS f32x4*)(wqc + 8 * s8 + 4); \
                    uu += (bflo(kk.x) * wa.x + bfhi(kk.x) * wa.y) + (bflo(kk.y) * wa.z + bfhi(kk.y) * wa.w) + (bflo(kk.z) * wb.x + bfhi(kk.z) * wb.y) + (bflo(kk.w) * wb.z + bfhi(kk.w) * wb.w); } } \
            f32x16 acc; \
            _Pragma("unroll") for (int i = 0; i < 16; ++i) acc[i] = 0.f; \
            _Pragma("unroll") for (int ks = 0; ks < 4; ++ks) { const bf16x8 af = *(const LAS bf16x8*)(Vw + (32 * vb + r) * 72 + 16 * ks + 8 * hh); const bf16x8 bfr = *(const LAS bf16x8*)(Kk + (32 * kb + r) * 72 + 16 * ks + 8 * hh); \
                acc = MFMA32(bfr, af, acc); }        \
            bf16* Uo = UC + (size_t)it * 32768 + (size_t)(64 * qd + 32 * vb + r) * 128 + 32 * kb + 4 * hh;        \
            _Pragma("unroll") for (int g4 = 0; g4 < 4; ++g4) { v2u o; o.x = pk2(Cst[4 * g4], Cst[4 * g4 + 1]); o.y = pk2(Cst[4 * g4 + 2], Cst[4 * g4 + 3]); *(v2u*)(Uo + 8 * g4) = o; } \
            if (qd == 0) { if (tid < 128) NV[(size_t)it * 128 + tid] = nn; if (tid == 0) MST[it] = m; } \
            const float mn = fmaxf(g + m, am), dec = __expf(g + m - mn), sc = __expf(am - mn); \
            _Pragma("unroll") for (int i = 0; i < 16; ++i) Cst[i] = dec * Cst[i] + sc * acc[i]; \
            nn = dec * nn + sc * uu; m = mn; } while (0)
        for (int c = 0; c < ML_NC; c += 4) { MLAB_CHUNK(c, xvA, xkA0, xkA1); MLAB_CHUNK(c + 1, xvB, xkB0, xkB1); MLAB_CHUNK(c + 2, xvC, xkC0, xkC1); MLAB_CHUNK(c + 3, xvD, xkD0, xkD1); }
        WG_BAR();
#undef MLAB_CHUNK
#undef MLAB_LOAD
    }
}
template <class AT_>
__device__ __forceinline__ void mlstm_phase_c(const AT_& a, Frame& F, int j) {
    unsigned char* ws = a.ws; const int tid = F.tid, lane = F.lane, w = F.wave, r = lane & 31, hh = lane >> 5;
    const bf16* QKVO = (const bf16*)(ws + WS_BIG); const float* GT = (const float*)(ws + WS_GATES);
    const bf16* UC = (const bf16*)(ws + WS_BIG + 384 * MiB); const float* NV = (const float*)(ws + WS_NV); const float* MST = (const float*)(ws + WS_MST);
    bf16* HS = (bf16*)(ws + WS_XN);
    const float* bg = a.in[I_MLBG] + j * 16; const float* hgain = a.in[I_MLHG] + (size_t)j * ML_H * ML_DV;
    LAS float* bb = (LAS float*)F.lds; LAS float* lis = bb + 64; LAS float* nvs = bb + 128;
    LAS bf16* Qs = (LAS bf16*)(F.lds + 1024); LAS bf16* Ks = (LAS bf16*)(F.lds + 1024 + 17408); LAS bf16* Vt = (LAS bf16*)(F.lds + 1024 + 34816);
    LAS float* hbuf = (LAS float*)(F.lds + 1024);
    const float kscale = 0.08838834764831845f;
    const int qb2 = w >> 2, dq = w & 3;
    for (int it = F.bid; it < ML_ITEMS; it += F.G) {
        const int b = it >> 9, h = (it >> 6) & 7, c = it & 63, tok0 = b * SEQ + c * ML_L;
        v4u xq[2], xk[2], xv[4];
#pragma unroll
        for (int i = 0; i < 2; ++i) { const int q = tid + 512 * i, s = q >> 4, c8 = q & 15; const bf16* rowp = QKVO + (size_t)(tok0 + s) * 6144 + h * 128 + 8 * c8; xq[i] = *(const v4u*)rowp; xk[i] = *(const v4u*)(rowp + 1024); }
        {   const bf16* rowp = QKVO + (size_t)(tok0 + lane) * 6144 + 2048 + h * 256;
#pragma unroll
            for (int i = 0; i < 4; ++i) xv[i] = *(const v4u*)(rowp + 8 * (w + 8 * i)); }
        const bf16* Cg = UC + (size_t)it * 32768;
        bf16x8 cfr[8][2];
#pragma unroll
        for (int s = 0; s < 8; ++s)
#pragma unroll
            for (int db = 0; db < 2; ++db) cfr[s][db] = *(const bf16x8*)(Cg + (64 * dq + 32 * db + r) * 128 + 16 * s + 8 * hh);
        v2u ogw[8];
#pragma unroll
        for (int i = 0; i < 8; ++i) ogw[i] = *(const v2u*)(QKVO + (size_t)(tok0 + 8 * w + i) * 6144 + 4096 + h * 256 + 4 * lane);
        if (w == 0) {
            const float li = GT[(size_t)(tok0 + lane) * 16 + h] + bg[h]; const float lf = log_sigmoid(GT[(size_t)(tok0 + lane) * 16 + 8 + h] + bg[8 + h]);
            bb[lane] = wave_incl_scan(lf, lane); lis[lane] = li;
        }
        if (tid < 128) nvs[tid] = NV[(size_t)it * 128 + tid];
#pragma unroll
        for (int i = 0; i < 2; ++i) { const int q = tid + 512 * i, s = q >> 4, c8 = q & 15;
            *(LAS v4u*)(Qs + s * 136 + 8 * c8) = xq[i];
            const v4u x = xk[i]; v4u y;
#pragma unroll
            for (int e = 0; e < 4; ++e) y[e] = pk2(bflo(x[e]) * kscale, bfhi(x[e]) * kscale);
            *(LAS v4u*)(Ks + s * 136 + 8 * c8) = y; }
        {
#pragma unroll
            for (int i = 0; i < 4; ++i) { const int c8 = w + 8 * i; const v4u x = xv[i];
#pragma unroll
                for (int e = 0; e < 4; ++e) { Vt[(8 * c8 + 2 * e) * 72 + lane] = (bf16)(x[e] & 0xffffu); Vt[(8 * c8 + 2 * e + 1) * 72 + lane] = (bf16)(x[e] >> 16); } } }
        const float mst = MST[it];
        __syncthreads();
        const int t = 32 * qb2 + r; const float bt = bb[t];
        bf16x8 Qf[8];
#pragma unroll
        for (int s = 0; s < 8; ++s) Qf[s] = *(const LAS bf16x8*)(Qs + t * 136 + 16 * s + 8 * hh);
        f32x16 accs[2];
#pragma unroll
        for (int kb = 0; kb < 2; ++kb)
#pragma unroll
            for (int i = 0; i < 16; ++i) accs[kb][i] = 0.f;
#pragma unroll
        for (int kb = 0; kb < 2; ++kb) if (kb <= qb2) {
#pragma unroll
            for (int s = 0; s < 8; ++s) { const bf16x8 kf = *(const LAS bf16x8*)(Ks + (32 * kb + r) * 136 + 16 * s + 8 * hh); accs[kb] = MFMA32(kf, Qf[s], accs[kb]); } }
        float mi = -INFINITY;
#pragma unroll
        for (int kb = 0; kb < 2; ++kb) if (kb <= qb2) {
#pragma unroll
            for (int i = 0; i < 16; ++i) { const int sp = 32 * kb + crow(i, hh); const float ld = bt - bb[sp] + lis[sp]; mi = fmaxf(mi, sp <= t ? ld : -INFINITY); } }
        mi = fmaxf(mi, __shfl_xor(mi, 32));
        const float mout = fmaxf(bt + mst, mi); float den = 0.f;
#pragma unroll
        for (int kb = 0; kb < 2; ++kb) if (kb <= qb2) {
#pragma unroll
            for (int i = 0; i < 16; ++i) { const int sp = 32 * kb + crow(i, hh); const float ex = __expf(bt - bb[sp] + lis[sp] - mout); const float d = (sp <= t) ? ex : 0.f; const float sv = accs[kb][i] * d; accs[kb][i] = sv; den += sv; } }
        den += __shfl_xor(den, 32);
        const float winter = __expf(bt + mst - mout);
        f32x16 accn[2];
#pragma unroll
        for (int db = 0; db < 2; ++db)
#pragma unroll
            for (int i = 0; i < 16; ++i) accn[db][i] = 0.f;
#pragma unroll
        for (int s = 0; s < 8; ++s)
#pragma unroll
            for (int db = 0; db < 2; ++db) accn[db] = MFMA32(cfr[s][db], Qf[s], accn[db]);
#pragma unroll
        for (int db = 0; db < 2; ++db)
#pragma unroll
            for (int i = 0; i < 16; ++i) accn[db][i] *= winter;
#pragma unroll
        for (int kb = 0; kb < 2; ++kb) if (kb <= qb2) {
#pragma unroll
            for (int s2 = 0; s2 < 2; ++s2) {
                v4u pw;
#pragma unroll
                for (int e = 0; e < 4; ++e) pw[e] = pk2(accs[kb][8 * s2 + 2 * e], accs[kb][8 * s2 + 2 * e + 1]);
                const bf16x8 pf = __builtin_bit_cast(bf16x8, pw);
#pragma unroll
                for (int db = 0; db < 2; ++db) { const LAS bf16* vp = Vt + (64 * dq + 32 * db + r) * 72 + 32 * kb + 16 * s2 + 4 * hh;
                    const v2u lo = *(const LAS v2u*)vp, hi = *(const LAS v2u*)(vp + 8); v4u vw; vw.x = lo.x; vw.y = lo.y; vw.z = hi.x; vw.w = hi.y;
                    accn[db] = MFMA32(__builtin_bit_cast(bf16x8, vw), pf, accn[db]); } } }
        float dn = 0.f;
#pragma unroll
        for (int s0 = 0; s0 < 8; s0 += 4) { f32x4 nva[4], nvb[4];
#pragma unroll
            for (int s = 0; s < 4; ++s) { nva[s] = *(const LAS f32x4*)(nvs + 16 * (s0 + s) + 8 * hh); nvb[s] = *(const LAS f32x4*)(nvs + 16 * (s0 + s) + 8 * hh + 4); }
#pragma unroll
            for (int s = 0; s < 4; ++s) { const v4u qw = __builtin_bit_cast(v4u, Qf[s0 + s]);
                dn += (bflo(qw[0]) * nva[s].x + bfhi(qw[0]) * nva[s].y) + (bflo(qw[1]) * nva[s].z + bfhi(qw[1]) * nva[s].w) + (bflo(qw[2]) * nvb[s].x + bfhi(qw[2]) * nvb[s].y) + (bflo(qw[3]) * nvb[s].z + bfhi(qw[3]) * nvb[s].w); } }
        dn += __shfl_xor(dn, 32);
        den += winter * dn;
        const float inv = 1.0f / fmaxf(fabsf(den), __expf(-mout));
        __syncthreads();
#pragma unroll
        for (int db = 0; db < 2; ++db)
#pragma unroll
            for (int g4 = 0; g4 < 4; ++g4) { f32x4 o; o.x = accn[db][4 * g4] * inv; o.y = accn[db][4 * g4 + 1] * inv; o.z = accn[db][4 * g4 + 2] * inv; o.w = accn[db][4 * g4 + 3] * inv;
                *(LAS f32x4*)(hbuf + t * 260 + 64 * dq + 32 * db + 8 * g4 + 4 * hh) = o; }
        __syncthreads();
        const f32x4 gn = *(const f32x4*)(hgain + h * ML_DV + 4 * lane);
#pragma unroll
        for (int i = 0; i < 8; ++i) { const int tt = 8 * w + i; const f32x4 v = *(const LAS f32x4*)(hbuf + tt * 260 + 4 * lane);
            const float ss = wave_sum((v.x * v.x + v.y * v.y) + (v.z * v.z + v.w * v.w)); const float rstd = 1.0f / sqrtf(ss * (1.0f / ML_DV) + NORM_EPS);
            const v2u ow = ogw[i];
            f32x4 y = v * rstd * gn; y.x *= pg8::fast_sigmoid(bflo(ow.x)); y.y *= pg8::fast_sigmoid(bfhi(ow.x)); y.z *= pg8::fast_sigmoid(bflo(ow.y)); y.w *= pg8::fast_sigmoid(bfhi(ow.y));
            v2u o; o.x = pk2(y.x, y.y); o.y = pk2(y.z, y.w);
            *(v2u*)(HS + (size_t)(tok0 + tt) * DM + h * 256 + 4 * lane) = o; }
        __syncthreads();
    }
}
template <class AT_>
__device__ __forceinline__ void attn_phase(const AT_& a, Frame& F, int j) {
    unsigned char* ws = a.ws; const int tid = F.tid, lane = F.lane, w = F.wave, r = lane & 31, hh = lane >> 5;
    const bf16* QKV = (const bf16*)(ws + WS_BIG); const float* ROPE = (const float*)(ws + WS_ROPE); bf16* O = (bf16*)(ws + WS_XN);
    const float* qg = a.in[I_ATQG] + j * 64; const float* kg = a.in[I_ATKG] + j * 64; const float* sinks = a.in[I_ATSINK] + j * 32;
    LAS bf16* Ks = (LAS bf16*)F.lds; LAS bf16* Vt = (LAS bf16*)(F.lds + 36864);
    for (int u = F.bid; u < AT_UNITS; u += F.G) {
        const int b = u >> 7, qb = (u >> 2) & 31, hk = u & 3, tok0 = b * SEQ + qb * AT_BLK, kt0 = tok0 - AT_BLK;
        if (tid < 256) {
            const int J = tid; const bool valid = (qb > 0) || (J >= AT_BLK);
            float v[64];
            if (valid) {
                const v4u* rp = (const v4u*)(QKV + (size_t)(kt0 + J) * AT_COLS + 2048 + hk * 64); float ss = 0.f;
#pragma unroll
                for (int q = 0; q < 8; ++q) { const v4u x = rp[q];
#pragma unroll
                    for (int e = 0; e < 4; ++e) { v[8 * q + 2 * e] = bflo(x[e]); v[8 * q + 2 * e + 1] = bfhi(x[e]); } }
#pragma unroll
                for (int d = 0; d < 64; ++d) ss += v[d] * v[d];
                const float rstd = 1.0f / sqrtf(ss * (1.0f / 64.0f) + NORM_EPS);
#pragma unroll
                for (int d = 0; d < 64; ++d) v[d] = v[d] * rstd * kg[d];
                const float* rp2 = ROPE + (size_t)(kt0 + J) * 16;
#pragma unroll
                for (int i = 0; i < 8; ++i) { const float cs = rp2[i], sn = rp2[8 + i], x1 = v[i], x2 = v[8 + i]; v[i] = x1 * cs - x2 * sn; v[8 + i] = x2 * cs + x1 * sn; }
            } else {
#pragma unroll
                for (int d = 0; d < 64; ++d) v[d] = 0.f;
            }
#pragma unroll
            for (int q = 0; q < 8; ++q) { v4u y;
#pragma unroll
                for (int e = 0; e < 4; ++e) y[e] = pk2(v[8 * q + 2 * e], v[8 * q + 2 * e + 1]);
                *(LAS v4u*)(Ks + J * 72 + 8 * q) = y; }
        } else {
            const int J = tid - 256; const bool valid = (qb > 0) || (J >= AT_BLK);
            const v4u* rp = (const v4u*)(QKV + (size_t)(valid ? kt0 + J : tok0) * AT_COLS + 2304 + hk * 64);
            v4u xr[8];
#pragma unroll
            for (int q = 0; q < 8; ++q) xr[q] = rp[q];
#pragma unroll
            for (int q = 0; q < 8; ++q) { const v4u x = valid ? xr[q] : (v4u){0u, 0u, 0u, 0u};
#pragma unroll
                for (int e = 0; e < 4; ++e) { Vt[(8 * q + 2 * e) * 264 + J] = (bf16)(x[e] & 0xffffu); Vt[(8 * q + 2 * e + 1) * 264 + J] = (bf16)(x[e] >> 16); } }
        }
        __syncthreads();
        const int hq = hk * 8 + w; const float sink = sinks[hq];
        for (int qi = 0; qi < 4; ++qi) {
            const int I = 32 * qi + r, tq = tok0 + I;
            float qv[4][8]; float ss = 0.f;
#pragma unroll
            for (int s = 0; s < 4; ++s) { const v4u x = *(const v4u*)(QKV + (size_t)tq * AT_COLS + hq * 64 + 16 * s + 8 * hh);
#pragma unroll
                for (int e = 0; e < 4; ++e) { qv[s][2 * e] = bflo(x[e]); qv[s][2 * e + 1] = bfhi(x[e]); } }
#pragma unroll
            for (int s = 0; s < 4; ++s)
#pragma unroll
                for (int e = 0; e < 8; ++e) ss += qv[s][e] * qv[s][e];
            ss += __shfl_xor(ss, 32);
            const float rstd = 0.125f / sqrtf(ss * (1.0f / 64.0f) + NORM_EPS);
#pragma unroll
            for (int s = 0; s < 4; ++s)
#pragma unroll
                for (int e = 0; e < 8; ++e) qv[s][e] = qv[s][e] * rstd * qg[16 * s + 8 * hh + e];
            {   const float* rp2 = ROPE + (size_t)tq * 16;
#pragma unroll
                for (int e = 0; e < 8; ++e) { const float mine = qv[0][e], other = __shfl_xor(mine, 32), cs = rp2[e], sn = rp2[8 + e];
                    qv[0][e] = (hh == 0) ? (mine * cs - other * sn) : (mine * cs + other * sn); } }
            bf16x8 Qf[4];
#pragma unroll
            for (int s = 0; s < 4; ++s) { v4u y;
#pragma unroll
                for (int e = 0; e < 4; ++e) y[e] = pk2(qv[s][2 * e], qv[s][2 * e + 1]);
                Qf[s] = __builtin_bit_cast(bf16x8, y); }
            f32x16 accs[5];
#pragma unroll
            for (int c = 0; c < 5; ++c) {
#pragma unroll
                for (int i = 0; i < 16; ++i) accs[c][i] = 0.f;
                const int kj = qi + c;
#pragma unroll
                for (int s = 0; s < 4; ++s) { const bf16x8 kf = *(const LAS bf16x8*)(Ks + (32 * kj + r) * 72 + 16 * s + 8 * hh); accs[c] = MFMA32(kf, Qf[s], accs[c]); } }
            float mx = sink;
#pragma unroll
            for (int c = 0; c < 5; ++c)
#pragma unroll
                for (int i = 0; i < 16; ++i) { const int J = 32 * (qi + c) + crow(i, hh); const bool ok = (J > I) && (J <= I + AT_BLK) && (qb > 0 || J >= AT_BLK); if (ok) mx = fmaxf(mx, accs[c][i]); }
            mx = fmaxf(mx, __shfl_xor(mx, 32));
            float sum = 0.f;
#pragma unroll
            for (int c = 0; c < 5; ++c)
#pragma unroll
                for (int i = 0; i < 16; ++i) { const int J = 32 * (qi + c) + crow(i, hh); const bool ok = (J > I) && (J <= I + AT_BLK) && (qb > 0 || J >= AT_BLK);
                    const float p = ok ? __expf(accs[c][i] - mx) : 0.f; accs[c][i] = p; sum += p; }
            sum += __shfl_xor(sum, 32);
            const float inv = 1.0f / (sum + __expf(sink - mx));
            f32x16 acco[2];
#pragma unroll
            for (int db = 0; db < 2; ++db)
#pragma unroll
                for (int i = 0; i < 16; ++i) acco[db][i] = 0.f;
#pragma unroll
            for (int c = 0; c < 5; ++c)
#pragma unroll
                for (int s2 = 0; s2 < 2; ++s2) { v4u pw;
#pragma unroll
                    for (int e = 0; e < 4; ++e) pw[e] = pk2(accs[c][8 * s2 + 2 * e], accs[c][8 * s2 + 2 * e + 1]);
                    const bf16x8 pf = __builtin_bit_cast(bf16x8, pw);
#pragma unroll
                    for (int db = 0; db < 2; ++db) { const LAS bf16* vp = Vt + (32 * db + r) * 264 + 32 * (qi + c) + 16 * s2 + 4 * hh;
                        const v2u lo = *(const LAS v2u*)vp, hi = *(const LAS v2u*)(vp + 8); v4u vw; vw.x = lo.x; vw.y = lo.y; vw.z = hi.x; vw.w = hi.y;
                        acco[db] = MFMA32(__builtin_bit_cast(bf16x8, vw), pf, acco[db]); } }
            bf16* orow = O + (size_t)tq * DM + hq * 64;
#pragma unroll
            for (int db = 0; db < 2; ++db)
#pragma unroll
                for (int g4 = 0; g4 < 4; ++g4) { v2u o; o.x = pk2(acco[db][4 * g4] * inv, acco[db][4 * g4 + 1] * inv); o.y = pk2(acco[db][4 * g4 + 2] * inv, acco[db][4 * g4 + 3] * inv);
                    *(v2u*)(orow + 32 * db + 8 * g4 + 4 * hh) = o; }
        }
        __syncthreads();
    }
}

template <int CTRL> __device__ __forceinline__ float dpp_f(float x) { return __builtin_bit_cast(float, __builtin_amdgcn_mov_dpp(__builtin_bit_cast(int, x), CTRL, 0xf, 0xf, true)); }
__device__ __forceinline__ float row8_allsum(float x) { x += dpp_f<0xB1>(x); x += dpp_f<0x4E>(x); x += dpp_f<0x141>(x); return x; }
struct RwOps { f32x4 a0, a1, r0, r1, w0, w1, b0, b1, k0, k1; f32x2 v, sc; };
template <class AT_>
__device__ __forceinline__ void rwkv_scan_phase(const AT_& a, Frame& F, int j) {
    unsigned char* ws = a.ws; const int lane = F.lane, w = F.wave;
    const bf16* RKV = (const bf16*)(ws + WS_BIG + 768 * MiB); const float* DEC = (const float*)(ws + WS_BIG);
    const bf16* AG = (const bf16*)(ws + WS_BIG + 256 * MiB); const bf16* GG = (const bf16*)(ws + WS_BIG + 384 * MiB); bf16* YG = (bf16*)(ws + WS_XN);
    const float* k_k = a.in[I_RWKK] + (size_t)j * DM; const float* k_a = a.in[I_RWKA] + (size_t)j * DM; const float* r_k = a.in[I_RWRK] + (size_t)j * DM;
    const float* ln_w = a.in[I_RWLNW] + (size_t)j * DM; const float* ln_b = a.in[I_RWLNB] + (size_t)j * DM;
    constexpr int OPB = 6 * RW_T * 64 * 4 + RW_T * 16;
    LAS float* Ybase = (LAS float*)(F.lds + 2 * OPB);
    const int vg = lane >> 3, kg = lane & 7, v0 = 16 * (w & 3) + 2 * vg;
    for (int bh = F.bid; bh < NBATCH * RW_H; bh += F.G) {
        const int b = bh >> 5, h = bh & 31, col = h * 64 + lane; const size_t tokb = (size_t)b * SEQ;
        const float kkc = k_k[col], kac = k_a[col], rkc = r_k[col], lnw = ln_w[col], lnb = ln_b[col];
        f32x2 S0[4], S1[4];
#pragma unroll
        for (int i = 0; i < 4; ++i) { S0[i] = (f32x2){0.f, 0.f}; S1[i] = (f32x2){0.f, 0.f}; }
        for (int blk = -1; blk <= RW_NBLK; ++blk) {
            if (w < 4) {
                if (blk >= 0 && blk < RW_NBLK) {
                    const LAS float* ob = (const LAS float*)(F.lds + (blk & 1) * OPB); LAS float* Yb = Ybase + (blk & 1) * (RW_T * 64);
                    auto ld = [&](int t) { RwOps o; const LAS float* p = ob + t * 64 + 8 * kg;
                        o.a0 = *(const LAS f32x4*)p; o.a1 = *(const LAS f32x4*)(p + 4); p += RW_T * 64; o.r0 = *(const LAS f32x4*)p; o.r1 = *(const LAS f32x4*)(p + 4); p += RW_T * 64;
                        o.w0 = *(const LAS f32x4*)p; o.w1 = *(const LAS f32x4*)(p + 4); p += RW_T * 64; o.b0 = *(const LAS f32x4*)p; o.b1 = *(const LAS f32x4*)(p + 4); p += RW_T * 64;
                        o.k0 = *(const LAS f32x4*)p; o.k1 = *(const LAS f32x4*)(p + 4);
                        o.v = *(const LAS f32x2*)(ob + 5 * RW_T * 64 + t * 64 + v0); o.sc = *(const LAS f32x2*)(ob + 6 * RW_T * 64 + t * 4); return o; };
                    auto step = [&](const RwOps& cur, int t) {
                        const f32x2 a01 = {cur.a0.x, cur.a0.y}, a23 = {cur.a0.z, cur.a0.w}, a45 = {cur.a1.x, cur.a1.y}, a67 = {cur.a1.z, cur.a1.w};
                        const f32x2 r01 = {cur.r0.x, cur.r0.y}, r23 = {cur.r0.z, cur.r0.w}, r45 = {cur.r1.x, cur.r1.y}, r67 = {cur.r1.z, cur.r1.w};
                        f32x2 sA0 = S0[0] * a01, sA1 = S1[0] * a01, sY0 = S0[0] * r01, sY1 = S1[0] * r01;
                        sA0 = S0[1] * a23 + sA0; sA1 = S1[1] * a23 + sA1; sY0 = S0[1] * r23 + sY0; sY1 = S1[1] * r23 + sY1;
                        sA0 = S0[2] * a45 + sA0; sA1 = S1[2] * a45 + sA1; sY0 = S0[2] * r45 + sY0; sY1 = S1[2] * r45 + sY1;
                        sA0 = S0[3] * a67 + sA0; sA1 = S1[3] * a67 + sA1; sY0 = S0[3] * r67 + sY0; sY1 = S1[3] * r67 + sY1;
                        const float sa0 = row8_allsum(sA0.x + sA0.y), sa1 = row8_allsum(sA1.x + sA1.y), yy0 = row8_allsum(sY0.x + sY0.y), yy1 = row8_allsum(sY1.x + sY1.y);
                        if (kg == 0) { f32x2 yo; yo.x = yy0 + sa0 * cur.sc.x + cur.v.x * cur.sc.y; yo.y = yy1 + sa1 * cur.sc.x + cur.v.y * cur.sc.y; *(LAS f32x2*)(Yb + t * 64 + v0) = yo; }
                        const f32x2 w01 = {cur.w0.x, cur.w0.y}, w23 = {cur.w0.z, cur.w0.w}, w45 = {cur.w1.x, cur.w1.y}, w67 = {cur.w1.z, cur.w1.w};
                        const f32x2 b01 = {cur.b0.x, cur.b0.y}, b23 = {cur.b0.z, cur.b0.w}, b45 = {cur.b1.x, cur.b1.y}, b67 = {cur.b1.z, cur.b1.w};
                        const f32x2 k01 = {cur.k0.x, cur.k0.y}, k23 = {cur.k0.z, cur.k0.w}, k45 = {cur.k1.x, cur.k1.y}, k67 = {cur.k1.z, cur.k1.w};
                        const f32x2 s0 = {sa0, sa0}, s1 = {sa1, sa1}, x0 = {cur.v.x, cur.v.x}, x1 = {cur.v.y, cur.v.y};
                        S0[0] = S0[0] * w01 + (s0 * b01 + x0 * k01); S0[1] = S0[1] * w23 + (s0 * b23 + x0 * k23); S0[2] = S0[2] * w45 + (s0 * b45 + x0 * k45); S0[3] = S0[3] * w67 + (s0 * b67 + x0 * k67);
                        S1[0] = S1[0] * w01 + (s1 * b01 + x1 * k01); S1[1] = S1[1] * w23 + (s1 * b23 + x1 * k23); S1[2] = S1[2] * w45 + (s1 * b45 + x1 * k45); S1[3] = S1[3] * w67 + (s1 * b67 + x1 * k67);
                    };
                    RwOps oa = ld(0);
                    for (int t = 0; t < RW_T; t += 2) {
                        const RwOps ob2 = ld(t + 1);
                        step(oa, t);
                        oa = ld(t + 2 < RW_T ? t + 2 : t + 1);
                        step(ob2, t + 1);
                    }
                }
            } else {
                const int tw = w - 4; const bool do_post = blk >= 1, do_prep = blk + 1 < RW_NBLK;
                float pr[8], pk[8], pv[8], pd[8], pa[8], pg[8];
#pragma unroll
                for (int i = 0; i < 8; ++i) { pr[i] = 0.f; pk[i] = 0.f; pv[i] = 0.f; pd[i] = 0.f; pa[i] = 0.f; pg[i] = 0.f; }
                if (do_prep) {
#pragma unroll
                    for (int i = 0; i < 8; ++i) { const size_t off = (tokb + (size_t)(blk + 1) * RW_T + tw + 4 * i) * DM + col;
                        pr[i] = bf2f(RKV[off]); pk[i] = bf2f(RKV[(size_t)MTOK * DM + off]); pv[i] = bf2f(RKV[(size_t)2 * MTOK * DM + off]); pd[i] = DEC[off]; pa[i] = bf2f(AG[off]); } }
                if (do_post) {
#pragma unroll
                    for (int i = 0; i < 8; ++i) pg[i] = bf2f(GG[(tokb + (size_t)(blk - 1) * RW_T + tw + 4 * i) * DM + col]); }
                if (do_post) {
                    const int pb = blk - 1; const LAS float* ob = (const LAS float*)(F.lds + (pb & 1) * OPB); const LAS float* Yb = Ybase + (pb & 1) * (RW_T * 64);
#pragma unroll
                    for (int i = 0; i < 8; ++i) { const int t = tw + 4 * i; const size_t tok = tokb + (size_t)pb * RW_T + t;
                        const float y = Yb[t * 64 + lane], vv = ob[5 * RW_T * 64 + t * 64 + lane], bon = ob[6 * RW_T * 64 + t * 4 + 2];
                        const float mu = wave_sum_dpp(y) * (1.0f / 64.0f), dlt = y - mu, var = wave_sum_dpp(dlt * dlt) * (1.0f / 64.0f);
                        const float yn = dlt * __builtin_amdgcn_rsqf(var + RW_LN_EPS) * lnw + lnb + bon * vv;
                        YG[tok * DM + col] = f2bf(yn * pg[i]); }
                }
                if (do_prep) {
                    LAS float* ob = (LAS float*)(F.lds + ((blk + 1) & 1) * OPB);
#pragma unroll
                    for (int i = 0; i < 8; ++i) { const int t = tw + 4 * i; const float rr = pr[i], kk0 = pk[i], vv = pv[i];
                        const float dec = __expf(-0.6065306597f * pg8::fast_sigmoid(pd[i])), ag = pg8::fast_sigmoid(pa[i]);
                        float kkv = kk0 * kkc; kkv = kkv * __builtin_amdgcn_rsqf(fmaxf(wave_sum_dpp(kkv * kkv), 1e-24f));
                        const float kp = kk0 * (1.0f + (ag - 1.0f) * kac); const float bv = kkv * ag;
                        ob[t * 64 + lane] = -kkv; ob[RW_T * 64 + t * 64 + lane] = dec * rr; ob[2 * RW_T * 64 + t * 64 + lane] = dec;
                        ob[3 * RW_T * 64 + t * 64 + lane] = bv; ob[4 * RW_T * 64 + t * 64 + lane] = kp; ob[5 * RW_T * 64 + t * 64 + lane] = vv;
                        const float br = wave_sum_dpp(bv * rr), kr = wave_sum_dpp(kp * rr), bon = wave_sum_dpp(rr * kp * rkc);
                        if (lane == 0) { ob[6 * RW_T * 64 + t * 4] = br; ob[6 * RW_T * 64 + t * 4 + 1] = kr; ob[6 * RW_T * 64 + t * 4 + 2] = bon; } }
                }
            }
            __syncthreads();
        }
    }
}
constexpr int RING_BYTES = 131072, MISC_OFF = RING_BYTES + 320, LDS_BYTES = 147456;
#ifndef MK_PER_PHASE
#define MK_PER_PHASE 0
#endif
constexpr int N_PHASES_MAX = 64;
#ifndef REP_CONV
#define REP_CONV 1
#endif
#ifndef REP_NORM
#define REP_NORM 1
#endif
#ifndef REP_GU
#define REP_GU 1
#endif
#ifndef REP_MIXG
#define REP_MIXG 1
#endif
#ifndef REP_MLA
#define REP_MLA 1
#endif
#ifndef REP_MLC
#define REP_MLC 1
#endif
#ifndef REP_ATTN
#define REP_ATTN 1
#endif
#ifndef REP_SCAN
#define REP_SCAN 1
#endif
template <int N> __device__ __forceinline__ int nrep() { if (N == 1) return 1; int v = N; asm volatile("" : "+s"(v)); return v; }
#define PH_REP(N) for (int rep_ = 0, nrep_ = nrep<N>(); rep_ < nrep_; ++rep_)
typedef const __attribute__((address_space(4))) Args CArgs;
__device__ __forceinline__ CArgs* kargs() { CArgs* p = (CArgs*)__builtin_amdgcn_kernarg_segment_ptr(); asm volatile("" : "+s"(p)); return p; }
struct Ctx { XcdBarrier bar; int lo, hi; };
#define PH_BEGIN if (ph >= C.lo && ph < C.hi) { CArgs& a = *kargs(); unsigned char* ws = a.ws; Frame F; { int t_ = threadIdx.x, g_ = gridDim.x, b_ = blockIdx.x; asm volatile("" : "+v"(t_), "+s"(g_), "+s"(b_)); \
                 unsigned lb_ = 0u; asm volatile("" : "+s"(lb_)); F.lds = (LAS unsigned char*)(size_t)lb_ + (size_t)(LAS unsigned char*)lds_raw; F.tid = t_; F.lane = t_ & 63; F.wave = __builtin_amdgcn_readfirstlane(t_ >> 6); F.G = g_; F.bid = b_; } \
                 bf16* XN = (bf16*)(ws + WS_XN); bf16* BIG = (bf16*)(ws + WS_BIG); bf16* WMA = (bf16*)(ws + WS_WMIX); bf16* WMO = (bf16*)(ws + WS_WMIX + 26 * MiB); (void)XN; (void)BIG; (void)WMA; (void)WMO;
#define PH_END   if (ph + 1 < C.hi) { XcdBarrier b2_ = C.bar; asm volatile("" : "+s"(b2_.bar)); xcd_barrier(b2_); } } ++ph;
#define XS0 ((bf16*)a.out)
#define XS1 ((bf16*)(ws + WS_BIG + 512 * MiB))

#ifndef GU_WGM
#define GU_WGM 8
#endif
#ifndef DN_WGM
#define DN_WGM 4
#endif
#ifndef I8_MIX_MASK
#define I8_MIX_MASK 0x2
#endif
#ifndef I8_GU_MASK
#define I8_GU_MASK 0xFF
#endif
#ifndef FP8_GU_MASK
#define FP8_GU_MASK 0x00
#endif
#ifndef FP8_DN_MASK
#define FP8_DN_MASK 0xC0
#endif
constexpr int RT_TAGS_OFF = RING_BYTES + 512, RT_TAB_OFF = RING_BYTES + 1024;
template <class Sched>
__device__ __forceinline__ pg8::RowTab build_row_tab(Frame& F, const Sched& S, const float* rowq, float wstep) {
    LAS int* tags = (LAS int*)(F.lds + RT_TAGS_OFF); LAS float* tab = (LAS float*)(F.lds + RT_TAB_OFF);
    if (F.tid == 0) { int n = 0;
        for (int k = 0; k < 8; ++k) tags[k] = -1;
        pg8::Unit u;
        for (int i = 0; S.next(i, u); ++i) { bool seen = false; for (int k = 0; k < n; ++k) seen = seen || (tags[k] == u.pm); if (!seen && n < 8) tags[n++] = u.pm; } }
    __syncthreads();
    for (int k = F.tid >> 8; k < 8; k += 2) { const int pm = tags[k]; if (pm >= 0) tab[k * 256 + (F.tid & 255)] = rowq[(size_t)pm * 256 + (F.tid & 255)] * wstep; }
    __syncthreads();
    return pg8::RowTab{tab, tags};
}
template <int L, int FI>
__device__ __forceinline__ void run_ffn(unsigned char* lds_raw, const Ctx& C, int& ph) {
    constexpr bool FIRST = (L == 0 && FI == 0), LAST = (L == DEPTH - 1 && FI == 1);
    constexpr bool F8 = ((FP8_DN_MASK >> (2 * L + FI)) & 1) != 0, I8G = ((I8_GU_MASK >> (2 * L + FI)) & 1) != 0, F8G = !I8G && ((FP8_GU_MASK >> (2 * L + FI)) & 1) != 0;
    constexpr int GDT = I8G ? 2 : (F8G ? 1 : 0);
    PH_BEGIN PH_REP(REP_NORM) { if (FIRST) norm_phase<0, false, GDT>(a, F, a.in[I_X], a.in[FI ? I_F2N : I_F1N] + (size_t)L * DM, 0);
                                else norm_phase<0, true, GDT>(a, F, LAST ? XS1 : XS0, a.in[FI ? I_F2N : I_F1N] + (size_t)L * DM, 0); } PH_END
    PH_BEGIN { bf16* WGU = (bf16*)(ws + (FI ? WS_WGU2 : WS_WGU1)); constexpr int KG = GDT ? DM / 2 : DM;
               pg8::Gemm g{XN, WGU, KG, KG, KG}; pg8::StaticOrder S; S.init(MTOK, 2 * FF, F.G, F.bid, GU_WGM);
               pg8::RowTab rt{nullptr, nullptr};
               if (I8G) rt = build_row_tab(F, S, (const float*)(ws + WS_ROWQ), 1.0f);
               pg8::EpiSwiGLU<F8, I8G> E{BIG, FF, F8G ? 1.0f / (pg8::X8_SCALE * pg8::W8_SCALE) : 1.0f, rt, (const float*)(ws + WS_CSTEP) + (2 * L + FI) * 2 * FF};
               PH_REP(REP_GU) { pg8::gemm_phase<pg8::EpiSwiGLU<F8, I8G>, pg8::StaticOrder, true, true, GDT>(F.lds, g, S, E, F.tid); } } PH_END
    PH_BEGIN { bf16* WDN = (bf16*)(ws + (FI ? WS_WDN2 : WS_WDN1));
               constexpr int KE = F8 ? FF / 2 : FF;
               constexpr float SC = F8 ? 0.5f / (pg8::H8_SCALE * pg8::W8_SCALE) : 0.5f;
               pg8::Gemm g{BIG, WDN, KE, KE, KE}; pg8::StaticOrder S; S.init(MTOK, DM, F.G, F.bid, DN_WGM);
               if (FIRST) { pg8::EpiResid<false, true> E{a.in[I_X], XS0, DM, SC}; pg8::gemm_phase<pg8::EpiResid<false, true>, pg8::StaticOrder, true, true, F8 ? 1 : 0>(F.lds, g, S, E, F.tid); }
               else if (LAST) { pg8::EpiResid<true, false> E{XS1, a.out, DM, SC}; pg8::gemm_phase<pg8::EpiResid<true, false>, pg8::StaticOrder, true, true, F8 ? 1 : 0>(F.lds, g, S, E, F.tid); }
               else { pg8::EpiResid<true, true> E{XS0, XS0, DM, SC}; pg8::gemm_phase<pg8::EpiResid<true, true>, pg8::StaticOrder, true, true, F8 ? 1 : 0>(F.lds, g, S, E, F.tid); } } PH_END
}
template <int L>
__device__ __forceinline__ void run_layer(unsigned char* lds_raw, const Ctx& C, int& ph) {
    constexpr int kind = L % 3, j = L / 3;
    constexpr bool I8A = ((I8_GU_MASK >> (2 * L)) & 1) != 0, I8B = ((I8_GU_MASK >> (2 * L + 1)) & 1) != 0, I8M = kind != 2 && ((I8_MIX_MASK >> L) & 1) != 0;
    if constexpr (I8A || I8B || I8M) {
        PH_BEGIN { if (I8A) colmax_wide(F, a.in[I_F1GU] + (size_t)L * DM * 2 * FF, DM, 2 * FF, (unsigned*)(ws + WS_CTL) + CW_CMAX + (2 * L) * 2 * FF);
                   if (I8B) colmax_wide(F, a.in[I_F2GU] + (size_t)L * DM * 2 * FF, DM, 2 * FF, (unsigned*)(ws + WS_CTL) + CW_CMAX + (2 * L + 1) * 2 * FF);
                   if (I8M && kind == 0) { colmax_wide(F, a.in[I_MLWIN] + (size_t)j * DM * ML_INCOLS, DM, 6144, (unsigned*)(ws + WS_CTL) + CW_CMAX2 + 6400 * L, ML_INCOLS);
                                          colmax_pass(F, a.in[I_MLWIN] + (size_t)j * DM * ML_INCOLS + 6144, DM, 16, ML_INCOLS, (unsigned*)(ws + WS_CTL) + CW_CMAX2 + 6400 * L + 6144); }
                   if (I8M && kind == 1) colmax_wide(F, a.in[I_ATQKV] + (size_t)j * DM * AT_COLS, DM, AT_COLS, (unsigned*)(ws + WS_CTL) + CW_CMAX2 + 6400 * L); } PH_END
    }
    PH_BEGIN PH_REP(REP_CONV) { conv_phase(a, F, L, ((FP8_DN_MASK >> (2 * L)) & 1) != 0, ((FP8_DN_MASK >> (2 * L + 1)) & 1) != 0, ((FP8_GU_MASK >> (2 * L)) & 1) != 0, ((FP8_GU_MASK >> (2 * L + 1)) & 1) != 0, I8A, I8B, I8M); } PH_END
    run_ffn<L, 0>(lds_raw, C, ph);
    if constexpr (kind == 0) {
        PH_BEGIN PH_REP(REP_NORM) { norm_phase<0, true, I8M ? 2 : 0>(a, F, XS0, a.in[I_MN] + (size_t)L * DM, j); } PH_END
        PH_BEGIN { constexpr int KM = I8M ? DM / 2 : DM; pg8::Gemm g{XN, WMA, KM, KM, KM}; pg8::StaticOrder S; S.init(MTOK, ML_NPAD, F.G, F.bid);
                   pg8::RowTab rt{nullptr, nullptr}; if (I8M) rt = build_row_tab(F, S, (const float*)(ws + WS_ROWQ), 1.0f);
                   pg8::EpiStore<I8M> E{BIG, 6144, 24, (float*)(ws + WS_GATES), rt, (const float*)(ws + WS_CSTEP2) + 6400 * L};
                   PH_REP(REP_MIXG) { pg8::gemm_phase<pg8::EpiStore<I8M>, pg8::StaticOrder, true, true, I8M ? 2 : 0>(F.lds, g, S, E, F.tid); } } PH_END
        PH_BEGIN PH_REP(REP_MLA) { mlstm_phase_ab(a, F, j); } PH_END
        PH_BEGIN PH_REP(REP_MLC) { mlstm_phase_c(a, F, j); } PH_END
    } else if constexpr (kind == 1) {
        PH_BEGIN PH_REP(REP_NORM) { norm_phase<1, true, I8M ? 2 : 0>(a, F, XS0, a.in[I_MN] + (size_t)L * DM, j); } PH_END
        PH_BEGIN { constexpr int KM = I8M ? DM / 2 : DM; pg8::Gemm g{XN, WMA, KM, KM, KM}; pg8::StaticOrder S; S.init(MTOK, AT_COLS, F.G, F.bid);
                   pg8::RowTab rt{nullptr, nullptr}; if (I8M) rt = build_row_tab(F, S, (const float*)(ws + WS_ROWQ), 1.0f);
                   pg8::EpiStore<I8M> E{BIG, AT_COLS, 1 << 30, nullptr, rt, (const float*)(ws + WS_CSTEP2) + 6400 * L};
                   PH_REP(REP_MIXG) { pg8::gemm_phase<pg8::EpiStore<I8M>, pg8::StaticOrder, true, true, I8M ? 2 : 0>(F.lds, g, S, E, F.tid); } } PH_END
        PH_BEGIN PH_REP(REP_ATTN) { attn_phase(a, F, j); } PH_END
    } else {
        PH_BEGIN PH_REP(REP_NORM) { norm_phase<2, true>(a, F, XS0, a.in[I_MN] + (size_t)L * DM, j); } PH_END
        PH_BEGIN { pg8::Gemm g{BIG, WMA, DM, DM, DM}; pg8::RwkvOrder1 S; S.b.init(MTOK, 27 * 256, F.G, F.bid);
                   pg8::EpiRwkv1 E{BIG + (size_t)384 * MiB, XN, MTOK};
                   PH_REP(REP_MIXG) { pg8::gemm_phase<pg8::EpiRwkv1, pg8::RwkvOrder1, true, true>(F.lds, g, S, E, F.tid); } } PH_END
        PH_BEGIN { pg8::Gemm g{XN, (bf16*)(ws + WS_WMIX + 28 * MiB), 256, 256, 256}; pg8::RwkvOrder2 S; S.b.init(MTOK, 24 * 256, F.G, F.bid);
                   pg8::EpiRwkv2 E{(float*)(ws + WS_BIG), (bf16*)(ws + WS_BIG + 256 * MiB), (bf16*)(ws + WS_BIG + 384 * MiB), a.in[I_RWW0] + (size_t)j * DM, a.in[I_RWA0] + (size_t)j * DM};
                   PH_REP(REP_MIXG) { pg8::gemm_phase<pg8::EpiRwkv2, pg8::RwkvOrder2, true, true>(F.lds, g, S, E, F.tid); } } PH_END
        PH_BEGIN PH_REP(REP_SCAN) { rwkv_scan_phase(a, F, j); } PH_END
    }
    PH_BEGIN { pg8::Gemm g{XN, kind == 2 ? (bf16*)(ws + WS_WMIX + 32 * MiB) : WMO, DM, DM, DM}; pg8::StaticOrder S; S.init(MTOK, DM, F.G, F.bid, DN_WGM);
               pg8::EpiResid<true, true> E{XS0, L == DEPTH - 1 ? XS1 : XS0, DM, 1.0f};
               pg8::gemm_phase<pg8::EpiResid<true, true>, pg8::StaticOrder, true, true>(F.lds, g, S, E, F.tid); } PH_END
    run_ffn<L, 1>(lds_raw, C, ph);
}
#undef PH_BEGIN
#undef PH_END

__global__ void __launch_bounds__(NTHREADS, 2) hybrid_fwd(Args a_unused) {
    extern __shared__ __attribute__((aligned(16))) unsigned char lds_raw[];
    volatile LAS unsigned* MISC = (volatile LAS unsigned*)((LAS unsigned char*)lds_raw + MISC_OFF);
    if (threadIdx.x < 32) MISC[threadIdx.x] = 0u;
    __syncthreads();
    Ctx C; C.bar = xcd_barrier_post((unsigned*)(kargs()->ws + WS_CTL) + CW_BAR, MISC + 8);
    C.lo = kargs()->ph_lo; C.hi = kargs()->ph_hi; int ph = 0;
    run_layer<0>(lds_raw, C, ph);
    run_layer<1>(lds_raw, C, ph);
    run_layer<2>(lds_raw, C, ph);
    run_layer<3>(lds_raw, C, ph);
}

extern "C" void kernel_launch(void* const* d_in, const int* in_sizes, int n_in, void* d_out, int out_size, void* d_ws, size_t ws_size, hipStream_t stream) {
    static int grid = 0;
    if (grid == 0) {
        if (n_in != N_IN || in_sizes[0] != MTOK * DM || out_size != MTOK * DM || ws_size < WS_END) {
            fprintf(stderr, "kernel_launch: unexpected shapes (n_in %d, in0 %d, out %d, ws %zu < %zu); nothing launched\n", n_in, n_in > 0 ? in_sizes[0] : -1, out_size, ws_size, (size_t)WS_END); grid = -1; return; }
        int dev = 0, cus = 0, per_cu = 0;
        if (hipGetDevice(&dev) != hipSuccess || hipDeviceGetAttribute(&cus, hipDeviceAttributeMultiprocessorCount, dev) != hipSuccess) { grid = -1; return; }
        if (hipFuncSetAttribute((const void*)hybrid_fwd, hipFuncAttributeMaxDynamicSharedMemorySize, LDS_BYTES) != hipSuccess) { fprintf(stderr, "kernel_launch: hipFuncSetAttribute failed\n"); grid = -1; return; }
        if (hipOccupancyMaxActiveBlocksPerMultiprocessor(&per_cu, (const void*)hybrid_fwd, NTHREADS, LDS_BYTES) != hipSuccess || per_cu < 1) { fprintf(stderr, "kernel_launch: occupancy query says %d blocks per CU\n", per_cu); }
        (void)hipGetLastError();
        grid = cus;
    }
    if (grid < 0) return;
    if (hipMemsetAsync((char*)d_ws + WS_CTL, 0, CTL_ZERO_BYTES, stream) != hipSuccess) return;
    Args a{};
    for (int i = 0; i < N_IN; ++i) a.in[i] = (const float*)d_in[i];
    a.out = (float*)d_out; a.ws = (unsigned char*)d_ws;
#if MK_PER_PHASE
    for (int p = 0; p < N_PHASES_MAX; ++p) { a.ph_lo = p; a.ph_hi = p + 1; hipLaunchKernelGGL(hybrid_fwd, dim3(grid), dim3(NTHREADS), LDS_BYTES, stream, a); }
#else
    a.ph_lo = 0; a.ph_hi = 1 << 30;
    hipLaunchKernelGGL(hybrid_fwd, dim3(grid), dim3(NTHREADS), LDS_BYTES, stream, a);
#endif
    const hipError_t le = hipPeekAtLastError();
    if (le != hipSuccess) fprintf(stderr, "kernel_launch: launch failed: %s\n", hipGetErrorName(le));
}
```

```cpp
#include <hip/hip_runtime.h>
#include <cstdio>
#include <cstdint>
#define I8_MIX_MASK 0xA
namespace pg8 {
#define PG8_LAS __attribute__((address_space(3)))
typedef unsigned short bf16_t;
typedef short bf16x8 __attribute__((ext_vector_type(8)));
typedef float f32x4 __attribute__((ext_vector_type(4)));
typedef unsigned u32x4 __attribute__((ext_vector_type(4)));
constexpr int BM = 256, BK = 64, HALF = 128, HTB = HALF * BK * 2  , STAGE_BYTES = 8 * HTB, NXCD = 8, WGM = 8;

__host__ __device__ __forceinline__ int lds_byte(int r, int c) { const int st = (r >> 4) * 2 + (c >> 5), rr = r & 15, cc = c & 31, ob = rr * 64 + cc * 2; return st * 1024 + (ob ^ (((ob >> 9) & 1) << 5)); }
__host__ __device__ __forceinline__ void stage_rc(int b, int& R, int& C) { const int st = b / 1024, sb = b % 1024, swz = sb ^ (((sb >> 9) & 1) << 5); R = (st >> 1) * 16 + swz / 64; C = (st & 1) * 32 + (swz % 64) / 2; }
__host__ __device__ __forceinline__ int perm32(int rho) { const int n = rho >> 4, i = rho & 15; return 8 * (i >> 2) + 4 * n + (i & 3); }

typedef int i32x8 __attribute__((ext_vector_type(8)));
__device__ __forceinline__ i32x8 ld32(const PG8_LAS unsigned char* p) { typedef int i32x4_ __attribute__((ext_vector_type(4))); const i32x4_ lo = *(const PG8_LAS i32x4_*)p, hi = *(const PG8_LAS i32x4_*)(p + 16); return __builtin_shufflevector(lo, hi, 0, 1, 2, 3, 4, 5, 6, 7); }
struct Unit { int pm, pn; };
struct Gemm { const bf16_t* A; const bf16_t* Bt; int lda, ldb, K; };

struct StaticOrder {
    int nM, nN, nwg, G, c, wgm;
    __host__ __device__ void init(int M, int N, int G_, int c_, int wgm_ = WGM) { nM = M / BM; nN = N / BM; nwg = nM * nN; G = G_; c = c_; wgm = wgm_; }
    __host__ __device__ bool next(int i, Unit& u) const {
        const long L = (long)i * G + c; if (L >= nwg) return false;
        int wgid = (int)L; { const int q = nwg / NXCD, r = nwg % NXCD, xcd = wgid % NXCD, off = wgid / NXCD; wgid = (xcd < r ? xcd * (q + 1) : r * (q + 1) + (xcd - r) * q) + off; }
        const int nig = wgm * nN, gid = wgid / nig, fm = gid * wgm, gsz = (nM - fm) < wgm ? (nM - fm) : wgm;
        u.pm = fm + ((wgid % nig) % gsz); u.pn = (wgid % nig) / gsz; return true;
    }
    __device__ __forceinline__ void a_ready(const Unit&) const {}
    __device__ __forceinline__ void done(const Unit&) const {}
};

typedef __bf16 bf16v2_t __attribute__((ext_vector_type(2)));
__device__ __forceinline__ unsigned cvt_pk_bf16(float lo, float hi) { bf16v2_t v; v.x = (__bf16)lo; v.y = (__bf16)hi; return __builtin_bit_cast(unsigned, v); }
__device__ __forceinline__ float fast_sigmoid(float x) { return __builtin_amdgcn_rcpf(1.0f + __expf(-x)); }
constexpr int MROWS_TILES = 128;

constexpr float H8_SCALE = 4.0f, W8_SCALE = 64.0f, X8_SCALE = 16.0f;
struct RowTab { const PG8_LAS float* tab; const PG8_LAS int* tags;
    __device__ __forceinline__ int slot(int pm) const { int s = 0;
#pragma unroll
        for (int k = 0; k < 8; ++k) if (tags[k] == pm) s = k;
        return __builtin_amdgcn_readfirstlane(s); } };
template <bool F8, bool IN8 = false>
struct EpiSwiGLU {
    static constexpr bool PERM = true, AFTER_DRAIN = false;
    void* O; int ldc; float isc; RowTab rt; const float* cstep;
    __device__ __forceinline__ void operator()(const f32x4 (&acc)[2][2][4][2], const Unit& u, int wr, int wc, int fr, int fq) const {
        const int row0 = u.pm * BM + wr * 64 + fr, col0 = u.pn * HALF + wc * 32 + 8 * fq; const int sl = IN8 ? rt.slot(u.pm) : 0;
        f32x4 cg[2], cu[2];
#pragma unroll
        for (int n = 0; n < 2; ++n) { cg[n] = IN8 ? *(const f32x4*)(cstep + u.pn * BM + wc * 32 + 8 * fq + 4 * n) : (f32x4){1.f, 1.f, 1.f, 1.f}; cu[n] = IN8 ? *(const f32x4*)(cstep + u.pn * BM + HALF + wc * 32 + 8 * fq + 4 * n) : (f32x4){1.f, 1.f, 1.f, 1.f}; }
#pragma unroll
        for (int ai = 0; ai < 2; ++ai)
#pragma unroll
            for (int m = 0; m < 4; ++m) { const size_t off = (size_t)(row0 + ai * HALF + m * 16) * ldc + col0;
                const float rs = IN8 ? rt.tab[sl * 256 + wr * 64 + ai * HALF + m * 16 + fr] : isc;
                float o[8];
#pragma unroll
                for (int n = 0; n < 2; ++n)
#pragma unroll
                    for (int e = 0; e < 4; ++e) { const float ga = acc[ai][0][m][n][e], ua = acc[ai][1][m][n][e];
                        const float g = (IN8 ? (float)__float_as_int(ga) * cg[n][e] : ga) * rs, up = (IN8 ? (float)__float_as_int(ua) * cu[n][e] : ua) * rs; o[4 * n + e] = g * fast_sigmoid(g) * up; }
                if (F8) { unsigned w0 = 0u, w1 = 0u;
#pragma unroll
                    for (int e = 0; e < 8; ++e) o[e] = __builtin_amdgcn_fmed3f(o[e] * H8_SCALE, -448.0f, 448.0f);
                    w0 = __builtin_amdgcn_cvt_pk_fp8_f32(o[0], o[1], w0, false); w0 = __builtin_amdgcn_cvt_pk_fp8_f32(o[2], o[3], w0, true);
                    w1 = __builtin_amdgcn_cvt_pk_fp8_f32(o[4], o[5], w1, false); w1 = __builtin_amdgcn_cvt_pk_fp8_f32(o[6], o[7], w1, true);
                    typedef unsigned u32x2_ __attribute__((ext_vector_type(2))); *(u32x2_*)((unsigned char*)O + off) = (u32x2_){w0, w1}; }
                else { u32x4 w; w.x = cvt_pk_bf16(o[0], o[1]); w.y = cvt_pk_bf16(o[2], o[3]); w.z = cvt_pk_bf16(o[4], o[5]); w.w = cvt_pk_bf16(o[6], o[7]);
                    __builtin_nontemporal_store(w, (u32x4*)((bf16_t*)O + off)); } }
    }
};
typedef _Float16 h16x8_t __attribute__((ext_vector_type(8)));
template <bool BB, bool OB>
struct EpiResid {
    static constexpr bool PERM = true, AFTER_DRAIN = false;
    const void* base; void* out; int ldc; float s;
    __device__ __forceinline__ void operator()(const f32x4 (&acc)[2][2][4][2], const Unit& u, int wr, int wc, int fr, int fq) const {
        const int row0 = u.pm * BM + wr * 64 + fr, col0 = u.pn * BM + wc * 32 + 8 * fq;
#pragma unroll
        for (int ai = 0; ai < 2; ++ai) {
            if constexpr (BB) {
                h16x8_t wv[4][2];
#pragma unroll
                for (int m = 0; m < 4; ++m)
#pragma unroll
                    for (int bj = 0; bj < 2; ++bj) wv[m][bj] = *(const h16x8_t*)((const bf16_t*)base + (size_t)(row0 + ai * HALF + m * 16) * ldc + col0 + bj * HALF);
#pragma unroll
                for (int m = 0; m < 4; ++m) { const size_t off = (size_t)(row0 + ai * HALF + m * 16) * ldc + col0;
#pragma unroll
                    for (int bj = 0; bj < 2; ++bj) { const h16x8_t w = wv[m][bj];
                        const f32x4 b0 = (f32x4){(float)w[0], (float)w[1], (float)w[2], (float)w[3]}, b1 = (f32x4){(float)w[4], (float)w[5], (float)w[6], (float)w[7]};
                        const f32x4 o0 = b0 + acc[ai][bj][m][0] * s, o1 = b1 + acc[ai][bj][m][1] * s;
                        if (OB) { h16x8_t wo; wo[0] = (_Float16)o0[0]; wo[1] = (_Float16)o0[1]; wo[2] = (_Float16)o0[2]; wo[3] = (_Float16)o0[3]; wo[4] = (_Float16)o1[0]; wo[5] = (_Float16)o1[1]; wo[6] = (_Float16)o1[2]; wo[7] = (_Float16)o1[3];
                            *(h16x8_t*)((bf16_t*)out + off + bj * HALF) = wo; }
                        else { *(f32x4*)((float*)out + off + bj * HALF) = o0; *(f32x4*)((float*)out + off + bj * HALF + 4) = o1; } } }
            } else {
#pragma unroll
                for (int m = 0; m < 4; ++m) { const size_t off = (size_t)(row0 + ai * HALF + m * 16) * ldc + col0; f32x4 bb[2][2];
#pragma unroll
                    for (int bj = 0; bj < 2; ++bj) { bb[bj][0] = *(const f32x4*)((const float*)base + off + bj * HALF); bb[bj][1] = *(const f32x4*)((const float*)base + off + bj * HALF + 4); }
#pragma unroll
                    for (int bj = 0; bj < 2; ++bj) { const f32x4 o0 = bb[bj][0] + acc[ai][bj][m][0] * s, o1 = bb[bj][1] + acc[ai][bj][m][1] * s;
                        if (OB) { h16x8_t wo; wo[0] = (_Float16)o0[0]; wo[1] = (_Float16)o0[1]; wo[2] = (_Float16)o0[2]; wo[3] = (_Float16)o0[3]; wo[4] = (_Float16)o1[0]; wo[5] = (_Float16)o1[1]; wo[6] = (_Float16)o1[2]; wo[7] = (_Float16)o1[3];
                            *(h16x8_t*)((bf16_t*)out + off + bj * HALF) = wo; }
                        else { *(f32x4*)((float*)out + off + bj * HALF) = o0; *(f32x4*)((float*)out + off + bj * HALF + 4) = o1; } } }
            }
        }
    }
};
__device__ __forceinline__ f32x4 i32bits_to_f32(f32x4 v) { return (f32x4){(float)__float_as_int(v.x), (float)__float_as_int(v.y), (float)__float_as_int(v.z), (float)__float_as_int(v.w)}; }
template <bool IN8 = false>
struct EpiStore {
    static constexpr bool PERM = true, AFTER_DRAIN = false;
    bf16_t* O; int ldc; int gate_tile; float* G; RowTab rt; const float* cstep;
    __device__ __forceinline__ void operator()(const f32x4 (&acc)[2][2][4][2], const Unit& u, int wr, int wc, int fr, int fq) const {
        const int row0 = u.pm * BM + wr * 64 + fr, colt = u.pn * BM, cl = wc * 32 + 8 * fq; const int sl = IN8 ? rt.slot(u.pm) : 0;
        f32x4 cs[2][2];
#pragma unroll
        for (int bj = 0; bj < 2; ++bj)
#pragma unroll
            for (int n = 0; n < 2; ++n) cs[bj][n] = IN8 ? *(const f32x4*)(cstep + colt + bj * HALF + cl + 4 * n) : (f32x4){1.f, 1.f, 1.f, 1.f};
        if (u.pn >= gate_tile) {
            if (wc == 0 && fq < 2) {
#pragma unroll
                for (int ai = 0; ai < 2; ++ai)
#pragma unroll
                    for (int m = 0; m < 4; ++m) { const int rl = wr * 64 + ai * HALF + m * 16 + fr; float* gp = G + (size_t)(u.pm * BM + rl) * 16 + 8 * fq;
                        if (IN8) { const float rs = rt.tab[sl * 256 + rl]; *(f32x4*)gp = i32bits_to_f32(acc[ai][0][m][0]) * cs[0][0] * rs; *(f32x4*)(gp + 4) = i32bits_to_f32(acc[ai][0][m][1]) * cs[0][1] * rs; }
                        else { *(f32x4*)gp = acc[ai][0][m][0]; *(f32x4*)(gp + 4) = acc[ai][0][m][1]; } }
            }
            return;
        }
#pragma unroll
        for (int ai = 0; ai < 2; ++ai)
#pragma unroll
            for (int m = 0; m < 4; ++m) { const int rl = wr * 64 + ai * HALF + m * 16 + fr; bf16_t* rowp = O + (size_t)(u.pm * BM + rl) * ldc + colt + cl;
                const float rs = IN8 ? rt.tab[sl * 256 + rl] : 1.0f;
#pragma unroll
                for (int bj = 0; bj < 2; ++bj) { f32x4 v0 = acc[ai][bj][m][0], v1 = acc[ai][bj][m][1];
                    if (IN8) { v0 = i32bits_to_f32(v0) * cs[bj][0] * rs; v1 = i32bits_to_f32(v1) * cs[bj][1] * rs; }
                    u32x4 w; w.x = cvt_pk_bf16(v0[0], v0[1]); w.y = cvt_pk_bf16(v0[2], v0[3]); w.z = cvt_pk_bf16(v1[0], v1[1]); w.w = cvt_pk_bf16(v1[2], v1[3]);
                    *(u32x4*)(rowp + bj * HALF) = w; } }
    }
};
struct EpiRwkv1 {
    static constexpr bool PERM = true, AFTER_DRAIN = false;
    bf16_t* RKV; bf16_t* L; int Mrows;
    __device__ __forceinline__ void operator()(const f32x4 (&acc)[2][2][4][2], const Unit& u, int wr, int wc, int fr, int fq) const {
        const int pml = u.pm & (MROWS_TILES - 1), row0 = pml * BM + wr * 64 + fr, cl = wc * 32 + 8 * fq;
        bf16_t* base; int ldc, colt, mode;
        if (u.pn < 24) { base = RKV + (size_t)(u.pn >> 3) * Mrows * 2048; ldc = 2048; colt = (u.pn & 7) * BM; mode = 0; }
        else { base = L + (size_t)(u.pn - 24) * Mrows * 256; ldc = 256; colt = 0; mode = u.pn - 23; }
#pragma unroll
        for (int ai = 0; ai < 2; ++ai)
#pragma unroll
            for (int m = 0; m < 4; ++m) { bf16_t* rowp = base + (size_t)(row0 + ai * HALF + m * 16) * ldc + colt + cl;
#pragma unroll
                for (int bj = 0; bj < 2; ++bj) { float o[8];
#pragma unroll
                    for (int n = 0; n < 2; ++n)
#pragma unroll
                        for (int e = 0; e < 4; ++e) { float v = acc[ai][bj][m][n][e];
                            if (mode == 1) { const float t = __expf(-2.0f * fabsf(v)); const float th = (1.0f - t) * __builtin_amdgcn_rcpf(1.0f + t); v = v < 0.f ? -th : th; }
                            else if (mode == 3) v = fast_sigmoid(v);
                            o[4 * n + e] = v; }
                    u32x4 w; w.x = cvt_pk_bf16(o[0], o[1]); w.y = cvt_pk_bf16(o[2], o[3]); w.z = cvt_pk_bf16(o[4], o[5]); w.w = cvt_pk_bf16(o[6], o[7]);
                    *(u32x4*)(rowp + bj * HALF) = w; } }
    }
};
struct EpiRwkv2 {
    static constexpr bool PERM = true, AFTER_DRAIN = false;
    float* DEC; bf16_t* AG; bf16_t* GG; const float* w0; const float* a0;
    __device__ __forceinline__ void operator()(const f32x4 (&acc)[2][2][4][2], const Unit& u, int wr, int wc, int fr, int fq) const {
        const int pml = u.pm & (MROWS_TILES - 1), row0 = pml * BM + wr * 64 + fr, seg = u.pn >> 3, col0 = (u.pn & 7) * BM + wc * 32 + 8 * fq;
        const float* bias = seg == 0 ? w0 : a0;
        f32x4 bv[2][2];
#pragma unroll
        for (int bj = 0; bj < 2; ++bj)
#pragma unroll
            for (int n = 0; n < 2; ++n) bv[bj][n] = seg < 2 ? *(const f32x4*)(bias + col0 + bj * HALF + 4 * n) : (f32x4){0.f, 0.f, 0.f, 0.f};
#pragma unroll
        for (int ai = 0; ai < 2; ++ai)
#pragma unroll
            for (int m = 0; m < 4; ++m) { const size_t ro = (size_t)(row0 + ai * HALF + m * 16) * 2048;
#pragma unroll
                for (int bj = 0; bj < 2; ++bj) { const int col = col0 + bj * HALF; const f32x4 v0 = acc[ai][bj][m][0] + bv[bj][0], v1 = acc[ai][bj][m][1] + bv[bj][1];
                    if (seg == 0) { *(f32x4*)(DEC + ro + col) = v0; *(f32x4*)(DEC + ro + col + 4) = v1; }
                    else { u32x4 w; w.x = cvt_pk_bf16(v0[0], v0[1]); w.y = cvt_pk_bf16(v0[2], v0[3]); w.z = cvt_pk_bf16(v1[0], v1[1]); w.w = cvt_pk_bf16(v1[2], v1[3]);
                        *(u32x4*)((seg == 1 ? AG : GG) + ro + col) = w; } } }
    }
};
struct RwkvOrder1 { StaticOrder b;
    __device__ bool next(int i, Unit& u) const { if (!b.next(i, u)) return false; const int seg = u.pn < 24 ? (u.pn >> 3) : u.pn - 21; u.pm += ((0x541320 >> (4 * seg)) & 7) * MROWS_TILES; return true; }
    __device__ __forceinline__ void a_ready(const Unit&) const {}
    __device__ __forceinline__ void done(const Unit&) const {} };
struct RwkvOrder2 { StaticOrder b;
    __device__ bool next(int i, Unit& u) const { if (!b.next(i, u)) return false; u.pm += (u.pn >> 3) * MROWS_TILES; return true; }
    __device__ __forceinline__ void a_ready(const Unit&) const {}
    __device__ __forceinline__ void done(const Unit&) const {} };

template <class Epi, class Sched, bool ALIGN_EPI = false, bool SP2 = false, int DT = 0>
__device__ __forceinline__ void gemm_phase(PG8_LAS unsigned char* lds, const Gemm g, const Sched& S, const Epi& E, const int tid_in) {
    const int tid = tid_in, wid = __builtin_amdgcn_readfirstlane(tid >> 6), lane = tid & 63, wr = wid >> 2, wc = wid & 3, fr = lane & 15, fq = lane >> 4;
    int K_ = g.K; asm volatile("" : "+s"(K_));
    const int K = K_, nt = K / BK;
    unsigned voffA[2], voffB[2];
#pragma unroll
    for (int i = 0; i < 2; ++i) { int R, C; stage_rc(tid * 16 + i * 8192, R, C); const int Rb = Epi::PERM ? ((R & ~31) + perm32(R & 31)) : R;
        voffA[i] = (unsigned)(R * g.lda + C) * 2u; voffB[i] = (unsigned)(Rb * g.ldb + C) * 2u; }
    const size_t kstep = (size_t)(BK * 2);
    const size_t hstepA = (size_t)HALF * g.lda * 2, hstepB = (size_t)HALF * g.ldb * 2;
    const size_t tstepA = 2 * hstepA, tstepB = 2 * hstepB;
    const unsigned ldsw = (unsigned)wid * 1024u;
    const int aoff = lds_byte(wr * 64 + fr, fq * (DT == 1 ? 16 : 8)), boff = lds_byte(wc * 32 + fr, fq * (DT == 1 ? 16 : 8));
#define PG8_SA(b, h) (((b) * 2 + (h)) * HTB)
#define PG8_SB(b, h) ((4 + (b) * 2 + (h)) * HTB)
#define PG8_STAGE(bufoff, gbase, voff) do { _Pragma("unroll") for (int _i = 0; _i < 2; ++_i) \
        __builtin_amdgcn_global_load_lds((const unsigned*)((const char*)(gbase) + (voff)[_i]), (PG8_LAS unsigned*)(lds + (bufoff) + ldsw + _i * 8192), 16, 0, 0); } while (0)
#define PG8_LDA(dst, b, h) do { if constexpr (DT != 1) { _Pragma("unroll") for (int m = 0; m < 4; ++m) _Pragma("unroll") for (int k = 0; k < 2; ++k) dst[m][k] = *(const PG8_LAS bf16x8*)(lds + PG8_SA(b, h) + aoff + m * 2048 + k * 1024); } \
        else { _Pragma("unroll") for (int m = 0; m < 4; ++m) dst##8[m] = ld32(lds + PG8_SA(b, h) + aoff + m * 2048); } } while (0)
#define PG8_LDB(dst, b, h) do { if constexpr (DT != 1) { _Pragma("unroll") for (int n = 0; n < 2; ++n) _Pragma("unroll") for (int k = 0; k < 2; ++k) dst[n][k] = *(const PG8_LAS bf16x8*)(lds + PG8_SB(b, h) + boff + n * 2048 + k * 1024); } \
        else { _Pragma("unroll") for (int n = 0; n < 2; ++n) dst##8[n] = ld32(lds + PG8_SB(b, h) + boff + n * 2048); } } while (0)
#define PG8_MMA(ai, bj, At, Bt) do { __builtin_amdgcn_s_setprio(1); \
        if constexpr (DT == 0) { _Pragma("unroll") for (int m = 0; m < 4; ++m) _Pragma("unroll") for (int n = 0; n < 2; ++n) _Pragma("unroll") for (int k = 0; k < 2; ++k) \
            acc[ai][bj][m][n] = __builtin_amdgcn_mfma_f32_16x16x32_bf16(Bt[n][k], At[m][k], acc[ai][bj][m][n], 0, 0, 0); } \
        else if constexpr (DT == 2) { typedef int i32x4_ __attribute__((ext_vector_type(4))); _Pragma("unroll") for (int m = 0; m < 4; ++m) _Pragma("unroll") for (int n = 0; n < 2; ++n) _Pragma("unroll") for (int k = 0; k < 2; ++k) \
            acc[ai][bj][m][n] = __builtin_bit_cast(f32x4, __builtin_amdgcn_mfma_i32_16x16x64_i8(__builtin_bit_cast(i32x4_, Bt[n][k]), __builtin_bit_cast(i32x4_, At[m][k]), __builtin_bit_cast(i32x4_, acc[ai][bj][m][n]), 0, 0, 0)); } \
        else { _Pragma("unroll") for (int m = 0; m < 4; ++m) _Pragma("unroll") for (int n = 0; n < 2; ++n) \
            { constexpr int O_ = 0; const int o_ = (m * 2 + n) * 4; f32x4 c_ = {accq[ai][bj][o_], accq[ai][bj][o_ + 1], accq[ai][bj][o_ + 2], accq[ai][bj][o_ + 3]}; (void)O_; \
              c_ = __builtin_amdgcn_mfma_scale_f32_16x16x128_f8f6f4(Bt##8[n], At##8[m], c_, 0, 0, 0, 0x7F7F7F7F, 0, 0x7F7F7F7F); \
              accq[ai][bj][o_] = c_[0]; accq[ai][bj][o_ + 1] = c_[1]; accq[ai][bj][o_ + 2] = c_[2]; accq[ai][bj][o_ + 3] = c_[3]; } } \
        __builtin_amdgcn_s_setprio(0); } while (0)
#define PG8_WAIT_V(n) asm volatile("s_waitcnt vmcnt(" #n ")" ::: "memory")
#define PG8_WAIT_L(n) asm volatile("s_waitcnt lgkmcnt(" #n ")" ::: "memory")
#define PG8_BAR __builtin_amdgcn_s_barrier()
#define PG8_SCHED __builtin_amdgcn_sched_barrier(0)
    Unit cur, nxt; int ui = 0;
    if (!S.next(0, cur)) return;
    f32x4 acc[2][2][4][2];
    typedef float f32x32 __attribute__((ext_vector_type(32)));
    f32x32 accq[2][2];
    if constexpr (DT == 1) {
#pragma unroll
        for (int a = 0; a < 2; ++a)
#pragma unroll
            for (int b = 0; b < 2; ++b)
#pragma unroll
                for (int i = 0; i < 32; ++i) accq[a][b][i] = 0.f; }
#pragma unroll
    for (int a = 0; a < 2; ++a)
#pragma unroll
        for (int b = 0; b < 2; ++b)
#pragma unroll
            for (int m = 0; m < 4; ++m)
#pragma unroll
                for (int n = 0; n < 2; ++n) acc[a][b][m][n] = (f32x4){0.f, 0.f, 0.f, 0.f};
    bf16x8 At[4][2], B0[2][2], B1[2][2];
    i32x8 At8[4], B08[2], B18[2];
    const char* cA = (const char*)g.A + (size_t)cur.pm * tstepA; const char* cB = (const char*)g.Bt + (size_t)cur.pn * tstepB;
    S.a_ready(cur);
    if constexpr (SP2) {
        PG8_STAGE(PG8_SB(0, 0), cB, voffB); PG8_STAGE(PG8_SB(0, 1), cB + hstepB, voffB); PG8_STAGE(PG8_SA(0, 0), cA, voffA); PG8_STAGE(PG8_SA(0, 1), cA + hstepA, voffA);
        if (wr == 1) PG8_BAR;
        PG8_WAIT_V(2); PG8_BAR;
        PG8_STAGE(PG8_SB(1, 0), cB + kstep, voffB); PG8_STAGE(PG8_SA(1, 0), cA + kstep, voffA); PG8_STAGE(PG8_SB(1, 1), cB + hstepB + kstep, voffB);
        PG8_WAIT_V(6); PG8_BAR;
    } else {
        PG8_STAGE(PG8_SB(0, 0), cB, voffB); PG8_STAGE(PG8_SA(0, 0), cA, voffA); PG8_STAGE(PG8_SB(0, 1), cB + hstepB, voffB); PG8_STAGE(PG8_SA(0, 1), cA + hstepA, voffA);
        if (wr == 1) PG8_BAR;
        PG8_WAIT_V(4); PG8_BAR;
        PG8_STAGE(PG8_SB(1, 0), cB + kstep, voffB); PG8_STAGE(PG8_SA(1, 0), cA + kstep, voffA); PG8_STAGE(PG8_SB(1, 1), cB + hstepB + kstep, voffB);
        PG8_WAIT_V(6); PG8_BAR;
    }
    for (;;) {
        const bool has_next = S.next(ui + 1, nxt);
        const char* nA = has_next ? (const char*)g.A + (size_t)nxt.pm * tstepA : cA; const char* nB = has_next ? (const char*)g.Bt + (size_t)nxt.pn * tstepB : cB;
        for (int t = 0; t < nt; t += 2) {
            const bool last = (t == nt - 2);
            const char* a1 = cA + (size_t)(t + 1) * kstep;
            const char* a2 = last ? nA : cA + (size_t)(t + 2) * kstep; const char* b2 = last ? nB : cB + (size_t)(t + 2) * kstep;
            const char* a3 = a2 + kstep; const char* b3 = b2 + kstep;
            if (last && has_next) S.a_ready(nxt);
            if constexpr (SP2) {
            PG8_LDB(B0, 0, 0); PG8_LDB(B1, 0, 1); PG8_SCHED; PG8_LDA(At, 0, 0); PG8_STAGE(PG8_SA(1, 1), a1 + hstepA, voffA);
            PG8_WAIT_V(8); PG8_WAIT_L(0); PG8_BAR; PG8_MMA(0, 0, At, B0); PG8_MMA(0, 1, At, B1); PG8_BAR; PG8_SCHED;
            PG8_LDA(At, 0, 1); PG8_STAGE(PG8_SB(0, 0), b2, voffB); PG8_STAGE(PG8_SB(0, 1), b2 + hstepB, voffB); PG8_STAGE(PG8_SA(0, 0), a2, voffA);
            PG8_WAIT_V(8); PG8_WAIT_L(0); PG8_BAR; PG8_MMA(1, 0, At, B0); PG8_MMA(1, 1, At, B1); PG8_BAR; PG8_SCHED;
            PG8_LDB(B0, 1, 0); PG8_LDB(B1, 1, 1); PG8_SCHED; PG8_LDA(At, 1, 0); PG8_STAGE(PG8_SA(0, 1), a2 + hstepA, voffA);
            PG8_WAIT_V(8); PG8_WAIT_L(0); PG8_BAR; PG8_MMA(0, 0, At, B0); PG8_MMA(0, 1, At, B1); PG8_BAR; PG8_SCHED;
            PG8_LDA(At, 1, 1); PG8_STAGE(PG8_SB(1, 0), b3, voffB); PG8_STAGE(PG8_SB(1, 1), b3 + hstepB, voffB); PG8_STAGE(PG8_SA(1, 0), a3, voffA);
            PG8_WAIT_V(8); PG8_WAIT_L(0); PG8_BAR; PG8_MMA(1, 0, At, B0); PG8_MMA(1, 1, At, B1); PG8_BAR; PG8_SCHED;
            } else {
            PG8_LDB(B0, 0, 0); PG8_SCHED; PG8_LDA(At, 0, 0); PG8_STAGE(PG8_SA(1, 1), a1 + hstepA, voffA);
            PG8_WAIT_L(8); PG8_BAR; PG8_WAIT_L(0); PG8_MMA(0, 0, At, B0); PG8_BAR; PG8_SCHED;
            PG8_LDB(B1, 0, 1); PG8_STAGE(PG8_SB(0, 0), b2, voffB);
            PG8_BAR; PG8_WAIT_L(0); PG8_MMA(0, 1, At, B1); PG8_BAR;
            PG8_LDA(At, 0, 1); PG8_STAGE(PG8_SA(0, 0), a2, voffA);
            PG8_BAR; PG8_WAIT_L(0); PG8_MMA(1, 0, At, B0); PG8_BAR; PG8_SCHED;
            PG8_STAGE(PG8_SB(0, 1), b2 + hstepB, voffB);
            PG8_WAIT_V(6); PG8_BAR; PG8_MMA(1, 1, At, B1); PG8_BAR;
            PG8_LDB(B0, 1, 0); PG8_SCHED; PG8_LDA(At, 1, 0); PG8_STAGE(PG8_SA(0, 1), a2 + hstepA, voffA);
            PG8_WAIT_L(8); PG8_BAR; PG8_WAIT_L(0); PG8_MMA(0, 0, At, B0); PG8_BAR; PG8_SCHED;
            PG8_LDB(B1, 1, 1); PG8_STAGE(PG8_SB(1, 0), b3, voffB);
            PG8_BAR; PG8_WAIT_L(0); PG8_MMA(0, 1, At, B1); PG8_BAR;
            PG8_LDA(At, 1, 1); PG8_STAGE(PG8_SA(1, 0), a3, voffA);
            PG8_BAR; PG8_WAIT_L(0); PG8_MMA(1, 0, At, B0); PG8_BAR; PG8_SCHED;
            PG8_STAGE(PG8_SB(1, 1), b3 + hstepB, voffB);
            PG8_WAIT_V(6); PG8_BAR; PG8_MMA(1, 1, At, B1); PG8_BAR;
            }
        }
        if constexpr (ALIGN_EPI) { if (wr == 0) PG8_BAR; }
        if constexpr (DT == 1) {
#pragma unroll
            for (int a = 0; a < 2; ++a)
#pragma unroll
                for (int b = 0; b < 2; ++b)
#pragma unroll
                    for (int m = 0; m < 4; ++m)
#pragma unroll
                        for (int n = 0; n < 2; ++n) { const int o_ = (m * 2 + n) * 4; acc[a][b][m][n] = (f32x4){accq[a][b][o_], accq[a][b][o_ + 1], accq[a][b][o_ + 2], accq[a][b][o_ + 3]}; } }
        if constexpr (!Epi::AFTER_DRAIN) { E(acc, cur, wr, wc, fr, fq); S.done(cur); }
        if (!has_next) break;
#pragma unroll
        for (int a = 0; a < 2; ++a)
#pragma unroll
            for (int b = 0; b < 2; ++b)
#pragma unroll
                for (int m = 0; m < 4; ++m)
#pragma unroll
                    for (int n = 0; n < 2; ++n) acc[a][b][m][n] = (f32x4){0.f, 0.f, 0.f, 0.f};
        if constexpr (DT == 1) {
#pragma unroll
            for (int a = 0; a < 2; ++a)
#pragma unroll
                for (int b = 0; b < 2; ++b)
#pragma unroll
                    for (int i = 0; i < 32; ++i) accq[a][b][i] = 0.f; }
        cur = nxt; cA = nA; cB = nB; ++ui;
        if constexpr (ALIGN_EPI) { if (wr == 1) PG8_BAR; }
    }
    PG8_WAIT_V(0);
    if constexpr (!ALIGN_EPI) { if (wr == 0) PG8_BAR; }
    PG8_BAR;
    if constexpr (Epi::AFTER_DRAIN) { E.fused(acc, cur, wr, wc, fr, fq, lds, wid, lane); S.done(cur); }
#undef PG8_SA
#undef PG8_SB
#undef PG8_STAGE
#undef PG8_LDA
#undef PG8_LDB
#undef PG8_MMA
#undef PG8_WAIT_V
#undef PG8_WAIT_L
#undef PG8_BAR
#undef PG8_SCHED
}
}

constexpr int NWAVES = 8, NTHREADS = 512;
constexpr int DM = 2048, NBATCH = 8, SEQ = 4096, MTOK = NBATCH * SEQ, FF = 5632, DEPTH = 4;
constexpr float NORM_EPS = 1e-6f;
constexpr int ML_H = 8, ML_DK = 128, ML_DV = 256, ML_L = 64, ML_NC = SEQ / ML_L, ML_INCOLS = 6160, ML_NPAD = 6400, ML_ITEMS = NBATCH * ML_H * ML_NC;
constexpr int AT_DH = 64, AT_HQ = 32, AT_HKV = 4, AT_G = 8, AT_BLK = 128, AT_NB = SEQ / AT_BLK, AT_COLS = 2560, AT_UNITS = NBATCH * AT_NB * AT_HKV;
constexpr int RW_H = 32, RW_N = 64, RW_T = 32, RW_NBLK = SEQ / RW_T;
constexpr float RW_LN_EPS = 64e-5f;
enum { I_X = 0, I_POS, I_F1N, I_F1GU, I_F1DN, I_MN, I_F2N, I_F2GU, I_F2DN, I_MLWIN, I_MLBG, I_MLHG, I_MLWOUT, I_ATQKV, I_ATQG, I_ATKG, I_ATSINK, I_ATWO,
       I_RWMIX, I_RWRKV, I_RWW0, I_RWWLA, I_RWWLB, I_RWA0, I_RWALA, I_RWALB, I_RWGLA, I_RWGLB, I_RWKK, I_RWKA, I_RWRK, I_RWLNW, I_RWLNB, I_RWWO, N_IN };
constexpr size_t MiB = 1u << 20;
constexpr size_t WS_CTL = 0, CTL_ZERO_BYTES = 1 * MiB;
constexpr size_t WS_ROPE = 2 * MiB;
constexpr size_t WS_GATES = 4 * MiB;
constexpr size_t WS_STAT = 6 * MiB;
constexpr size_t WS_MST = 6 * MiB + 65536;
constexpr size_t WS_NV = 8 * MiB;
constexpr size_t WS_ROWQ = 10 * MiB;
constexpr int CW_CMAX = 65536;
constexpr int CW_CMAX2 = 65536 + 8 * 11264;
constexpr size_t WS_CSTEP2 = 11 * MiB + 512 * 1024;
constexpr size_t WS_CSTEP = 11 * MiB;
constexpr size_t WS_WGU1 = 16 * MiB, WS_WDN1 = 60 * MiB, WS_WGU2 = 82 * MiB, WS_WDN2 = 126 * MiB, WS_WMIX = 148 * MiB;
constexpr size_t WS_XN = 192 * MiB;
constexpr size_t WS_BIG = 320 * MiB;
constexpr size_t WS_END = WS_BIG + 1152 * MiB;
constexpr int CW_BAR = 4096;

#define GAS __attribute__((address_space(1)))
#define LAS __attribute__((address_space(3)))
typedef unsigned short bf16;
typedef unsigned v4u __attribute__((ext_vector_type(4)));
typedef unsigned v2u __attribute__((ext_vector_type(2)));
typedef float f32x4 __attribute__((ext_vector_type(4)));
typedef float f32x2 __attribute__((ext_vector_type(2)));
typedef float f32x16 __attribute__((ext_vector_type(16)));
typedef short bf16x8 __attribute__((ext_vector_type(8)));
typedef short s16x4 __attribute__((ext_vector_type(4)));
#define LDS_WAIT() asm volatile("s_waitcnt lgkmcnt(0)" ::: "memory")
#define VM_WAIT() asm volatile("s_waitcnt vmcnt(0)" ::: "memory")
#define MFMA32(a, b, c) __builtin_amdgcn_mfma_f32_32x32x16_bf16((a), (b), (c), 0, 0, 0)
__device__ __forceinline__ unsigned pk2(float lo, float hi) { return pg8::cvt_pk_bf16(lo, hi); }
__device__ __forceinline__ float bf2f(unsigned short h) { return __builtin_bit_cast(float, (unsigned)h << 16); }
__device__ __forceinline__ float bflo(unsigned w) { return __builtin_bit_cast(float, w << 16); }
__device__ __forceinline__ float bfhi(unsigned w) { return __builtin_bit_cast(float, w & 0xffff0000u); }
__device__ __forceinline__ unsigned short f2bf(float f) { return (unsigned short)(pk2(f, 0.f) & 0xffffu); }
__device__ __forceinline__ float wave_sum(float v) {
#pragma unroll
    for (int o = 1; o < 64; o <<= 1) v += __shfl_xor(v, o);
    return v;
}
__device__ __forceinline__ float wave_max(float v) {
#pragma unroll
    for (int o = 1; o < 64; o <<= 1) v = fmaxf(v, __shfl_xor(v, o));
    return v;
}

template <int CTRL, int RM> __device__ __forceinline__ float dpp_upd(float x) { return __builtin_bit_cast(float, __builtin_amdgcn_update_dpp(0, __builtin_bit_cast(int, x), CTRL, RM, 0xf, false)); }
__device__ __forceinline__ float wave_sum_dpp(float x) {
    x += dpp_upd<0xB1, 0xf>(x); x += dpp_upd<0x4E, 0xf>(x); x += dpp_upd<0x141, 0xf>(x); x += dpp_upd<0x140, 0xf>(x);
    x += dpp_upd<0x142, 0xa>(x); x += dpp_upd<0x143, 0xc>(x);
    return __builtin_bit_cast(float, __builtin_amdgcn_readlane(__builtin_bit_cast(int, x), 63));
}
__device__ __forceinline__ int crow(int reg, int h) { return (reg & 3) + 8 * (reg >> 2) + 4 * h; }
#define XB_TMO      128
#define XB_XCNT(j)  (256  + 64 * (j))
#define XB_XSUB(j)  (1280 + 64 * (j))
#define XB_XGEN(j)  (2304 + 64 * (j))
#define XB_TOP      3328
#define XB_TOPGEN   3392
#define XCD_BAR_WORDS 3456
#define XB_SPIN_CAP (1u << 18)

__device__ __forceinline__ unsigned xb_ld(unsigned* p)              { return __hip_atomic_load(p, __ATOMIC_RELAXED, __HIP_MEMORY_SCOPE_AGENT); }
__device__ __forceinline__ unsigned xb_add(unsigned* p, unsigned v) { return __hip_atomic_fetch_add(p, v, __ATOMIC_RELAXED, __HIP_MEMORY_SCOPE_AGENT); }
__device__ __forceinline__ unsigned xb_xcc_id() { return (unsigned)__builtin_amdgcn_s_getreg((3 << 11) | 20) & 0xFu; }
#define XB_SPIN(cond, bar) do { unsigned _sp = 0; while (cond) { __builtin_amdgcn_s_sleep(1); \
    if ((++_sp & 255u) == 0u) { if (xb_ld(&(bar)[XB_TMO])) break; if (_sp > XB_SPIN_CAP) { atomicAdd(&(bar)[XB_TMO], 1u); break; } } } } while (0)

struct XcdBarrier {
    unsigned* bar; unsigned x;
    volatile LAS unsigned* st;
};

__device__ __forceinline__ XcdBarrier xcd_barrier_post(unsigned* bar, volatile LAS unsigned* st) {
    XcdBarrier b; b.bar = bar; b.x = xb_xcc_id(); b.st = st;
    if (threadIdx.x == 0) (void)xb_add(&bar[XB_XCNT(b.x)], 1u);
    return b;
}
__device__ __forceinline__ void xcd_barrier_complete(unsigned* bar, unsigned x, unsigned& nloc, unsigned& nx) {
    const unsigned G = gridDim.x * gridDim.y * gridDim.z;
    unsigned sum, cnt, mine, sp = 0u;
    for (;;) {
        sum = 0u; cnt = 0u; mine = 0u;
#pragma unroll
        for (unsigned j = 0; j < 16; ++j) { const unsigned c = xb_ld(&bar[XB_XCNT(j)]); sum += c; cnt += (c > 0u) ? 1u : 0u; mine = (j == x) ? c : mine; }
        if (sum == G) break;
        __builtin_amdgcn_s_sleep(1);
        if ((++sp & 255u) == 0u) { if (xb_ld(&bar[XB_TMO])) break; if (sp > XB_SPIN_CAP) { atomicAdd(&bar[XB_TMO], 1u); break; } }
    }
    nloc = mine > 0u ? mine : 1u; nx = cnt > 0u ? cnt : 1u;
}

__device__ __forceinline__ void xcd_barrier(const XcdBarrier& b) {
    asm volatile("s_waitcnt vmcnt(0)" ::: "memory");
    __syncthreads();
    if (threadIdx.x == 0) {
        unsigned* bar = b.bar;
        __builtin_amdgcn_s_waitcnt(0);
        unsigned nloc = b.st[0], nx = b.st[1];
        if (nloc == 0u) { xcd_barrier_complete(bar, b.x, nloc, nx); b.st[0] = nloc; b.st[1] = nx; }
        const unsigned old = xb_add(&bar[XB_XSUB(b.x)], 1u);
        const unsigned gen = old / nloc;
        if (old + 1u == (gen + 1u) * nloc) {
            __builtin_amdgcn_fence(__ATOMIC_RELEASE, "agent");
            asm volatile("s_waitcnt vmcnt(0)" ::: "memory");
            const unsigned og = xb_add(&bar[XB_TOP], 1u);
            const unsigned tg = og / nx;
            if (og + 1u == (tg + 1u) * nx) xb_add(&bar[XB_TOPGEN], 1u);
            else XB_SPIN(xb_ld(&bar[XB_TOPGEN]) == tg, bar);
            __builtin_amdgcn_fence(__ATOMIC_ACQUIRE, "agent");
            xb_add(&bar[XB_XGEN(b.x)], 1u);
            asm volatile("s_waitcnt vmcnt(0)" ::: "memory");
        } else {
            XB_SPIN(xb_ld(&bar[XB_XGEN(b.x)]) == gen, bar);
            __builtin_amdgcn_fence(__ATOMIC_ACQUIRE, "agent");
            asm volatile("s_waitcnt vmcnt(0)" ::: "memory");
        }
    }
    __syncthreads();
}

struct Args { const float* in[N_IN]; float* out; unsigned char* ws; int ph_lo, ph_hi; };
struct Frame { LAS unsigned char* lds; int tid, lane, wave, G, bid; };

__device__ __forceinline__ void transpose_item(const float* W, int ldw, bf16* WT, int ldt, int k0, int n0, int dst_row0, LAS float* scr, int lane) {
#pragma unroll 8
    for (int i = 0; i < 32; ++i) { const int kk = 2 * i + (lane >> 5); scr[kk * 33 + (lane & 31)] = W[(size_t)(k0 + kk) * ldw + n0 + (lane & 31)]; }
    LDS_WAIT(); asm volatile("" ::: "memory");
    const int c = lane & 7;
#pragma unroll
    for (int j = 0; j < 4; ++j) { const int n = (lane >> 3) + 8 * j; const LAS float* s = scr + (8 * c) * 33 + n;
        v4u o; o.x = pk2(s[0 * 33], s[1 * 33]); o.y = pk2(s[2 * 33], s[3 * 33]); o.z = pk2(s[4 * 33], s[5 * 33]); o.w = pk2(s[6 * 33], s[7 * 33]);
        *(v4u*)(WT + (size_t)(dst_row0 + n) * ldt + k0 + 8 * c) = o; }
    LDS_WAIT(); asm volatile("" ::: "memory");
}
__device__ __forceinline__ void transpose_item_f8(const float* W, int ldw, unsigned char* WT, int ldt, int k0, int n0, int dst_row0, LAS float* scr, int lane, float scale) {
#pragma unroll 8
    for (int i = 0; i < 32; ++i) { const int kk = 2 * i + (lane >> 5); scr[kk * 33 + (lane & 31)] = __builtin_amdgcn_fmed3f(W[(size_t)(k0 + kk) * ldw + n0 + (lane & 31)] * scale, -448.f, 448.f); }
    LDS_WAIT(); asm volatile("" ::: "memory");
    const int c = lane & 7;
#pragma unroll
    for (int j = 0; j < 4; ++j) { const int n = (lane >> 3) + 8 * j; const LAS float* s = scr + (8 * c) * 33 + n; unsigned w0 = 0u, w1 = 0u;
        w0 = __builtin_amdgcn_cvt_pk_fp8_f32(s[0 * 33], s[1 * 33], w0, false); w0 = __builtin_amdgcn_cvt_pk_fp8_f32(s[2 * 33], s[3 * 33], w0, true);
        w1 = __builtin_amdgcn_cvt_pk_fp8_f32(s[4 * 33], s[5 * 33], w1, false); w1 = __builtin_amdgcn_cvt_pk_fp8_f32(s[6 * 33], s[7 * 33], w1, true);
        *(v2u*)(WT + (size_t)(dst_row0 + n) * ldt + k0 + 8 * c) = (v2u){w0, w1}; }
    LDS_WAIT(); asm volatile("" ::: "memory");
}
__device__ __forceinline__ void colmax_pass(Frame& F, const float* W, int K, int N, int ldw, unsigned* cmax) {
    const int nit = N * (K / 128);
    for (int it = F.bid * NTHREADS + F.tid; it < nit; it += F.G * NTHREADS) { const int n = it % N, k0 = (it / N) * 128; const float* p = W + (size_t)k0 * ldw + n; float m = 0.f;
#pragma unroll 8
        for (int k = 0; k < 128; ++k) m = fmaxf(m, fabsf(p[(size_t)k * ldw]));
        atomicMax(cmax + n, __builtin_bit_cast(unsigned, m)); }
}
__device__ __forceinline__ void colmax_wide(Frame& F, const float* W, int K, int N, unsigned* cmax, int ldw = 0) {
    LAS float* red = (LAS float*)F.lds;
    const int ncb = N / 256, nit = ncb * (K / 128), pitch = ldw ? ldw : N;
    for (int it = F.bid; it < nit; it += F.G) { const int cb = it % ncb, k0 = (it / ncb) * 128 + F.wave * 16;
        const f32x4* p = (const f32x4*)(W + (size_t)k0 * pitch + cb * 256) + F.lane; f32x4 m = {0.f, 0.f, 0.f, 0.f};
#pragma unroll
        for (int k = 0; k < 16; ++k) { const f32x4 v = p[(size_t)k * (pitch / 4)]; m.x = fmaxf(m.x, fabsf(v.x)); m.y = fmaxf(m.y, fabsf(v.y)); m.z = fmaxf(m.z, fabsf(v.z)); m.w = fmaxf(m.w, fabsf(v.w)); }
        *(LAS f32x4*)(red + F.wave * 256 + 4 * F.lane) = m;
        __syncthreads();
        if (F.tid < 256) { float r = red[F.tid];
#pragma unroll
            for (int w = 1; w < 8; ++w) r = fmaxf(r, red[w * 256 + F.tid]);
            atomicMax(cmax + cb * 256 + F.tid, __builtin_bit_cast(unsigned, r)); }
        __syncthreads(); }
}
__device__ __forceinline__ unsigned pack_i8x4(float a, float b, float c, float d) {
    const int ia = (int)rintf(a), ib = (int)rintf(b), ic = (int)rintf(c), id = (int)rintf(d);
    return (unsigned)(ia & 0xff) | ((unsigned)(ib & 0xff) << 8) | ((unsigned)(ic & 0xff) << 16) | ((unsigned)(id & 0xff) << 24);
}
__device__ __forceinline__ void conv_small_i8(Frame& F, const float* W, int ldw, int col_off, int K, int Nsrc, unsigned char* WT, int rows, const unsigned* cmax, float* cstep) {
    const int gt = F.bid * NTHREADS + F.tid, NT = F.G * NTHREADS;
    for (int idx = gt; idx < rows * (K / 4); idx += NT) { const int n = idx / (K / 4), k = 4 * (idx - n * (K / 4)); unsigned w = 0u;
        if (n < Nsrc) { const float cm = fmaxf(__builtin_bit_cast(float, __hip_atomic_load(cmax + col_off + n, __ATOMIC_RELAXED, __HIP_MEMORY_SCOPE_AGENT)), 1e-30f), sc = 127.0f / cm; const float* p = W + (size_t)k * ldw + col_off + n;
            w = pack_i8x4(p[0] * sc, p[ldw] * sc, p[2 * (size_t)ldw] * sc, p[3 * (size_t)ldw] * sc); if (k == 0) cstep[col_off + n] = cm * (1.0f / 127.0f); }
        else if (k == 0) cstep[col_off + n] = 1.0f;
        *(unsigned*)(WT + (size_t)n * K + k) = w; }
}
template <int MAP>
__device__ __forceinline__ void conv_T_i8(Frame& F, const float* W, int K, int N, int ldw, unsigned char* WT, const unsigned* cmax, float* cstep) {
    LAS float* scr = (LAS float*)(F.lds + F.wave * 16384);
    const int gw = F.bid * NWAVES + F.wave, NGW = F.G * NWAVES, nblk = N / 32, nitems = (K / 64) * nblk, lane = F.lane;
    for (int it = gw; it < nitems; it += NGW) { const int n0 = 32 * (it % nblk), k0 = 64 * (it / nblk); const int jj = n0 < FF ? n0 : n0 - FF; const int dr = MAP == 1 ? (jj >> 7) * 256 + (n0 < FF ? 0 : 128) + (jj & 127) : n0;
        const float cm = fmaxf(__builtin_bit_cast(float, __hip_atomic_load(cmax + n0 + (lane & 31), __ATOMIC_RELAXED, __HIP_MEMORY_SCOPE_AGENT)), 1e-30f), scale = 127.0f / cm;
        if (k0 == 0 && lane < 32) cstep[dr + lane] = cm * (1.0f / 127.0f);
#pragma unroll 8
        for (int i = 0; i < 32; ++i) { const int kk = 2 * i + (lane >> 5); scr[kk * 33 + (lane & 31)] = W[(size_t)(k0 + kk) * ldw + n0 + (lane & 31)] * scale; }
        LDS_WAIT(); asm volatile("" ::: "memory");
        const int c = lane & 7;
#pragma unroll
        for (int j = 0; j < 4; ++j) { const int n = (lane >> 3) + 8 * j; const LAS float* s = scr + (8 * c) * 33 + n;
            *(v2u*)(WT + (size_t)(dr + n) * K + k0 + 8 * c) = (v2u){pack_i8x4(s[0 * 33], s[1 * 33], s[2 * 33], s[3 * 33]), pack_i8x4(s[4 * 33], s[5 * 33], s[6 * 33], s[7 * 33])}; }
        LDS_WAIT(); asm volatile("" ::: "memory"); }
}
template <int MAP>
__device__ __forceinline__ void conv_T_f8(Frame& F, const float* W, int K, int N, unsigned char* WT, float scale) {
    LAS float* scr = (LAS float*)(F.lds + F.wave * 16384);
    const int gw = F.bid * NWAVES + F.wave, NGW = F.G * NWAVES, nblk = N / 32, nitems = (K / 64) * nblk;
    for (int it = gw; it < nitems; it += NGW) { const int n0 = 32 * (it % nblk); int dr = n0;
        if (MAP == 1) { const int jj = n0 < FF ? n0 : n0 - FF; dr = (jj >> 7) * 256 + (n0 < FF ? 0 : 128) + (jj & 127); }
        transpose_item_f8(W, N, WT, K, 64 * (it / nblk), n0, dr, scr, F.lane, scale); }
}
template <int MAP>
__device__ __forceinline__ void conv_T(Frame& F, const float* W, int K, int Nuse, int ldw, bf16* WT, int row_off) {
    LAS float* scr = (LAS float*)(F.lds + F.wave * 16384);
    const int gw = F.bid * NWAVES + F.wave, NGW = F.G * NWAVES, nblk = Nuse / 32, nitems = (K / 64) * nblk;
    for (int it = gw; it < nitems; it += NGW) { const int kb = it / nblk, n0 = 32 * (it % nblk); int dr;
        if (MAP == 1) { const int jj = n0 < FF ? n0 : n0 - FF; dr = (jj >> 7) * 256 + (n0 < FF ? 0 : 128) + (jj & 127); } else dr = row_off + n0;
        transpose_item(W, ldw, WT, K, 64 * kb, n0, dr, scr, F.lane); }
}
__device__ __forceinline__ void conv_small(Frame& F, const float* W, int ldw, int col_off, int Ksrc, int Nsrc, bf16* WT, int rows, int cols) {
    const int gt = F.bid * NTHREADS + F.tid, NT = F.G * NTHREADS;
    for (int idx = gt; idx < rows * cols; idx += NT) { const int n = idx / cols, k = idx - n * cols; const float v = (n < Nsrc && k < Ksrc) ? W[(size_t)k * ldw + col_off + n] : 0.f; WT[idx] = f2bf(v); }
}
template <class AT_>
__device__ __forceinline__ void conv_phase(const AT_& a, Frame& F, int l, bool f8dn1, bool f8dn2, bool f8gu1, bool f8gu2, bool i8gu1, bool i8gu2, bool i8mix) {
    unsigned char* ws = a.ws;
    if (i8gu1) conv_T_i8<1>(F, a.in[I_F1GU] + (size_t)l * DM * 2 * FF, DM, 2 * FF, 2 * FF, ws + WS_WGU1, (const unsigned*)(ws + WS_CTL) + CW_CMAX + (2 * l) * 2 * FF, (float*)(ws + WS_CSTEP) + (2 * l) * 2 * FF);
    else if (f8gu1) conv_T_f8<1>(F, a.in[I_F1GU] + (size_t)l * DM * 2 * FF, DM, 2 * FF, ws + WS_WGU1, pg8::W8_SCALE);
    else conv_T<1>(F, a.in[I_F1GU] + (size_t)l * DM * 2 * FF, DM, 2 * FF, 2 * FF, (bf16*)(ws + WS_WGU1), 0);
    if (f8dn1) conv_T_f8<0>(F, a.in[I_F1DN] + (size_t)l * FF * DM, FF, DM, ws + WS_WDN1, pg8::W8_SCALE);
    else conv_T<0>(F, a.in[I_F1DN] + (size_t)l * FF * DM, FF, DM, DM, (bf16*)(ws + WS_WDN1), 0);
    if (i8gu2) conv_T_i8<1>(F, a.in[I_F2GU] + (size_t)l * DM * 2 * FF, DM, 2 * FF, 2 * FF, ws + WS_WGU2, (const unsigned*)(ws + WS_CTL) + CW_CMAX + (2 * l + 1) * 2 * FF, (float*)(ws + WS_CSTEP) + (2 * l + 1) * 2 * FF);
    else if (f8gu2) conv_T_f8<1>(F, a.in[I_F2GU] + (size_t)l * DM * 2 * FF, DM, 2 * FF, ws + WS_WGU2, pg8::W8_SCALE);
    else conv_T<1>(F, a.in[I_F2GU] + (size_t)l * DM * 2 * FF, DM, 2 * FF, 2 * FF, (bf16*)(ws + WS_WGU2), 0);
    if (f8dn2) conv_T_f8<0>(F, a.in[I_F2DN] + (size_t)l * FF * DM, FF, DM, ws + WS_WDN2, pg8::W8_SCALE);
    else conv_T<0>(F, a.in[I_F2DN] + (size_t)l * FF * DM, FF, DM, DM, (bf16*)(ws + WS_WDN2), 0);
    bf16* WA = (bf16*)(ws + WS_WMIX); bf16* WO = (bf16*)(ws + WS_WMIX + 26 * MiB);
    const int kind = l % 3, j = l / 3;
    if (kind == 0) {
        const float* win = a.in[I_MLWIN] + (size_t)j * DM * ML_INCOLS;
        if (i8mix) { const unsigned* cm = (const unsigned*)(ws + WS_CTL) + CW_CMAX2 + 6400 * l; float* cs = (float*)(ws + WS_CSTEP2) + 6400 * l;
            conv_T_i8<0>(F, win, DM, 6144, ML_INCOLS, (unsigned char*)WA, cm, cs);
            conv_small_i8(F, win, ML_INCOLS, 6144, DM, 16, (unsigned char*)WA + (size_t)6144 * DM, 256, cm, cs); }
        else { conv_T<0>(F, win, DM, 6144, ML_INCOLS, WA, 0);
        conv_small(F, win, ML_INCOLS, 6144, DM, 16, WA + (size_t)6144 * DM, 256, DM); }
        conv_T<0>(F, a.in[I_MLWOUT] + (size_t)j * DM * DM, DM, DM, DM, WO, 0);
    } else if (kind == 1) {
        if (i8mix) conv_T_i8<0>(F, a.in[I_ATQKV] + (size_t)j * DM * AT_COLS, DM, AT_COLS, AT_COLS, (unsigned char*)WA, (const unsigned*)(ws + WS_CTL) + CW_CMAX2 + 6400 * l, (float*)(ws + WS_CSTEP2) + 6400 * l);
        else conv_T<0>(F, a.in[I_ATQKV] + (size_t)j * DM * AT_COLS, DM, AT_COLS, AT_COLS, WA, 0);
        conv_T<0>(F, a.in[I_ATWO] + (size_t)j * DM * DM, DM, DM, DM, WO, 0);
    } else {
        for (int z = 0; z < 3; ++z) conv_T<0>(F, a.in[I_RWRKV] + ((size_t)j * 3 + z) * DM * DM, DM, DM, DM, WA, z * DM);
        bf16* WLA = WA + (size_t)6144 * DM;
        conv_small(F, a.in[I_RWWLA] + (size_t)j * DM * 96, 96, 0, DM, 96, WLA, 256, DM);
        conv_small(F, a.in[I_RWALA] + (size_t)j * DM * 96, 96, 0, DM, 96, WLA + (size_t)256 * DM, 256, DM);
        conv_small(F, a.in[I_RWGLA] + (size_t)j * DM * 256, 256, 0, DM, 256, WLA + (size_t)512 * DM, 256, DM);
        bf16* WLB = (bf16*)(ws + WS_WMIX + 28 * MiB);
        conv_small(F, a.in[I_RWWLB] + (size_t)j * 96 * DM, DM, 0, 96, DM, WLB, DM, 256);
        conv_small(F, a.in[I_RWALB] + (size_t)j * 96 * DM, DM, 0, 96, DM, WLB + (size_t)DM * 256, DM, 256);
        conv_small(F, a.in[I_RWGLB] + (size_t)j * 256 * DM, DM, 0, 256, DM, WLB + (size_t)2 * DM * 256, DM, 256);
        conv_T<0>(F, a.in[I_RWWO] + (size_t)j * DM * DM, DM, DM, DM, (bf16*)(ws + WS_WMIX + 32 * MiB), 0);
    }
}

template <bool SB> __device__ __forceinline__ void load_row(const void* xin, size_t row, int lane, f32x4 (&v)[8]) {
    if (SB) { typedef _Float16 h16x4_t __attribute__((ext_vector_type(4))); const h16x4_t* xr = (const h16x4_t*)((const bf16*)xin + row * DM) + lane;
#pragma unroll
        for (int q = 0; q < 8; ++q) { const h16x4_t w = xr[64 * q]; v[q] = (f32x4){(float)w[0], (float)w[1], (float)w[2], (float)w[3]}; } }
    else { const f32x4* xr = (const f32x4*)((const float*)xin + row * DM) + lane;
#pragma unroll
        for (int q = 0; q < 8; ++q) v[q] = xr[64 * q]; }
}
template <int MODE, bool SB, int F8 = 0, class AT_>
__device__ __forceinline__ void norm_phase(const AT_& a, Frame& F, const void* xin, const float* gain, int j) {
    unsigned char* ws = a.ws; const int lane = F.lane;
    const int gw = F.bid * NWAVES + F.wave, NGW = F.G * NWAVES;
    f32x4 gn[8];
#pragma unroll
    for (int q = 0; q < 8; ++q) gn[q] = *(const f32x4*)(gain + 4 * lane + 256 * q);
    if (MODE != 2) {
        bf16* xn = (bf16*)(ws + WS_XN);
        for (int row = gw; row < MTOK; row += NGW) {
            f32x4 v[8]; float ss = 0.f; load_row<SB>(xin, (size_t)row, lane, v);
#pragma unroll
            for (int q = 0; q < 8; ++q) ss += (v[q].x * v[q].x + v[q].y * v[q].y) + (v[q].z * v[q].z + v[q].w * v[q].w);
            const float rstd = 1.0f / sqrtf(wave_sum(ss) * (1.0f / DM) + NORM_EPS);
            if (F8 == 2) { unsigned* o4 = (unsigned*)((unsigned char*)xn + (size_t)row * DM) + lane; float mx = 0.f;
#pragma unroll
                for (int q = 0; q < 8; ++q) { v[q] = v[q] * rstd * gn[q]; mx = fmaxf(fmaxf(mx, fmaxf(fabsf(v[q].x), fabsf(v[q].y))), fmaxf(fabsf(v[q].z), fabsf(v[q].w))); }
                mx = fmaxf(wave_max(mx), 1e-30f); const float qs = 127.0f / mx;
#pragma unroll
                for (int q = 0; q < 8; ++q) o4[64 * q] = pack_i8x4(v[q].x * qs, v[q].y * qs, v[q].z * qs, v[q].w * qs);
                if (lane == 0) ((float*)(ws + WS_ROWQ))[row] = mx * (1.0f / 127.0f); }
            else if (F8 == 1) { unsigned* o4 = (unsigned*)((unsigned char*)xn + (size_t)row * DM) + lane;
#pragma unroll
                for (int q = 0; q < 8; ++q) { const f32x4 y = v[q] * (rstd * pg8::X8_SCALE) * gn[q]; unsigned w = 0u;
                    w = __builtin_amdgcn_cvt_pk_fp8_f32(__builtin_amdgcn_fmed3f(y.x, -448.f, 448.f), __builtin_amdgcn_fmed3f(y.y, -448.f, 448.f), w, false);
                    w = __builtin_amdgcn_cvt_pk_fp8_f32(__builtin_amdgcn_fmed3f(y.z, -448.f, 448.f), __builtin_amdgcn_fmed3f(y.w, -448.f, 448.f), w, true); o4[64 * q] = w; } }
            else { v2u* o8 = (v2u*)(xn + (size_t)row * DM) + lane;
#pragma unroll
                for (int q = 0; q < 8; ++q) { const f32x4 y = v[q] * rstd * gn[q]; v2u w; w.x = pk2(y.x, y.y); w.y = pk2(y.z, y.w); o8[64 * q] = w; } }
            if (MODE == 1 && lane < 8) {
                const int pos = ((const int*)a.in[I_POS])[row];
                const float inv_freq = powf(500000.0f, -(float)(2 * lane) / 16.0f); const float ang = (float)pos * inv_freq;
                const double rev = (double)ang * 0.15915494309189535; const float fr = (float)(rev - floor(rev));
                float* rp = (float*)(ws + WS_ROPE) + (size_t)row * 16; rp[lane] = __builtin_amdgcn_cosf(fr); rp[8 + lane] = __builtin_amdgcn_sinf(fr);
            }
        }
    } else {
        LAS float* mixs = (LAS float*)F.lds; const float* mix = a.in[I_RWMIX] + (size_t)j * 6 * DM;
        for (int i = F.tid; i < 6 * DM; i += NTHREADS) mixs[i] = mix[i];
        __syncthreads();
        bf16* xm = (bf16*)(ws + WS_BIG);
        for (int blk = gw; blk < MTOK / 16; blk += NGW) {
            const int row0 = blk * 16; f32x4 prev[8];
            if ((row0 % SEQ) == 0) {
#pragma unroll
                for (int q = 0; q < 8; ++q) prev[q] = (f32x4){0.f, 0.f, 0.f, 0.f};
            } else {
                float ss = 0.f; load_row<SB>(xin, (size_t)(row0 - 1), lane, prev);
#pragma unroll
                for (int q = 0; q < 8; ++q) ss += (prev[q].x * prev[q].x + prev[q].y * prev[q].y) + (prev[q].z * prev[q].z + prev[q].w * prev[q].w);
                const float rstd = 1.0f / sqrtf(wave_sum(ss) * (1.0f / DM) + NORM_EPS);
#pragma unroll
                for (int q = 0; q < 8; ++q) prev[q] = prev[q] * rstd * gn[q];
            }
            for (int rr = 0; rr < 16; ++rr) {
                const int row = row0 + rr; f32x4 v[8]; float ss = 0.f; load_row<SB>(xin, (size_t)row, lane, v);
#pragma unroll
                for (int q = 0; q < 8; ++q) ss += (v[q].x * v[q].x + v[q].y * v[q].y) + (v[q].z * v[q].z + v[q].w * v[q].w);
                const float rstd = 1.0f / sqrtf(wave_sum(ss) * (1.0f / DM) + NORM_EPS);
#pragma unroll
                for (int q = 0; q < 8; ++q) v[q] = v[q] * rstd * gn[q];
#pragma unroll 1
                for (int z = 0; z < 6; ++z) { v2u* o8 = (v2u*)(xm + ((size_t)z * MTOK + row) * DM) + lane;
#pragma unroll
                    for (int q = 0; q < 8; ++q) { const f32x4 mx = *(const LAS f32x4*)(mixs + z * DM + 4 * lane + 256 * q); const f32x4 y = v[q] + (prev[q] - v[q]) * mx;
                        v2u w; w.x = pk2(y.x, y.y); w.y = pk2(y.z, y.w); o8[64 * q] = w; } }
#pragma unroll
                for (int q = 0; q < 8; ++q) prev[q] = v[q];
            }
        }
    }
}
__device__ __forceinline__ float log_sigmoid(float x) { return fminf(x, 0.f) - __logf(1.0f + __expf(-fabsf(x))); }
__device__ __forceinline__ float wave_incl_scan(float v, int lane) {
#pragma unroll
    for (int o = 1; o < 64; o <<= 1) { const float n = __shfl_up(v, o); if (lane >= o) v += n; }
    return v;
}
#define WG_BAR() do { asm volatile("s_waitcnt lgkmcnt(0)" ::: "memory"); __builtin_amdgcn_s_barrier(); asm volatile("" ::: "memory"); } while (0)
template <class AT_>
__device__ __forceinline__ void mlstm_phase_ab(const AT_& a, Frame& F, int j) {
    unsigned char* ws = a.ws; const int tid = F.tid, lane = F.lane, w = F.wave, r = lane & 31, hh = lane >> 5;
    const bf16* QKVO = (const bf16*)(ws + WS_BIG); const float* GT = (const float*)(ws + WS_GATES);
    bf16* UC = (bf16*)(ws + WS_BIG + 384 * MiB); float* NV = (float*)(ws + WS_NV); float* MST = (float*)(ws + WS_MST);
    const float* bg = a.in[I_MLBG] + j * 16;
    LAS bf16* Vwt = (LAS bf16*)F.lds; LAS bf16* Kt = (LAS bf16*)(F.lds + 9216);
    LAS float* WQ = (LAS float*)(F.lds + 65536); LAS float* GS = (LAS float*)(F.lds + 65536 + 16384);
    const float kscale = 0.08838834764831845f;
    const int vb = w & 1, kb = w >> 1;
    for (int u = F.bid; u < NBATCH * ML_H * 4; u += F.G) {
        const int qd = (u >> 3) & 3, bh = (u & 7) + 8 * (u >> 5), b = bh >> 3, h = bh & 7;
        const float bgi = bg[h], bgf = bg[8 + h];
        v4u xvA, xvB, xvC, xvD, xkA0, xkA1, xkB0, xkB1, xkC0, xkC1, xkD0, xkD1;
#define MLAB_LOAD(CC, XV, XK0, XK1) do { const bf16* rowp = QKVO + (size_t)(b * SEQ + (CC) * ML_L + lane) * 6144; \
            XV = *(const v4u*)(rowp + 2048 + h * 256 + 64 * qd + 8 * w); XK0 = *(const v4u*)(rowp + 1024 + h * 128 + 8 * w); XK1 = *(const v4u*)(rowp + 1024 + h * 128 + 8 * (w + 8)); } while (0)
        MLAB_LOAD(0, xvA, xkA0, xkA1); MLAB_LOAD(1, xvB, xkB0, xkB1); MLAB_LOAD(2, xvC, xkC0, xkC1); MLAB_LOAD(3, xvD, xkD0, xkD1);
#pragma unroll
        for (int k = 0; k < 8; ++k) { const int cc = 8 * w + k; const size_t t = (size_t)(b * SEQ + cc * ML_L + lane) * 16;
            const float li = GT[t + h] + bgi; const float lf = log_sigmoid(GT[t + 8 + h] + bgf);
            const float bs = wave_incl_scan(lf, lane); const float g = __shfl(bs, 63); const float lw = g - bs + li; const float am = wave_max(lw);
            WQ[cc * 64 + lane] = __expf(lw - am);
            if (lane == 0) { GS[2 * cc] = g; GS[2 * cc + 1] = am; } }
        f32x16 Cst; float m = 0.f, nn = 0.f;
#pragma unroll
        for (int i = 0; i < 16; ++i) Cst[i] = 0.f;
        WG_BAR();
#define MLAB_CHUNK(CC, XV, XK0, XK1) do { const int c_ = (CC), it = bh * ML_NC + c_; LAS bf16* Vw = Vwt + (c_ & 1) * 14336; LAS bf16* Kk = Kt + (c_ & 1) * 14336; const LAS float* wqc = WQ + c_ * 64; \
            {   const float wsv = wqc[lane];        \
                _Pragma("unroll") for (int e = 0; e < 4; ++e) { const unsigned wd = XV[e]; Vw[(8 * w + 2 * e) * 72 + lane] = f2bf(bflo(wd) * wsv); Vw[(8 * w + 2 * e + 1) * 72 + lane] = f2bf(bfhi(wd) * wsv); } \
                _Pragma("unroll") for (int e = 0; e < 4; ++e) { const unsigned wd = XK0[e]; Kk[(8 * w + 2 * e) * 72 + lane] = f2bf(bflo(wd) * kscale); Kk[(8 * w + 2 * e + 1) * 72 + lane] = f2bf(bfhi(wd) * kscale); } \
                _Pragma("unroll") for (int e = 0; e < 4; ++e) { const unsigned wd = XK1[e]; Kk[(8 * (w + 8) + 2 * e) * 72 + lane] = f2bf(bflo(wd) * kscale); Kk[(8 * (w + 8) + 2 * e + 1) * 72 + lane] = f2bf(bfhi(wd) * kscale); } } \
            WG_BAR(); \
            if (c_ + 4 < ML_NC) MLAB_LOAD(c_ + 4, XV, XK0, XK1); \
            const float g = GS[2 * c_], am = GS[2 * c_ + 1]; \
            float uu = 0.f; \
            if (tid < 128) { \
                _Pragma("unroll") for (int s8 = 0; s8 < 8; ++s8) { const v4u kk = *(const LAS v4u*)(Kk + tid * 72 + 8 * s8); const f32x4 wa = *(const LAS f32x4*)(wqc + 8 * s8), wb = *(const LAS f32x4*)(wqc + 8 * s8 + 4); \
                    uu += (bflo(kk.x) * wa.x + bfhi(kk.x) * wa.y) + (bflo(kk.y) * wa.z + bfhi(kk.y) * wa.w) + (bflo(kk.z) * wb.x + bfhi(kk.z) * wb.y) + (bflo(kk.w) * wb.z + bfhi(kk.w) * wb.w); } } \
            f32x16 acc; \
            _Pragma("unroll") for (int i = 0; i < 16; ++i) acc[i] = 0.f; \
            _Pragma("unroll") for (int ks = 0; ks < 4; ++ks) { const bf16x8 af = *(const LAS bf16x8*)(Vw + (32 * vb + r) * 72 + 16 * ks + 8 * hh); const bf16x8 bfr = *(const LAS bf16x8*)(Kk + (32 * kb + r) * 72 + 16 * ks + 8 * hh); \
                acc = MFMA32(bfr, af, acc); }        \
            bf16* Uo = UC + (size_t)it * 32768 + (size_t)(64 * qd + 32 * vb + r) * 128 + 32 * kb + 4 * hh;        \
            _Pragma("unroll") for (int g4 = 0; g4 < 4; ++g4) { v2u o; o.x = pk2(Cst[4 * g4], Cst[4 * g4 + 1]); o.y = pk2(Cst[4 * g4 + 2], Cst[4 * g4 + 3]); *(v2u*)(Uo + 8 * g4) = o; } \
            if (qd == 0) { if (tid < 128) NV[(size_t)it * 128 + tid] = nn; if (tid == 0) MST[it] = m; } \
            const float mn = fmaxf(g + m, am), dec = __expf(g + m - mn), sc = __expf(am - mn); \
            _Pragma("unroll") for (int i = 0; i < 16; ++i) Cst[i] = dec * Cst[i] + sc * acc[i]; \
            nn = dec * nn + sc * uu; m = mn; } while (0)
        for (int c = 0; c < ML_NC; c += 4) { MLAB_CHUNK(c, xvA, xkA0, xkA1); MLAB_CHUNK(c + 1, xvB, xkB0, xkB1); MLAB_CHUNK(c + 2, xvC, xkC0, xkC1); MLAB_CHUNK(c + 3, xvD, xkD0, xkD1); }
        WG_BAR();
#undef MLAB_CHUNK
#undef MLAB_LOAD
    }
}
template <class AT_>
__device__ __forceinline__ void mlstm_phase_c(const AT_& a, Frame& F, int j) {
    unsigned char* ws = a.ws; const int tid = F.tid, lane = F.lane, w = F.wave, r = lane & 31, hh = lane >> 5;
    const bf16* QKVO = (const bf16*)(ws + WS_BIG); const float* GT = (const float*)(ws + WS_GATES);
    const bf16* UC = (const bf16*)(ws + WS_BIG + 384 * MiB); const float* NV = (const float*)(ws + WS_NV); const float* MST = (const float*)(ws + WS_MST);
    bf16* HS = (bf16*)(ws + WS_XN);
    const float* bg = a.in[I_MLBG] + j * 16; const float* hgain = a.in[I_MLHG] + (size_t)j * ML_H * ML_DV;
    LAS float* bb = (LAS float*)F.lds; LAS float* lis = bb + 64; LAS float* nvs = bb + 128;
    LAS bf16* Qs = (LAS bf16*)(F.lds + 1024); LAS bf16* Ks = (LAS bf16*)(F.lds + 1024 + 17408); LAS bf16* Vt = (LAS bf16*)(F.lds + 1024 + 34816);
    LAS float* hbuf = (LAS float*)(F.lds + 1024);
    LAS unsigned char* CL = F.lds + 73728;
#define MLC_FRAG(f) ((f) * 1024 + ((f) >= 56 ? 1024 : 0))
    const float kscale = 0.08838834764831845f;
    const int qb2 = w >> 2, dq = w & 3;
    v4u xq[2], xk[2], xv[4]; v2u ogw[8]; float gli = 0.f, glf = 0.f, nv_r = 0.f, mst_r = 0.f;
#define MLC_LOAD_X(IT) do { const int it_ = (IT), h_ = (it_ >> 6) & 7, t0_ = (it_ >> 9) * SEQ + (it_ & 63) * ML_L; \
        _Pragma("unroll") for (int i = 0; i < 2; ++i) { const int q = tid + 512 * i, s = q >> 4, c8 = q & 15; const bf16* rowp = QKVO + (size_t)(t0_ + s) * 6144 + h_ * 128 + 8 * c8; xq[i] = *(const v4u*)rowp; xk[i] = *(const v4u*)(rowp + 1024); } \
        { const bf16* rowp = QKVO + (size_t)(t0_ + lane) * 6144 + 2048 + h_ * 256; _Pragma("unroll") for (int i = 0; i < 4; ++i) xv[i] = *(const v4u*)(rowp + 8 * (w + 8 * i)); } \
        if (w == 0) { gli = GT[(size_t)(t0_ + lane) * 16 + h_]; glf = GT[(size_t)(t0_ + lane) * 16 + 8 + h_]; } \
        if (tid < 128) nv_r = NV[(size_t)it_ * 128 + tid]; \
        mst_r = MST[it_]; } while (0)
#define MLC_LOAD_C(IT) do { const bf16* Cg = UC + (size_t)(IT) * 32768;        \
        _Pragma("unroll") for (int s4 = 0; s4 < 4; ++s4) _Pragma("unroll") for (int db = 0; db < 2; ++db) { const int s = 4 * qb2 + s4; \
            __builtin_amdgcn_global_load_lds((const unsigned*)(Cg + (64 * dq + 32 * db + r) * 128 + 16 * s + 8 * hh), (LAS unsigned*)(CL + MLC_FRAG((dq * 8 + s) * 2 + db)), 16, 0, 0); } } while (0)
#define MLC_LOAD_O(IT) do { const int it_ = (IT), h_ = (it_ >> 6) & 7, t0_ = (it_ >> 9) * SEQ + (it_ & 63) * ML_L; \
        _Pragma("unroll") for (int i = 0; i < 8; ++i) ogw[i] = *(const v2u*)(QKVO + (size_t)(t0_ + 8 * w + i) * 6144 + 4096 + h_ * 256 + 4 * lane); } while (0)
    if (F.bid < ML_ITEMS) { MLC_LOAD_X(F.bid); MLC_LOAD_C(F.bid); MLC_LOAD_O(F.bid); }
    for (int it = F.bid; it < ML_ITEMS; it += F.G) {
        const int b = it >> 9, h = (it >> 6) & 7, c = it & 63, tok0 = b * SEQ + c * ML_L; const int nit = it + F.G; const bool has = nit < ML_ITEMS;
        if (w == 0) {
            const float li = gli + bg[h]; const float lf = log_sigmoid(glf + bg[8 + h]);
            const float bsv = wave_incl_scan(lf, lane); bb[lane] = bsv; lis[lane] = li - bsv;
        }
        if (tid < 128) nvs[tid] = nv_r;
#pragma unroll
        for (int i = 0; i < 2; ++i) { const int q = tid + 512 * i, s = q >> 4, c8 = q & 15;
            *(LAS v4u*)(Qs + s * 136 + 8 * c8) = xq[i];
            const v4u x = xk[i]; v4u y;
#pragma unroll
            for (int e = 0; e < 4; ++e) y[e] = pk2(bflo(x[e]) * kscale, bfhi(x[e]) * kscale);
            *(LAS v4u*)(Ks + s * 136 + 8 * c8) = y; }
        {
#pragma unroll
            for (int i = 0; i < 4; ++i) { const int c8 = w + 8 * i; const v4u x = xv[i];
#pragma unroll
                for (int e = 0; e < 4; ++e) { Vt[(8 * c8 + 2 * e) * 72 + lane] = (bf16)(x[e] & 0xffffu); Vt[(8 * c8 + 2 * e + 1) * 72 + lane] = (bf16)(x[e] >> 16); } } }
        const float mst = mst_r;
        asm volatile("s_waitcnt vmcnt(0) lgkmcnt(0)" ::: "memory"); __builtin_amdgcn_s_barrier(); asm volatile("" ::: "memory");
        if (has) MLC_LOAD_X(nit);
        const int t = 32 * qb2 + r; const float bt = bb[t];
        bf16x8 Qf[8]; f32x4 blv[2][4];
#pragma unroll
        for (int s = 0; s < 8; ++s) Qf[s] = *(const LAS bf16x8*)(Qs + t * 136 + 16 * s + 8 * hh);
#pragma unroll
        for (int kb = 0; kb < 2; ++kb) if (kb <= qb2) {
#pragma unroll
            for (int g = 0; g < 4; ++g) blv[kb][g] = *(const LAS f32x4*)(lis + 32 * kb + 8 * g + 4 * hh); }
        f32x16 accs[2];
#pragma unroll
        for (int kb = 0; kb < 2; ++kb)
#pragma unroll
            for (int i = 0; i < 16; ++i) accs[kb][i] = 0.f;
#pragma unroll
        for (int kb = 0; kb < 2; ++kb) if (kb <= qb2) { bf16x8 kf[8];
#pragma unroll
            for (int s = 0; s < 8; ++s) kf[s] = *(const LAS bf16x8*)(Ks + (32 * kb + r) * 136 + 16 * s + 8 * hh);
#pragma unroll
            for (int s = 0; s < 8; ++s) accs[kb] = MFMA32(kf[s], Qf[s], accs[kb]); }
        float mi = -INFINITY;
#pragma unroll
        for (int kb = 0; kb < 2; ++kb) if (kb <= qb2) {
#pragma unroll
            for (int i = 0; i < 16; ++i) { const int sp = 32 * kb + crow(i, hh); const float ld = bt + blv[kb][i >> 2][i & 3]; mi = fmaxf(mi, sp <= t ? ld : -INFINITY); } }
        mi = fmaxf(mi, __shfl_xor(mi, 32));
        const float mout = fmaxf(bt + mst, mi); float den = 0.f;
#pragma unroll
        for (int kb = 0; kb < 2; ++kb) if (kb <= qb2) {
#pragma unroll
            for (int i = 0; i < 16; ++i) { const int sp = 32 * kb + crow(i, hh); const float ex = __expf(bt + blv[kb][i >> 2][i & 3] - mout); const float d = (sp <= t) ? ex : 0.f; const float sv = accs[kb][i] * d; accs[kb][i] = sv; den += sv; } }
        den += __shfl_xor(den, 32);
        const float winter = __expf(bt + mst - mout);
        f32x16 accn[2];
#pragma unroll
        for (int db = 0; db < 2; ++db)
#pragma unroll
            for (int i = 0; i < 16; ++i) accn[db][i] = 0.f;
#pragma unroll
        for (int s = 0; s < 8; ++s)
#pragma unroll
            for (int db = 0; db < 2; ++db) accn[db] = MFMA32(*(const LAS bf16x8*)(CL + MLC_FRAG((dq * 8 + s) * 2 + db) + lane * 16), Qf[s], accn[db]);
#pragma unroll
        for (int db = 0; db < 2; ++db)
#pragma unroll
            for (int i = 0; i < 16; ++i) accn[db][i] *= winter;
#pragma unroll
        for (int kb = 0; kb < 2; ++kb) if (kb <= qb2) {
#pragma unroll
            for (int s2 = 0; s2 < 2; ++s2) {
                v4u pw;
#pragma unroll
                for (int e = 0; e < 4; ++e) pw[e] = pk2(accs[kb][8 * s2 + 2 * e], accs[kb][8 * s2 + 2 * e + 1]);
                const bf16x8 pf = __builtin_bit_cast(bf16x8, pw);
#pragma unroll
                for (int db = 0; db < 2; ++db) { const LAS bf16* vp = Vt + (64 * dq + 32 * db + r) * 72 + 32 * kb + 16 * s2 + 4 * hh;
                    const v2u lo = *(const LAS v2u*)vp, hi = *(const LAS v2u*)(vp + 8); v4u vw; vw.x = lo.x; vw.y = lo.y; vw.z = hi.x; vw.w = hi.y;
                    accn[db] = MFMA32(__builtin_bit_cast(bf16x8, vw), pf, accn[db]); } } }
        float dn = 0.f;
#pragma unroll
        for (int s0 = 0; s0 < 8; s0 += 4) { f32x4 nva[4], nvb[4];
#pragma unroll
            for (int s = 0; s < 4; ++s) { nva[s] = *(const LAS f32x4*)(nvs + 16 * (s0 + s) + 8 * hh); nvb[s] = *(const LAS f32x4*)(nvs + 16 * (s0 + s) + 8 * hh + 4); }
#pragma unroll
            for (int s = 0; s < 4; ++s) { const v4u qw = __builtin_bit_cast(v4u, Qf[s0 + s]);
                dn += (bflo(qw[0]) * nva[s].x + bfhi(qw[0]) * nva[s].y) + (bflo(qw[1]) * nva[s].z + bfhi(qw[1]) * nva[s].w) + (bflo(qw[2]) * nvb[s].x + bfhi(qw[2]) * nvb[s].y) + (bflo(qw[3]) * nvb[s].z + bfhi(qw[3]) * nvb[s].w); } }
        dn += __shfl_xor(dn, 32);
        den += winter * dn;
        const float inv = 1.0f / fmaxf(fabsf(den), __expf(-mout));
        WG_BAR();
        if (has) MLC_LOAD_C(nit);
#pragma unroll
        for (int db = 0; db < 2; ++db)
#pragma unroll
            for (int g4 = 0; g4 < 4; ++g4) { f32x4 o; o.x = accn[db][4 * g4] * inv; o.y = accn[db][4 * g4 + 1] * inv; o.z = accn[db][4 * g4 + 2] * inv; o.w = accn[db][4 * g4 + 3] * inv;
                *(LAS f32x4*)(hbuf + t * 260 + 64 * dq + 32 * db + 8 * g4 + 4 * hh) = o; }
        WG_BAR();
        const f32x4 gn = *(const f32x4*)(hgain + h * ML_DV + 4 * lane);
#pragma unroll
        for (int i = 0; i < 8; ++i) { const int tt = 8 * w + i; const f32x4 v = *(const LAS f32x4*)(hbuf + tt * 260 + 4 * lane);
            const float ss = wave_sum((v.x * v.x + v.y * v.y) + (v.z * v.z + v.w * v.w)); const float rstd = 1.0f / sqrtf(ss * (1.0f / ML_DV) + NORM_EPS);
            const v2u ow = ogw[i];
            f32x4 y = v * rstd * gn; y.x *= pg8::fast_sigmoid(bflo(ow.x)); y.y *= pg8::fast_sigmoid(bfhi(ow.x)); y.z *= pg8::fast_sigmoid(bflo(ow.y)); y.w *= pg8::fast_sigmoid(bfhi(ow.y));
            v2u o; o.x = pk2(y.x, y.y); o.y = pk2(y.z, y.w);
            *(v2u*)(HS + (size_t)(tok0 + tt) * DM + h * 256 + 4 * lane) = o; }
        if (has) MLC_LOAD_O(nit);
        WG_BAR();
    }
#undef MLC_LOAD_X
#undef MLC_LOAD_C
#undef MLC_FRAG
#undef MLC_LOAD_O
}
template <class AT_>
__device__ __forceinline__ void attn_phase(const AT_& a, Frame& F, int j) {
    unsigned char* ws = a.ws; const int tid = F.tid, lane = F.lane, w = F.wave, r = lane & 31, hh = lane >> 5;
    const bf16* QKV = (const bf16*)(ws + WS_BIG); const float* ROPE = (const float*)(ws + WS_ROPE); bf16* O = (bf16*)(ws + WS_XN);
    const float* qg = a.in[I_ATQG] + j * 64; const float* kg = a.in[I_ATKG] + j * 64; const float* sinks = a.in[I_ATSINK] + j * 32;
    LAS bf16* Ks = (LAS bf16*)F.lds; LAS bf16* Vt = (LAS bf16*)(F.lds + 36864);
    for (int u = F.bid; u < AT_UNITS; u += F.G) {
        const int b = u >> 7, qb = (u >> 2) & 31, hk = u & 3, tok0 = b * SEQ + qb * AT_BLK, kt0 = tok0 - AT_BLK;
        if (tid < 256) {
            const int J = tid; const bool valid = (qb > 0) || (J >= AT_BLK);
            float v[64];
            if (valid) {
                const v4u* rp = (const v4u*)(QKV + (size_t)(kt0 + J) * AT_COLS + 2048 + hk * 64); float ss = 0.f;
#pragma unroll
                for (int q = 0; q < 8; ++q) { const v4u x = rp[q];
#pragma unroll
                    for (int e = 0; e < 4; ++e) { v[8 * q + 2 * e] = bflo(x[e]); v[8 * q + 2 * e + 1] = bfhi(x[e]); } }
#pragma unroll
                for (int d = 0; d < 64; ++d) ss += v[d] * v[d];
                const float rstd = 1.0f / sqrtf(ss * (1.0f / 64.0f) + NORM_EPS);
#pragma unroll
                for (int d = 0; d < 64; ++d) v[d] = v[d] * rstd * kg[d];
                const float* rp2 = ROPE + (size_t)(kt0 + J) * 16;
#pragma unroll
                for (int i = 0; i < 8; ++i) { const float cs = rp2[i], sn = rp2[8 + i], x1 = v[i], x2 = v[8 + i]; v[i] = x1 * cs - x2 * sn; v[8 + i] = x2 * cs + x1 * sn; }
            } else {
#pragma unroll
                for (int d = 0; d < 64; ++d) v[d] = 0.f;
            }
#pragma unroll
            for (int q = 0; q < 8; ++q) { v4u y;
#pragma unroll
                for (int e = 0; e < 4; ++e) y[e] = pk2(v[8 * q + 2 * e], v[8 * q + 2 * e + 1]);
                *(LAS v4u*)(Ks + J * 72 + 8 * q) = y; }
        } else {
            const int J = tid - 256; const bool valid = (qb > 0) || (J >= AT_BLK);
            const v4u* rp = (const v4u*)(QKV + (size_t)(valid ? kt0 + J : tok0) * AT_COLS + 2304 + hk * 64);
            v4u xr[8];
#pragma unroll
            for (int q = 0; q < 8; ++q) xr[q] = rp[q];
#pragma unroll
            for (int q = 0; q < 8; ++q) { const v4u x = valid ? xr[q] : (v4u){0u, 0u, 0u, 0u};
#pragma unroll
                for (int e = 0; e < 4; ++e) { Vt[(8 * q + 2 * e) * 264 + J] = (bf16)(x[e] & 0xffffu); Vt[(8 * q + 2 * e + 1) * 264 + J] = (bf16)(x[e] >> 16); } }
        }
        __syncthreads();
        const int hq = hk * 8 + w; const float sink = sinks[hq];
        for (int qi = 0; qi < 4; ++qi) {
            const int I = 32 * qi + r, tq = tok0 + I;
            float qv[4][8]; float ss = 0.f;
#pragma unroll
            for (int s = 0; s < 4; ++s) { const v4u x = *(const v4u*)(QKV + (size_t)tq * AT_COLS + hq * 64 + 16 * s + 8 * hh);
#pragma unroll
                for (int e = 0; e < 4; ++e) { qv[s][2 * e] = bflo(x[e]); qv[s][2 * e + 1] = bfhi(x[e]); } }
#pragma unroll
            for (int s = 0; s < 4; ++s)
#pragma unroll
                for (int e = 0; e < 8; ++e) ss += qv[s][e] * qv[s][e];
            ss += __shfl_xor(ss, 32);
            const float rstd = 0.125f / sqrtf(ss * (1.0f / 64.0f) + NORM_EPS);
#pragma unroll
            for (int s = 0; s < 4; ++s)
#pragma unroll
                for (int e = 0; e < 8; ++e) qv[s][e] = qv[s][e] * rstd * qg[16 * s + 8 * hh + e];
            {   const float* rp2 = ROPE + (size_t)tq * 16;
#pragma unroll
                for (int e = 0; e < 8; ++e) { const float mine = qv[0][e], other = __shfl_xor(mine, 32), cs = rp2[e], sn = rp2[8 + e];
                    qv[0][e] = (hh == 0) ? (mine * cs - other * sn) : (mine * cs + other * sn); } }
            bf16x8 Qf[4];
#pragma unroll
            for (int s = 0; s < 4; ++s) { v4u y;
#pragma unroll
                for (int e = 0; e < 4; ++e) y[e] = pk2(qv[s][2 * e], qv[s][2 * e + 1]);
                Qf[s] = __builtin_bit_cast(bf16x8, y); }
            f32x16 accs[5];
#pragma unroll
            for (int c = 0; c < 5; ++c) {
#pragma unroll
                for (int i = 0; i < 16; ++i) accs[c][i] = 0.f;
                const int kj = qi + c;
#pragma unroll
                for (int s = 0; s < 4; ++s) { const bf16x8 kf = *(const LAS bf16x8*)(Ks + (32 * kj + r) * 72 + 16 * s + 8 * hh); accs[c] = MFMA32(kf, Qf[s], accs[c]); } }
            float mx = sink;
#pragma unroll
            for (int c = 0; c < 5; ++c)
#pragma unroll
                for (int i = 0; i < 16; ++i) { const int J = 32 * (qi + c) + crow(i, hh); const bool ok = (J > I) && (J <= I + AT_BLK) && (qb > 0 || J >= AT_BLK); if (ok) mx = fmaxf(mx, accs[c][i]); }
            mx = fmaxf(mx, __shfl_xor(mx, 32));
            float sum = 0.f;
#pragma unroll
            for (int c = 0; c < 5; ++c)
#pragma unroll
                for (int i = 0; i < 16; ++i) { const int J = 32 * (qi + c) + crow(i, hh); const bool ok = (J > I) && (J <= I + AT_BLK) && (qb > 0 || J >= AT_BLK);
                    const float p = ok ? __expf(accs[c][i] - mx) : 0.f; accs[c][i] = p; sum += p; }
            sum += __shfl_xor(sum, 32);
            const float inv = 1.0f / (sum + __expf(sink - mx));
            f32x16 acco[2];
#pragma unroll
            for (int db = 0; db < 2; ++db)
#pragma unroll
                for (int i = 0; i < 16; ++i) acco[db][i] = 0.f;
#pragma unroll
            for (int c = 0; c < 5; ++c)
#pragma unroll
                for (int s2 = 0; s2 < 2; ++s2) { v4u pw;
#pragma unroll
                    for (int e = 0; e < 4; ++e) pw[e] = pk2(accs[c][8 * s2 + 2 * e], accs[c][8 * s2 + 2 * e + 1]);
                    const bf16x8 pf = __builtin_bit_cast(bf16x8, pw);
#pragma unroll
                    for (int db = 0; db < 2; ++db) { const LAS bf16* vp = Vt + (32 * db + r) * 264 + 32 * (qi + c) + 16 * s2 + 4 * hh;
                        const v2u lo = *(const LAS v2u*)vp, hi = *(const LAS v2u*)(vp + 8); v4u vw; vw.x = lo.x; vw.y = lo.y; vw.z = hi.x; vw.w = hi.y;
                        acco[db] = MFMA32(__builtin_bit_cast(bf16x8, vw), pf, acco[db]); } }
            bf16* orow = O + (size_t)tq * DM + hq * 64;
#pragma unroll
            for (int db = 0; db < 2; ++db)
#pragma unroll
                for (int g4 = 0; g4 < 4; ++g4) { v2u o; o.x = pk2(acco[db][4 * g4] * inv, acco[db][4 * g4 + 1] * inv); o.y = pk2(acco[db][4 * g4 + 2] * inv, acco[db][4 * g4 + 3] * inv);
                    *(v2u*)(orow + 32 * db + 8 * g4 + 4 * hh) = o; }
        }
        __syncthreads();
    }
}

template <int CTRL> __device__ __forceinline__ float dpp_f(float x) { return __builtin_bit_cast(float, __builtin_amdgcn_mov_dpp(__builtin_bit_cast(int, x), CTRL, 0xf, 0xf, true)); }
__device__ __forceinline__ float row8_allsum(float x) { x += dpp_f<0xB1>(x); x += dpp_f<0x4E>(x); x += dpp_f<0x141>(x); return x; }
struct RwOps { f32x4 a0, a1, r0, r1, w0, w1, b0, b1, k0, k1; f32x2 v, sc; };
template <class AT_>
__device__ __forceinline__ void rwkv_scan_phase(const AT_& a, Frame& F, int j) {
    unsigned char* ws = a.ws; const int lane = F.lane, w = F.wave;
    const bf16* RKV = (const bf16*)(ws + WS_BIG + 768 * MiB); const float* DEC = (const float*)(ws + WS_BIG);
    const bf16* AG = (const bf16*)(ws + WS_BIG + 256 * MiB); const bf16* GG = (const bf16*)(ws + WS_BIG + 384 * MiB); bf16* YG = (bf16*)(ws + WS_XN);
    const float* k_k = a.in[I_RWKK] + (size_t)j * DM; const float* k_a = a.in[I_RWKA] + (size_t)j * DM; const float* r_k = a.in[I_RWRK] + (size_t)j * DM;
    const float* ln_w = a.in[I_RWLNW] + (size_t)j * DM; const float* ln_b = a.in[I_RWLNB] + (size_t)j * DM;
    constexpr int OPB = 6 * RW_T * 64 * 4 + RW_T * 16;
    LAS float* Ybase = (LAS float*)(F.lds + 2 * OPB);
    const int vg = lane >> 3, kg = lane & 7, v0 = 16 * (w & 3) + 2 * vg;
    for (int bh = F.bid; bh < NBATCH * RW_H; bh += F.G) {
        const int b = bh >> 5, h = bh & 31, col = h * 64 + lane; const size_t tokb = (size_t)b * SEQ;
        const float kkc = k_k[col], kac = k_a[col], rkc = r_k[col], lnw = ln_w[col], lnb = ln_b[col];
        f32x2 S0[4], S1[4];
#pragma unroll
        for (int i = 0; i < 4; ++i) { S0[i] = (f32x2){0.f, 0.f}; S1[i] = (f32x2){0.f, 0.f}; }
        for (int blk = -1; blk <= RW_NBLK; ++blk) {
            if (w < 4) {
                if (blk >= 0 && blk < RW_NBLK) {
                    const LAS float* ob = (const LAS float*)(F.lds + (blk & 1) * OPB); LAS float* Yb = Ybase + (blk & 1) * (RW_T * 64);
                    auto ld = [&](int t) { RwOps o; const LAS float* p = ob + t * 64 + 8 * kg;
                        o.a0 = *(const LAS f32x4*)p; o.a1 = *(const LAS f32x4*)(p + 4); p += RW_T * 64; o.r0 = *(const LAS f32x4*)p; o.r1 = *(const LAS f32x4*)(p + 4); p += RW_T * 64;
                        o.w0 = *(const LAS f32x4*)p; o.w1 = *(const LAS f32x4*)(p + 4); p += RW_T * 64; o.b0 = *(const LAS f32x4*)p; o.b1 = *(const LAS f32x4*)(p + 4); p += RW_T * 64;
                        o.k0 = *(const LAS f32x4*)p; o.k1 = *(const LAS f32x4*)(p + 4);
                        o.v = *(const LAS f32x2*)(ob + 5 * RW_T * 64 + t * 64 + v0); o.sc = *(const LAS f32x2*)(ob + 6 * RW_T * 64 + t * 4); return o; };
                    auto step = [&](const RwOps& cur, int t) {
                        const f32x2 a01 = {cur.a0.x, cur.a0.y}, a23 = {cur.a0.z, cur.a0.w}, a45 = {cur.a1.x, cur.a1.y}, a67 = {cur.a1.z, cur.a1.w};
                        const f32x2 r01 = {cur.r0.x, cur.r0.y}, r23 = {cur.r0.z, cur.r0.w}, r45 = {cur.r1.x, cur.r1.y}, r67 = {cur.r1.z, cur.r1.w};
                        f32x2 sA0 = S0[0] * a01, sA1 = S1[0] * a01, sY0 = S0[0] * r01, sY1 = S1[0] * r01;
                        sA0 = S0[1] * a23 + sA0; sA1 = S1[1] * a23 + sA1; sY0 = S0[1] * r23 + sY0; sY1 = S1[1] * r23 + sY1;
                        sA0 = S0[2] * a45 + sA0; sA1 = S1[2] * a45 + sA1; sY0 = S0[2] * r45 + sY0; sY1 = S1[2] * r45 + sY1;
                        sA0 = S0[3] * a67 + sA0; sA1 = S1[3] * a67 + sA1; sY0 = S0[3] * r67 + sY0; sY1 = S1[3] * r67 + sY1;
                        const float sa0 = row8_allsum(sA0.x + sA0.y), sa1 = row8_allsum(sA1.x + sA1.y), yy0 = row8_allsum(sY0.x + sY0.y), yy1 = row8_allsum(sY1.x + sY1.y);
                        if (kg == 0) { f32x2 yo; yo.x = yy0 + sa0 * cur.sc.x + cur.v.x * cur.sc.y; yo.y = yy1 + sa1 * cur.sc.x + cur.v.y * cur.sc.y; *(LAS f32x2*)(Yb + t * 64 + v0) = yo; }
                        const f32x2 w01 = {cur.w0.x, cur.w0.y}, w23 = {cur.w0.z, cur.w0.w}, w45 = {cur.w1.x, cur.w1.y}, w67 = {cur.w1.z, cur.w1.w};
                        const f32x2 b01 = {cur.b0.x, cur.b0.y}, b23 = {cur.b0.z, cur.b0.w}, b45 = {cur.b1.x, cur.b1.y}, b67 = {cur.b1.z, cur.b1.w};
                        const f32x2 k01 = {cur.k0.x, cur.k0.y}, k23 = {cur.k0.z, cur.k0.w}, k45 = {cur.k1.x, cur.k1.y}, k67 = {cur.k1.z, cur.k1.w};
                        const f32x2 s0 = {sa0, sa0}, s1 = {sa1, sa1}, x0 = {cur.v.x, cur.v.x}, x1 = {cur.v.y, cur.v.y};
                        S0[0] = S0[0] * w01 + (s0 * b01 + x0 * k01); S0[1] = S0[1] * w23 + (s0 * b23 + x0 * k23); S0[2] = S0[2] * w45 + (s0 * b45 + x0 * k45); S0[3] = S0[3] * w67 + (s0 * b67 + x0 * k67);
                        S1[0] = S1[0] * w01 + (s1 * b01 + x1 * k01); S1[1] = S1[1] * w23 + (s1 * b23 + x1 * k23); S1[2] = S1[2] * w45 + (s1 * b45 + x1 * k45); S1[3] = S1[3] * w67 + (s1 * b67 + x1 * k67);
                    };
                    RwOps oa = ld(0);
                    for (int t = 0; t < RW_T; t += 2) {
                        const RwOps ob2 = ld(t + 1);
                        step(oa, t);
                        oa = ld(t + 2 < RW_T ? t + 2 : t + 1);
                        step(ob2, t + 1);
                    }
                }
            } else {
                const int tw = w - 4; const bool do_post = blk >= 1, do_prep = blk + 1 < RW_NBLK;
                float pr[8], pk[8], pv[8], pd[8], pa[8], pg[8];
#pragma unroll
                for (int i = 0; i < 8; ++i) { pr[i] = 0.f; pk[i] = 0.f; pv[i] = 0.f; pd[i] = 0.f; pa[i] = 0.f; pg[i] = 0.f; }
                if (do_prep) {
#pragma unroll
                    for (int i = 0; i < 8; ++i) { const size_t off = (tokb + (size_t)(blk + 1) * RW_T + tw + 4 * i) * DM + col;
                        pr[i] = bf2f(RKV[off]); pk[i] = bf2f(RKV[(size_t)MTOK * DM + off]); pv[i] = bf2f(RKV[(size_t)2 * MTOK * DM + off]); pd[i] = DEC[off]; pa[i] = bf2f(AG[off]); } }
                if (do_post) {
#pragma unroll
                    for (int i = 0; i < 8; ++i) pg[i] = bf2f(GG[(tokb + (size_t)(blk - 1) * RW_T + tw + 4 * i) * DM + col]); }
                if (do_post) {
                    const int pb = blk - 1; const LAS float* ob = (const LAS float*)(F.lds + (pb & 1) * OPB); const LAS float* Yb = Ybase + (pb & 1) * (RW_T * 64);
#pragma unroll
                    for (int i = 0; i < 8; ++i) { const int t = tw + 4 * i; const size_t tok = tokb + (size_t)pb * RW_T + t;
                        const float y = Yb[t * 64 + lane], vv = ob[5 * RW_T * 64 + t * 64 + lane], bon = ob[6 * RW_T * 64 + t * 4 + 2];
                        const float mu = wave_sum_dpp(y) * (1.0f / 64.0f), dlt = y - mu, var = wave_sum_dpp(dlt * dlt) * (1.0f / 64.0f);
                        const float yn = dlt * __builtin_amdgcn_rsqf(var + RW_LN_EPS) * lnw + lnb + bon * vv;
                        YG[tok * DM + col] = f2bf(yn * pg[i]); }
                }
                if (do_prep) {
                    LAS float* ob = (LAS float*)(F.lds + ((blk + 1) & 1) * OPB);
#pragma unroll
                    for (int i = 0; i < 8; ++i) { const int t = tw + 4 * i; const float rr = pr[i], kk0 = pk[i], vv = pv[i];
                        const float dec = __expf(-0.6065306597f * pg8::fast_sigmoid(pd[i])), ag = pg8::fast_sigmoid(pa[i]);
                        float kkv = kk0 * kkc; kkv = kkv * __builtin_amdgcn_rsqf(fmaxf(wave_sum_dpp(kkv * kkv), 1e-24f));
                        const float kp = kk0 * (1.0f + (ag - 1.0f) * kac); const float bv = kkv * ag;
                        ob[t * 64 + lane] = -kkv; ob[RW_T * 64 + t * 64 + lane] = dec * rr; ob[2 * RW_T * 64 + t * 64 + lane] = dec;
                        ob[3 * RW_T * 64 + t * 64 + lane] = bv; ob[4 * RW_T * 64 + t * 64 + lane] = kp; ob[5 * RW_T * 64 + t * 64 + lane] = vv;
                        const float br = wave_sum_dpp(bv * rr), kr = wave_sum_dpp(kp * rr), bon = wave_sum_dpp(rr * kp * rkc);
                        if (lane == 0) { ob[6 * RW_T * 64 + t * 4] = br; ob[6 * RW_T * 64 + t * 4 + 1] = kr; ob[6 * RW_T * 64 + t * 4 + 2] = bon; } }
                }
            }
            __syncthreads();
        }
    }
}
constexpr int RING_BYTES = 131072, MISC_OFF = RING_BYTES + 320, LDS_BYTES = 147456;
#ifndef MK_PER_PHASE
#define MK_PER_PHASE 0
#endif
constexpr int N_PHASES_MAX = 64;
#ifndef REP_CONV
#define REP_CONV 1
#endif
#ifndef REP_NORM
#define REP_NORM 1
#endif
#ifndef REP_GU
#define REP_GU 1
#endif
#ifndef REP_MIXG
#define REP_MIXG 1
#endif
#ifndef REP_MLA
#define REP_MLA 1
#endif
#ifndef REP_MLC
#define REP_MLC 1
#endif
#ifndef REP_ATTN
#define REP_ATTN 1
#endif
#ifndef REP_SCAN
#define REP_SCAN 1
#endif
template <int N> __device__ __forceinline__ int nrep() { if (N == 1) return 1; int v = N; asm volatile("" : "+s"(v)); return v; }
#define PH_REP(N) for (int rep_ = 0, nrep_ = nrep<N>(); rep_ < nrep_; ++rep_)
typedef const __attribute__((address_space(4))) Args CArgs;
__device__ __forceinline__ CArgs* kargs() { CArgs* p = (CArgs*)__builtin_amdgcn_kernarg_segment_ptr(); asm volatile("" : "+s"(p)); return p; }
struct Ctx { XcdBarrier bar; int lo, hi; };
#define PH_BEGIN if (ph >= C.lo && ph < C.hi) { CArgs& a = *kargs(); unsigned char* ws = a.ws; Frame F; { int t_ = threadIdx.x, g_ = gridDim.x, b_ = blockIdx.x; asm volatile("" : "+v"(t_), "+s"(g_), "+s"(b_)); \
                 unsigned lb_ = 0u; asm volatile("" : "+s"(lb_)); F.lds = (LAS unsigned char*)(size_t)lb_ + (size_t)(LAS unsigned char*)lds_raw; F.tid = t_; F.lane = t_ & 63; F.wave = __builtin_amdgcn_readfirstlane(t_ >> 6); F.G = g_; F.bid = b_; } \
                 bf16* XN = (bf16*)(ws + WS_XN); bf16* BIG = (bf16*)(ws + WS_BIG); bf16* WMA = (bf16*)(ws + WS_WMIX); bf16* WMO = (bf16*)(ws + WS_WMIX + 26 * MiB); (void)XN; (void)BIG; (void)WMA; (void)WMO;
#define PH_END   if (ph + 1 < C.hi) { XcdBarrier b2_ = C.bar; asm volatile("" : "+s"(b2_.bar)); xcd_barrier(b2_); } } ++ph;
#define XS0 ((bf16*)a.out)
#define XS1 ((bf16*)(ws + WS_BIG + 512 * MiB))

#ifndef GU_WGM
#define GU_WGM 8
#endif
#ifndef DN_WGM
#define DN_WGM 4
#endif
#ifndef I8_MIX_MASK
#define I8_MIX_MASK 0x2
#endif
#ifndef I8_GU_MASK
#define I8_GU_MASK 0xFF
#endif
#ifndef FP8_GU_MASK
#define FP8_GU_MASK 0x00
#endif
#ifndef FP8_DN_MASK
#define FP8_DN_MASK 0xC0
#endif
constexpr int RT_TAGS_OFF = RING_BYTES + 512, RT_TAB_OFF = RING_BYTES + 1024;
template <class Sched>
__device__ __forceinline__ pg8::RowTab build_row_tab(Frame& F, const Sched& S, const float* rowq, float wstep) {
    LAS int* tags = (LAS int*)(F.lds + RT_TAGS_OFF); LAS float* tab = (LAS float*)(F.lds + RT_TAB_OFF);
    if (F.tid == 0) { int n = 0;
        for (int k = 0; k < 8; ++k) tags[k] = -1;
        pg8::Unit u;
        for (int i = 0; S.next(i, u); ++i) { bool seen = false; for (int k = 0; k < n; ++k) seen = seen || (tags[k] == u.pm); if (!seen && n < 8) tags[n++] = u.pm; } }
    __syncthreads();
    for (int k = F.tid >> 8; k < 8; k += 2) { const int pm = tags[k]; if (pm >= 0) tab[k * 256 + (F.tid & 255)] = rowq[(size_t)pm * 256 + (F.tid & 255)] * wstep; }
    __syncthreads();
    return pg8::RowTab{tab, tags};
}
template <int L, int FI>
__device__ __forceinline__ void run_ffn(unsigned char* lds_raw, const Ctx& C, int& ph) {
    constexpr bool FIRST = (L == 0 && FI == 0), LAST = (L == DEPTH - 1 && FI == 1);
    constexpr bool F8 = ((FP8_DN_MASK >> (2 * L + FI)) & 1) != 0, I8G = ((I8_GU_MASK >> (2 * L + FI)) & 1) != 0, F8G = !I8G && ((FP8_GU_MASK >> (2 * L + FI)) & 1) != 0;
    constexpr int GDT = I8G ? 2 : (F8G ? 1 : 0);
    PH_BEGIN PH_REP(REP_NORM) { if (FIRST) norm_phase<0, false, GDT>(a, F, a.in[I_X], a.in[FI ? I_F2N : I_F1N] + (size_t)L * DM, 0);
                                else norm_phase<0, true, GDT>(a, F, LAST ? XS1 : XS0, a.in[FI ? I_F2N : I_F1N] + (size_t)L * DM, 0); } PH_END
    PH_BEGIN { bf16* WGU = (bf16*)(ws + (FI ? WS_WGU2 : WS_WGU1)); constexpr int KG = GDT ? DM / 2 : DM;
               pg8::Gemm g{XN, WGU, KG, KG, KG}; pg8::StaticOrder S; S.init(MTOK, 2 * FF, F.G, F.bid, GU_WGM);
               pg8::RowTab rt{nullptr, nullptr};
               if (I8G) rt = build_row_tab(F, S, (const float*)(ws + WS_ROWQ), 1.0f);
               pg8::EpiSwiGLU<F8, I8G> E{BIG, FF, F8G ? 1.0f / (pg8::X8_SCALE * pg8::W8_SCALE) : 1.0f, rt, (const float*)(ws + WS_CSTEP) + (2 * L + FI) * 2 * FF};
               PH_REP(REP_GU) { pg8::gemm_phase<pg8::EpiSwiGLU<F8, I8G>, pg8::StaticOrder, true, true, GDT>(F.lds, g, S, E, F.tid); } } PH_END
    PH_BEGIN { bf16* WDN = (bf16*)(ws + (FI ? WS_WDN2 : WS_WDN1));
               constexpr int KE = F8 ? FF / 2 : FF;
               constexpr float SC = F8 ? 0.5f / (pg8::H8_SCALE * pg8::W8_SCALE) : 0.5f;
               pg8::Gemm g{BIG, WDN, KE, KE, KE}; pg8::StaticOrder S; S.init(MTOK, DM, F.G, F.bid, DN_WGM);
               if (FIRST) { pg8::EpiResid<false, true> E{a.in[I_X], XS0, DM, SC}; pg8::gemm_phase<pg8::EpiResid<false, true>, pg8::StaticOrder, true, true, F8 ? 1 : 0>(F.lds, g, S, E, F.tid); }
               else if (LAST) { pg8::EpiResid<true, false> E{XS1, a.out, DM, SC}; pg8::gemm_phase<pg8::EpiResid<true, false>, pg8::StaticOrder, true, true, F8 ? 1 : 0>(F.lds, g, S, E, F.tid); }
               else { pg8::EpiResid<true, true> E{XS0, XS0, DM, SC}; pg8::gemm_phase<pg8::EpiResid<true, true>, pg8::StaticOrder, true, true, F8 ? 1 : 0>(F.lds, g, S, E, F.tid); } } PH_END
}
template <int L>
__device__ __forceinline__ void run_layer(unsigned char* lds_raw, const Ctx& C, int& ph) {
    constexpr int kind = L % 3, j = L / 3;
    constexpr bool I8A = ((I8_GU_MASK >> (2 * L)) & 1) != 0, I8B = ((I8_GU_MASK >> (2 * L + 1)) & 1) != 0, I8M = kind != 2 && ((I8_MIX_MASK >> L) & 1) != 0;
    if constexpr (I8A || I8B || I8M) {
        PH_BEGIN { if (I8A) colmax_wide(F, a.in[I_F1GU] + (size_t)L * DM * 2 * FF, DM, 2 * FF, (unsigned*)(ws + WS_CTL) + CW_CMAX + (2 * L) * 2 * FF);
                   if (I8B) colmax_wide(F, a.in[I_F2GU] + (size_t)L * DM * 2 * FF, DM, 2 * FF, (unsigned*)(ws + WS_CTL) + CW_CMAX + (2 * L + 1) * 2 * FF);
                   if (I8M && kind == 0) { colmax_wide(F, a.in[I_MLWIN] + (size_t)j * DM * ML_INCOLS, DM, 6144, (unsigned*)(ws + WS_CTL) + CW_CMAX2 + 6400 * L, ML_INCOLS);
                                          colmax_pass(F, a.in[I_MLWIN] + (size_t)j * DM * ML_INCOLS + 6144, DM, 16, ML_INCOLS, (unsigned*)(ws + WS_CTL) + CW_CMAX2 + 6400 * L + 6144); }
                   if (I8M && kind == 1) colmax_wide(F, a.in[I_ATQKV] + (size_t)j * DM * AT_COLS, DM, AT_COLS, (unsigned*)(ws + WS_CTL) + CW_CMAX2 + 6400 * L); } PH_END
    }
    PH_BEGIN PH_REP(REP_CONV) { conv_phase(a, F, L, ((FP8_DN_MASK >> (2 * L)) & 1) != 0, ((FP8_DN_MASK >> (2 * L + 1)) & 1) != 0, ((FP8_GU_MASK >> (2 * L)) & 1) != 0, ((FP8_GU_MASK >> (2 * L + 1)) & 1) != 0, I8A, I8B, I8M); } PH_END
    run_ffn<L, 0>(lds_raw, C, ph);
    if constexpr (kind == 0) {
        PH_BEGIN PH_REP(REP_NORM) { norm_phase<0, true, I8M ? 2 : 0>(a, F, XS0, a.in[I_MN] + (size_t)L * DM, j); } PH_END
        PH_BEGIN { constexpr int KM = I8M ? DM / 2 : DM; pg8::Gemm g{XN, WMA, KM, KM, KM}; pg8::StaticOrder S; S.init(MTOK, ML_NPAD, F.G, F.bid);
                   pg8::RowTab rt{nullptr, nullptr}; if (I8M) rt = build_row_tab(F, S, (const float*)(ws + WS_ROWQ), 1.0f);
                   pg8::EpiStore<I8M> E{BIG, 6144, 24, (float*)(ws + WS_GATES), rt, (const float*)(ws + WS_CSTEP2) + 6400 * L};
                   PH_REP(REP_MIXG) { pg8::gemm_phase<pg8::EpiStore<I8M>, pg8::StaticOrder, true, true, I8M ? 2 : 0>(F.lds, g, S, E, F.tid); } } PH_END
        PH_BEGIN PH_REP(REP_MLA) { mlstm_phase_ab(a, F, j); } PH_END
        PH_BEGIN PH_REP(REP_MLC) { mlstm_phase_c(a, F, j); } PH_END
    } else if constexpr (kind == 1) {
        PH_BEGIN PH_REP(REP_NORM) { norm_phase<1, true, I8M ? 2 : 0>(a, F, XS0, a.in[I_MN] + (size_t)L * DM, j); } PH_END
        PH_BEGIN { constexpr int KM = I8M ? DM / 2 : DM; pg8::Gemm g{XN, WMA, KM, KM, KM}; pg8::StaticOrder S; S.init(MTOK, AT_COLS, F.G, F.bid);
                   pg8::RowTab rt{nullptr, nullptr}; if (I8M) rt = build_row_tab(F, S, (const float*)(ws + WS_ROWQ), 1.0f);
                   pg8::EpiStore<I8M> E{BIG, AT_COLS, 1 << 30, nullptr, rt, (const float*)(ws + WS_CSTEP2) + 6400 * L};
                   PH_REP(REP_MIXG) { pg8::gemm_phase<pg8::EpiStore<I8M>, pg8::StaticOrder, true, true, I8M ? 2 : 0>(F.lds, g, S, E, F.tid); } } PH_END
        PH_BEGIN PH_REP(REP_ATTN) { attn_phase(a, F, j); } PH_END
    } else {
        PH_BEGIN PH_REP(REP_NORM) { norm_phase<2, true>(a, F, XS0, a.in[I_MN] + (size_t)L * DM, j); } PH_END
        PH_BEGIN { pg8::Gemm g{BIG, WMA, DM, DM, DM}; pg8::RwkvOrder1 S; S.b.init(MTOK, 27 * 256, F.G, F.bid);
                   pg8::EpiRwkv1 E{BIG + (size_t)384 * MiB, XN, MTOK};
                   PH_REP(REP_MIXG) { pg8::gemm_phase<pg8::EpiRwkv1, pg8::RwkvOrder1, true, true>(F.lds, g, S, E, F.tid); } } PH_END
        PH_BEGIN { pg8::Gemm g{XN, (bf16*)(ws + WS_WMIX + 28 * MiB), 256, 256, 256}; pg8::RwkvOrder2 S; S.b.init(MTOK, 24 * 256, F.G, F.bid);
                   pg8::EpiRwkv2 E{(float*)(ws + WS_BIG), (bf16*)(ws + WS_BIG + 256 * MiB), (bf16*)(ws + WS_BIG + 384 * MiB), a.in[I_RWW0] + (size_t)j * DM, a.in[I_RWA0] + (size_t)j * DM};
                   PH_REP(REP_MIXG) { pg8::gemm_phase<pg8::EpiRwkv2, pg8::RwkvOrder2, true, true>(F.lds, g, S, E, F.tid); } } PH_END
        PH_BEGIN PH_REP(REP_SCAN) { rwkv_scan_phase(a, F, j); } PH_END
    }
    PH_BEGIN { pg8::Gemm g{XN, kind == 2 ? (bf16*)(ws + WS_WMIX + 32 * MiB) : WMO, DM, DM, DM}; pg8::StaticOrder S; S.init(MTOK, DM, F.G, F.bid, DN_WGM);
               pg8::EpiResid<true, true> E{XS0, L == DEPTH - 1 ? XS1 : XS0, DM, 1.0f};
               pg8::gemm_phase<pg8::EpiResid<true, true>, pg8::StaticOrder, true, true>(F.lds, g, S, E, F.tid); } PH_END
    run_ffn<L, 1>(lds_raw, C, ph);
}
#undef PH_BEGIN
#undef PH_END

__global__ void __launch_bounds__(NTHREADS, 2) hybrid_fwd(Args a_unused) {
    extern __shared__ __attribute__((aligned(16))) unsigned char lds_raw[];
    volatile LAS unsigned* MISC = (volatile LAS unsigned*)((LAS unsigned char*)lds_raw + MISC_OFF);
    if (threadIdx.x < 32) MISC[threadIdx.x] = 0u;
    __syncthreads();
    Ctx C; C.bar = xcd_barrier_post((unsigned*)(kargs()->ws + WS_CTL) + CW_BAR, MISC + 8);
    C.lo = kargs()->ph_lo; C.hi = kargs()->ph_hi; int ph = 0;
    run_layer<0>(lds_raw, C, ph);
    run_layer<1>(lds_raw, C, ph);
    run_layer<2>(lds_raw, C, ph);
    run_layer<3>(lds_raw, C, ph);
}

extern "C" void kernel_launch(void* const* d_in, const int* in_sizes, int n_in, void* d_out, int out_size, void* d_ws, size_t ws_size, hipStream_t stream) {
    static int grid = 0;
    if (grid == 0) {
        if (n_in != N_IN || in_sizes[0] != MTOK * DM || out_size != MTOK * DM || ws_size < WS_END) {
            fprintf(stderr, "kernel_launch: unexpected shapes (n_in %d, in0 %d, out %d, ws %zu < %zu); nothing launched\n", n_in, n_in > 0 ? in_sizes[0] : -1, out_size, ws_size, (size_t)WS_END); grid = -1; return; }
        int dev = 0, cus = 0, per_cu = 0;
        if (hipGetDevice(&dev) != hipSuccess || hipDeviceGetAttribute(&cus, hipDeviceAttributeMultiprocessorCount, dev) != hipSuccess) { grid = -1; return; }
        if (hipFuncSetAttribute((const void*)hybrid_fwd, hipFuncAttributeMaxDynamicSharedMemorySize, LDS_BYTES) != hipSuccess) { fprintf(stderr, "kernel_launch: hipFuncSetAttribute failed\n"); grid = -1; return; }
        if (hipOccupancyMaxActiveBlocksPerMultiprocessor(&per_cu, (const void*)hybrid_fwd, NTHREADS, LDS_BYTES) != hipSuccess || per_cu < 1) { fprintf(stderr, "kernel_launch: occupancy query says %d blocks per CU\n", per_cu); }
        (void)hipGetLastError();
        grid = cus;
    }
    if (grid < 0) return;
    if (hipMemsetAsync((char*)d_ws + WS_CTL, 0, CTL_ZERO_BYTES, stream) != hipSuccess) return;
    Args a{};
    for (int i = 0; i < N_IN; ++i) a.in[i] = (const float*)d_in[i];
    a.out = (float*)d_out; a.ws = (unsigned char*)d_ws;
#if MK_PER_PHASE
    for (int p = 0; p < N_PHASES_MAX; ++p) { a.ph_lo = p; a.ph_hi = p + 1; hipLaunchKernelGGL(hybrid_fwd, dim3(grid), dim3(NTHREADS), LDS_BYTES, stream, a); }
#else
    a.ph_lo = 0; a.ph_hi = 1 << 30;
    hipLaunchKernelGGL(hybrid_fwd, dim3(grid), dim3(NTHREADS), LDS_BYTES, stream, a);
#endif
    const hipError_t le = hipPeekAtLastError();
    if (le != hipSuccess) fprintf(stderr, "kernel_launch: launch failed: %s\n", hipGetErrorName(le));
}
```

```cpp
#include <hip/hip_runtime.h>
#include <cstdio>
#include <cstdint>
#define I8_MIX_MASK 0xA
namespace pg8 {
#define PG8_LAS __attribute__((address_space(3)))
typedef unsigned short bf16_t;
typedef short bf16x8 __attribute__((ext_vector_type(8)));
typedef float f32x4 __attribute__((ext_vector_type(4)));
typedef unsigned u32x4 __attribute__((ext_vector_type(4)));
constexpr int BM = 256, BK = 64, HALF = 128, HTB = HALF * BK * 2  , STAGE_BYTES = 8 * HTB, NXCD = 8, WGM = 8;

__host__ __device__ __forceinline__ int lds_byte(int r, int c) { const int st = (r >> 4) * 2 + (c >> 5), rr = r & 15, cc = c & 31, ob = rr * 64 + cc * 2; return st * 1024 + (ob ^ (((ob >> 9) & 1) << 5)); }
__host__ __device__ __forceinline__ void stage_rc(int b, int& R, int& C) { const int st = b / 1024, sb = b % 1024, swz = sb ^ (((sb >> 9) & 1) << 5); R = (st >> 1) * 16 + swz / 64; C = (st & 1) * 32 + (swz % 64) / 2; }
__host__ __device__ __forceinline__ int perm32(int rho) { const int n = rho >> 4, i = rho & 15; return 8 * (i >> 2) + 4 * n + (i & 3); }

typedef int i32x8 __attribute__((ext_vector_type(8)));
__device__ __forceinline__ i32x8 ld32(const PG8_LAS unsigned char* p) { typedef int i32x4_ __attribute__((ext_vector_type(4))); const i32x4_ lo = *(const PG8_LAS i32x4_*)p, hi = *(const PG8_LAS i32x4_*)(p + 16); return __builtin_shufflevector(lo, hi, 0, 1, 2, 3, 4, 5, 6, 7); }
struct Unit { int pm, pn; };
struct Gemm { const bf16_t* A; const bf16_t* Bt; int lda, ldb, K; };

struct StaticOrder {
    int nM, nN, nwg, G, c, wgm;
    __host__ __device__ void init(int M, int N, int G_, int c_, int wgm_ = WGM) { nM = M / BM; nN = N / BM; nwg = nM * nN; G = G_; c = c_; wgm = wgm_; }
    __host__ __device__ bool next(int i, Unit& u) const {
        const long L = (long)i * G + c; if (L >= nwg) return false;
        int wgid = (int)L; { const int q = nwg / NXCD, r = nwg % NXCD, xcd = wgid % NXCD, off = wgid / NXCD; wgid = (xcd < r ? xcd * (q + 1) : r * (q + 1) + (xcd - r) * q) + off; }
        const int nig = wgm * nN, gid = wgid / nig, fm = gid * wgm, gsz = (nM - fm) < wgm ? (nM - fm) : wgm;
        u.pm = fm + ((wgid % nig) % gsz); u.pn = (wgid % nig) / gsz; return true;
    }
    __device__ __forceinline__ void a_ready(const Unit&) const {}
    __device__ __forceinline__ void done(const Unit&) const {}
};

typedef __bf16 bf16v2_t __attribute__((ext_vector_type(2)));
__device__ __forceinline__ unsigned cvt_pk_bf16(float lo, float hi) { bf16v2_t v; v.x = (__bf16)lo; v.y = (__bf16)hi; return __builtin_bit_cast(unsigned, v); }
__device__ __forceinline__ float fast_sigmoid(float x) { return __builtin_amdgcn_rcpf(1.0f + __expf(-x)); }
constexpr int MROWS_TILES = 128;

constexpr float H8_SCALE = 4.0f, W8_SCALE = 64.0f, X8_SCALE = 16.0f;
struct RowTab { const PG8_LAS float* tab; const PG8_LAS int* tags;
    __device__ __forceinline__ int slot(int pm) const { int s = 0;
#pragma unroll
        for (int k = 0; k < 8; ++k) if (tags[k] == pm) s = k;
        return __builtin_amdgcn_readfirstlane(s); } };
template <bool F8, bool IN8 = false>
struct EpiSwiGLU {
    static constexpr bool PERM = true, AFTER_DRAIN = false;
    void* O; int ldc; float isc; RowTab rt; const float* cstep;
    __device__ __forceinline__ void operator()(const f32x4 (&acc)[2][2][4][2], const Unit& u, int wr, int wc, int fr, int fq) const {
        const int row0 = u.pm * BM + wr * 64 + fr, col0 = u.pn * HALF + wc * 32 + 8 * fq; const int sl = IN8 ? rt.slot(u.pm) : 0;
        f32x4 cg[2], cu[2];
#pragma unroll
        for (int n = 0; n < 2; ++n) { cg[n] = IN8 ? *(const f32x4*)(cstep + u.pn * BM + wc * 32 + 8 * fq + 4 * n) : (f32x4){1.f, 1.f, 1.f, 1.f}; cu[n] = IN8 ? *(const f32x4*)(cstep + u.pn * BM + HALF + wc * 32 + 8 * fq + 4 * n) : (f32x4){1.f, 1.f, 1.f, 1.f}; }
#pragma unroll
        for (int ai = 0; ai < 2; ++ai)
#pragma unroll
            for (int m = 0; m < 4; ++m) { const size_t off = (size_t)(row0 + ai * HALF + m * 16) * ldc + col0;
                const float rs = IN8 ? rt.tab[sl * 256 + wr * 64 + ai * HALF + m * 16 + fr] : isc;
                float o[8];
#pragma unroll
                for (int n = 0; n < 2; ++n)
#pragma unroll
                    for (int e = 0; e < 4; ++e) { const float ga = acc[ai][0][m][n][e], ua = acc[ai][1][m][n][e];
                        const float g = (IN8 ? (float)__float_as_int(ga) * cg[n][e] : ga) * rs, up = (IN8 ? (float)__float_as_int(ua) * cu[n][e] : ua) * rs; o[4 * n + e] = g * fast_sigmoid(g) * up; }
                if (F8) { unsigned w0 = 0u, w1 = 0u;
#pragma unroll
                    for (int e = 0; e < 8; ++e) o[e] = __builtin_amdgcn_fmed3f(o[e] * H8_SCALE, -448.0f, 448.0f);
                    w0 = __builtin_amdgcn_cvt_pk_fp8_f32(o[0], o[1], w0, false); w0 = __builtin_amdgcn_cvt_pk_fp8_f32(o[2], o[3], w0, true);
                    w1 = __builtin_amdgcn_cvt_pk_fp8_f32(o[4], o[5], w1, false); w1 = __builtin_amdgcn_cvt_pk_fp8_f32(o[6], o[7], w1, true);
                    typedef unsigned u32x2_ __attribute__((ext_vector_type(2))); *(u32x2_*)((unsigned char*)O + off) = (u32x2_){w0, w1}; }
                else { u32x4 w; w.x = cvt_pk_bf16(o[0], o[1]); w.y = cvt_pk_bf16(o[2], o[3]); w.z = cvt_pk_bf16(o[4], o[5]); w.w = cvt_pk_bf16(o[6], o[7]);
                    __builtin_nontemporal_store(w, (u32x4*)((bf16_t*)O + off)); } }
    }
};
typedef _Float16 h16x8_t __attribute__((ext_vector_type(8)));
template <bool BB, bool OB>
struct EpiResid {
    static constexpr bool PERM = true, AFTER_DRAIN = false;
    const void* base; void* out; int ldc; float s;
    __device__ __forceinline__ void operator()(const f32x4 (&acc)[2][2][4][2], const Unit& u, int wr, int wc, int fr, int fq) const {
        const int row0 = u.pm * BM + wr * 64 + fr, col0 = u.pn * BM + wc * 32 + 8 * fq;
#pragma unroll
        for (int ai = 0; ai < 2; ++ai) {
            if constexpr (BB) {
                h16x8_t wv[4][2];
#pragma unroll
                for (int m = 0; m < 4; ++m)
#pragma unroll
                    for (int bj = 0; bj < 2; ++bj) wv[m][bj] = *(const h16x8_t*)((const bf16_t*)base + (size_t)(row0 + ai * HALF + m * 16) * ldc + col0 + bj * HALF);
#pragma unroll
                for (int m = 0; m < 4; ++m) { const size_t off = (size_t)(row0 + ai * HALF + m * 16) * ldc + col0;
#pragma unroll
                    for (int bj = 0; bj < 2; ++bj) { const h16x8_t w = wv[m][bj];
                        const f32x4 b0 = (f32x4){(float)w[0], (float)w[1], (float)w[2], (float)w[3]}, b1 = (f32x4){(float)w[4], (float)w[5], (float)w[6], (float)w[7]};
                        const f32x4 o0 = b0 + acc[ai][bj][m][0] * s, o1 = b1 + acc[ai][bj][m][1] * s;
                        if (OB) { h16x8_t wo; wo[0] = (_Float16)o0[0]; wo[1] = (_Float16)o0[1]; wo[2] = (_Float16)o0[2]; wo[3] = (_Float16)o0[3]; wo[4] = (_Float16)o1[0]; wo[5] = (_Float16)o1[1]; wo[6] = (_Float16)o1[2]; wo[7] = (_Float16)o1[3];
                            *(h16x8_t*)((bf16_t*)out + off + bj * HALF) = wo; }
                        else { *(f32x4*)((float*)out + off + bj * HALF) = o0; *(f32x4*)((float*)out + off + bj * HALF + 4) = o1; } } }
            } else {
#pragma unroll
                for (int m = 0; m < 4; ++m) { const size_t off = (size_t)(row0 + ai * HALF + m * 16) * ldc + col0; f32x4 bb[2][2];
#pragma unroll
                    for (int bj = 0; bj < 2; ++bj) { bb[bj][0] = *(const f32x4*)((const float*)base + off + bj * HALF); bb[bj][1] = *(const f32x4*)((const float*)base + off + bj * HALF + 4); }
#pragma unroll
                    for (int bj = 0; bj < 2; ++bj) { const f32x4 o0 = bb[bj][0] + acc[ai][bj][m][0] * s, o1 = bb[bj][1] + acc[ai][bj][m][1] * s;
                        if (OB) { h16x8_t wo; wo[0] = (_Float16)o0[0]; wo[1] = (_Float16)o0[1]; wo[2] = (_Float16)o0[2]; wo[3] = (_Float16)o0[3]; wo[4] = (_Float16)o1[0]; wo[5] = (_Float16)o1[1]; wo[6] = (_Float16)o1[2]; wo[7] = (_Float16)o1[3];
                            *(h16x8_t*)((bf16_t*)out + off + bj * HALF) = wo; }
                        else { *(f32x4*)((float*)out + off + bj * HALF) = o0; *(f32x4*)((float*)out + off + bj * HALF + 4) = o1; } } }
            }
        }
    }
};
__device__ __forceinline__ f32x4 i32bits_to_f32(f32x4 v) { return (f32x4){(float)__float_as_int(v.x), (float)__float_as_int(v.y), (float)__float_as_int(v.z), (float)__float_as_int(v.w)}; }
template <bool IN8 = false>
struct EpiStore {
    static constexpr bool PERM = true, AFTER_DRAIN = false;
    bf16_t* O; int ldc; int gate_tile; float* G; RowTab rt; const float* cstep;
    __device__ __forceinline__ void operator()(const f32x4 (&acc)[2][2][4][2], const Unit& u, int wr, int wc, int fr, int fq) const {
        const int row0 = u.pm * BM + wr * 64 + fr, colt = u.pn * BM, cl = wc * 32 + 8 * fq; const int sl = IN8 ? rt.slot(u.pm) : 0;
        f32x4 cs[2][2];
#pragma unroll
        for (int bj = 0; bj < 2; ++bj)
#pragma unroll
            for (int n = 0; n < 2; ++n) cs[bj][n] = IN8 ? *(const f32x4*)(cstep + colt + bj * HALF + cl + 4 * n) : (f32x4){1.f, 1.f, 1.f, 1.f};
        if (u.pn >= gate_tile) {
            if (wc == 0 && fq < 2) {
#pragma unroll
                for (int ai = 0; ai < 2; ++ai)
#pragma unroll
                    for (int m = 0; m < 4; ++m) { const int rl = wr * 64 + ai * HALF + m * 16 + fr; float* gp = G + (size_t)(u.pm * BM + rl) * 16 + 8 * fq;
                        if (IN8) { const float rs = rt.tab[sl * 256 + rl]; *(f32x4*)gp = i32bits_to_f32(acc[ai][0][m][0]) * cs[0][0] * rs; *(f32x4*)(gp + 4) = i32bits_to_f32(acc[ai][0][m][1]) * cs[0][1] * rs; }
                        else { *(f32x4*)gp = acc[ai][0][m][0]; *(f32x4*)(gp + 4) = acc[ai][0][m][1]; } }
            }
            return;
        }
#pragma unroll
        for (int ai = 0; ai < 2; ++ai)
#pragma unroll
            for (int m = 0; m < 4; ++m) { const int rl = wr * 64 + ai * HALF + m * 16 + fr; bf16_t* rowp = O + (size_t)(u.pm * BM + rl) * ldc + colt + cl;
                const float rs = IN8 ? rt.tab[sl * 256 + rl] : 1.0f;
#pragma unroll
                for (int bj = 0; bj < 2; ++bj) { f32x4 v0 = acc[ai][bj][m][0], v1 = acc[ai][bj][m][1];
                    if (IN8) { v0 = i32bits_to_f32(v0) * cs[bj][0] * rs; v1 = i32bits_to_f32(v1) * cs[bj][1] * rs; }
                    u32x4 w; w.x = cvt_pk_bf16(v0[0], v0[1]); w.y = cvt_pk_bf16(v0[2], v0[3]); w.z = cvt_pk_bf16(v1[0], v1[1]); w.w = cvt_pk_bf16(v1[2], v1[3]);
                    *(u32x4*)(rowp + bj * HALF) = w; } }
    }
};
struct EpiRwkv1 {
    static constexpr bool PERM = true, AFTER_DRAIN = false;
    bf16_t* RKV; bf16_t* L; int Mrows;
    __device__ __forceinline__ void operator()(const f32x4 (&acc)[2][2][4][2], const Unit& u, int wr, int wc, int fr, int fq) const {
        const int pml = u.pm & (MROWS_TILES - 1), row0 = pml * BM + wr * 64 + fr, cl = wc * 32 + 8 * fq;
        bf16_t* base; int ldc, colt, mode;
        if (u.pn < 24) { base = RKV + (size_t)(u.pn >> 3) * Mrows * 2048; ldc = 2048; colt = (u.pn & 7) * BM; mode = 0; }
        else { base = L + (size_t)(u.pn - 24) * Mrows * 256; ldc = 256; colt = 0; mode = u.pn - 23; }
#pragma unroll
        for (int ai = 0; ai < 2; ++ai)
#pragma unroll
            for (int m = 0; m < 4; ++m) { bf16_t* rowp = base + (size_t)(row0 + ai * HALF + m * 16) * ldc + colt + cl;
#pragma unroll
                for (int bj = 0; bj < 2; ++bj) { float o[8];
#pragma unroll
                    for (int n = 0; n < 2; ++n)
#pragma unroll
                        for (int e = 0; e < 4; ++e) { float v = acc[ai][bj][m][n][e];
                            if (mode == 1) { const float t = __expf(-2.0f * fabsf(v)); const float th = (1.0f - t) * __builtin_amdgcn_rcpf(1.0f + t); v = v < 0.f ? -th : th; }
                            else if (mode == 3) v = fast_sigmoid(v);
                            o[4 * n + e] = v; }
                    u32x4 w; w.x = cvt_pk_bf16(o[0], o[1]); w.y = cvt_pk_bf16(o[2], o[3]); w.z = cvt_pk_bf16(o[4], o[5]); w.w = cvt_pk_bf16(o[6], o[7]);
                    *(u32x4*)(rowp + bj * HALF) = w; } }
    }
};
struct EpiRwkv2 {
    static constexpr bool PERM = true, AFTER_DRAIN = false;
    float* DEC; bf16_t* AG; bf16_t* GG; const float* w0; const float* a0;
    __device__ __forceinline__ void operator()(const f32x4 (&acc)[2][2][4][2], const Unit& u, int wr, int wc, int fr, int fq) const {
        const int pml = u.pm & (MROWS_TILES - 1), row0 = pml * BM + wr * 64 + fr, seg = u.pn >> 3, col0 = (u.pn & 7) * BM + wc * 32 + 8 * fq;
        const float* bias = seg == 0 ? w0 : a0;
        f32x4 bv[2][2];
#pragma unroll
        for (int bj = 0; bj < 2; ++bj)
#pragma unroll
            for (int n = 0; n < 2; ++n) bv[bj][n] = seg < 2 ? *(const f32x4*)(bias + col0 + bj * HALF + 4 * n) : (f32x4){0.f, 0.f, 0.f, 0.f};
#pragma unroll
        for (int ai = 0; ai < 2; ++ai)
#pragma unroll
            for (int m = 0; m < 4; ++m) { const size_t ro = (size_t)(row0 + ai * HALF + m * 16) * 2048;
#pragma unroll
                for (int bj = 0; bj < 2; ++bj) { const int col = col0 + bj * HALF; const f32x4 v0 = acc[ai][bj][m][0] + bv[bj][0], v1 = acc[ai][bj][m][1] + bv[bj][1];
                    if (seg == 0) { *(f32x4*)(DEC + ro + col) = v0; *(f32x4*)(DEC + ro + col + 4) = v1; }
                    else { u32x4 w; w.x = cvt_pk_bf16(v0[0], v0[1]); w.y = cvt_pk_bf16(v0[2], v0[3]); w.z = cvt_pk_bf16(v1[0], v1[1]); w.w = cvt_pk_bf16(v1[2], v1[3]);
                        *(u32x4*)((seg == 1 ? AG : GG) + ro + col) = w; } } }
    }
};
struct RwkvOrder1 { StaticOrder b;
    __device__ bool next(int i, Unit& u) const { if (!b.next(i, u)) return false; const int seg = u.pn < 24 ? (u.pn >> 3) : u.pn - 21; u.pm += ((0x541320 >> (4 * seg)) & 7) * MROWS_TILES; return true; }
    __device__ __forceinline__ void a_ready(const Unit&) const {}
    __device__ __forceinline__ void done(const Unit&) const {} };
struct RwkvOrder2 { StaticOrder b;
    __device__ bool next(int i, Unit& u) const { if (!b.next(i, u)) return false; u.pm += (u.pn >> 3) * MROWS_TILES; return true; }
    __device__ __forceinline__ void a_ready(const Unit&) const {}
    __device__ __forceinline__ void done(const Unit&) const {} };

template <class Epi, class Sched, bool ALIGN_EPI = false, bool SP2 = false, int DT = 0>
__device__ __forceinline__ void gemm_phase(PG8_LAS unsigned char* lds, const Gemm g, const Sched& S, const Epi& E, const int tid_in) {
    const int tid = tid_in, wid = __builtin_amdgcn_readfirstlane(tid >> 6), lane = tid & 63, wr = wid >> 2, wc = wid & 3, fr = lane & 15, fq = lane >> 4;
    int K_ = g.K; asm volatile("" : "+s"(K_));
    const int K = K_, nt = K / BK;
    unsigned voffA[2], voffB[2];
#pragma unroll
    for (int i = 0; i < 2; ++i) { int R, C; stage_rc(tid * 16 + i * 8192, R, C); const int Rb = Epi::PERM ? ((R & ~31) + perm32(R & 31)) : R;
        voffA[i] = (unsigned)(R * g.lda + C) * 2u; voffB[i] = (unsigned)(Rb * g.ldb + C) * 2u; }
    const size_t kstep = (size_t)(BK * 2);
    const size_t hstepA = (size_t)HALF * g.lda * 2, hstepB = (size_t)HALF * g.ldb * 2;
    const size_t tstepA = 2 * hstepA, tstepB = 2 * hstepB;
    const unsigned ldsw = (unsigned)wid * 1024u;
    const int aoff = lds_byte(wr * 64 + fr, fq * (DT == 1 ? 16 : 8)), boff = lds_byte(wc * 32 + fr, fq * (DT == 1 ? 16 : 8));
#define PG8_SA(b, h) (((b) * 2 + (h)) * HTB)
#define PG8_SB(b, h) ((4 + (b) * 2 + (h)) * HTB)
#define PG8_STAGE(bufoff, gbase, voff) do { _Pragma("unroll") for (int _i = 0; _i < 2; ++_i) \
        __builtin_amdgcn_global_load_lds((const unsigned*)((const char*)(gbase) + (voff)[_i]), (PG8_LAS unsigned*)(lds + (bufoff) + ldsw + _i * 8192), 16, 0, 0); } while (0)
#define PG8_LDA(dst, b, h) do { if constexpr (DT != 1) { _Pragma("unroll") for (int m = 0; m < 4; ++m) _Pragma("unroll") for (int k = 0; k < 2; ++k) dst[m][k] = *(const PG8_LAS bf16x8*)(lds + PG8_SA(b, h) + aoff + m * 2048 + k * 1024); } \
        else { _Pragma("unroll") for (int m = 0; m < 4; ++m) dst##8[m] = ld32(lds + PG8_SA(b, h) + aoff + m * 2048); } } while (0)
#define PG8_LDB(dst, b, h) do { if constexpr (DT != 1) { _Pragma("unroll") for (int n = 0; n < 2; ++n) _Pragma("unroll") for (int k = 0; k < 2; ++k) dst[n][k] = *(const PG8_LAS bf16x8*)(lds + PG8_SB(b, h) + boff + n * 2048 + k * 1024); } \
        else { _Pragma("unroll") for (int n = 0; n < 2; ++n) dst##8[n] = ld32(lds + PG8_SB(b, h) + boff + n * 2048); } } while (0)
#define PG8_MMA(ai, bj, At, Bt) do { __builtin_amdgcn_s_setprio(1); \
        if constexpr (DT == 0) { _Pragma("unroll") for (int m = 0; m < 4; ++m) _Pragma("unroll") for (int n = 0; n < 2; ++n) _Pragma("unroll") for (int k = 0; k < 2; ++k) \
            acc[ai][bj][m][n] = __builtin_amdgcn_mfma_f32_16x16x32_bf16(Bt[n][k], At[m][k], acc[ai][bj][m][n], 0, 0, 0); } \
        else if constexpr (DT == 2) { typedef int i32x4_ __attribute__((ext_vector_type(4))); _Pragma("unroll") for (int m = 0; m < 4; ++m) _Pragma("unroll") for (int n = 0; n < 2; ++n) _Pragma("unroll") for (int k = 0; k < 2; ++k) \
            acc[ai][bj][m][n] = __builtin_bit_cast(f32x4, __builtin_amdgcn_mfma_i32_16x16x64_i8(__builtin_bit_cast(i32x4_, Bt[n][k]), __builtin_bit_cast(i32x4_, At[m][k]), __builtin_bit_cast(i32x4_, acc[ai][bj][m][n]), 0, 0, 0)); } \
        else { _Pragma("unroll") for (int m = 0; m < 4; ++m) _Pragma("unroll") for (int n = 0; n < 2; ++n) \
            { constexpr int O_ = 0; const int o_ = (m * 2 + n) * 4; f32x4 c_ = {accq[ai][bj][o_], accq[ai][bj][o_ + 1], accq[ai][bj][o_ + 2], accq[ai][bj][o_ + 3]}; (void)O_; \
              c_ = __builtin_amdgcn_mfma_scale_f32_16x16x128_f8f6f4(Bt##8[n], At##8[m], c_, 0, 0, 0, 0x7F7F7F7F, 0, 0x7F7F7F7F); \
              accq[ai][bj][o_] = c_[0]; accq[ai][bj][o_ + 1] = c_[1]; accq[ai][bj][o_ + 2] = c_[2]; accq[ai][bj][o_ + 3] = c_[3]; } } \
        __builtin_amdgcn_s_setprio(0); } while (0)
#define PG8_WAIT_V(n) asm volatile("s_waitcnt vmcnt(" #n ")" ::: "memory")
#define PG8_WAIT_L(n) asm volatile("s_waitcnt lgkmcnt(" #n ")" ::: "memory")
#define PG8_BAR __builtin_amdgcn_s_barrier()
#define PG8_SCHED __builtin_amdgcn_sched_barrier(0)
    Unit cur, nxt; int ui = 0;
    if (!S.next(0, cur)) return;
    f32x4 acc[2][2][4][2];
    typedef float f32x32 __attribute__((ext_vector_type(32)));
    f32x32 accq[2][2];
    if constexpr (DT == 1) {
#pragma unroll
        for (int a = 0; a < 2; ++a)
#pragma unroll
            for (int b = 0; b < 2; ++b)
#pragma unroll
                for (int i = 0; i < 32; ++i) accq[a][b][i] = 0.f; }
#pragma unroll
    for (int a = 0; a < 2; ++a)
#pragma unroll
        for (int b = 0; b < 2; ++b)
#pragma unroll
            for (int m = 0; m < 4; ++m)
#pragma unroll
                for (int n = 0; n < 2; ++n) acc[a][b][m][n] = (f32x4){0.f, 0.f, 0.f, 0.f};
    bf16x8 At[4][2], B0[2][2], B1[2][2];
    i32x8 At8[4], B08[2], B18[2];
    const char* cA = (const char*)g.A + (size_t)cur.pm * tstepA; const char* cB = (const char*)g.Bt + (size_t)cur.pn * tstepB;
    S.a_ready(cur);
    if constexpr (SP2) {
        PG8_STAGE(PG8_SB(0, 0), cB, voffB); PG8_STAGE(PG8_SB(0, 1), cB + hstepB, voffB); PG8_STAGE(PG8_SA(0, 0), cA, voffA); PG8_STAGE(PG8_SA(0, 1), cA + hstepA, voffA);
        if (wr == 1) PG8_BAR;
        PG8_WAIT_V(2); PG8_BAR;
        PG8_STAGE(PG8_SB(1, 0), cB + kstep, voffB); PG8_STAGE(PG8_SA(1, 0), cA + kstep, voffA); PG8_STAGE(PG8_SB(1, 1), cB + hstepB + kstep, voffB);
        PG8_WAIT_V(6); PG8_BAR;
    } else {
        PG8_STAGE(PG8_SB(0, 0), cB, voffB); PG8_STAGE(PG8_SA(0, 0), cA, voffA); PG8_STAGE(PG8_SB(0, 1), cB + hstepB, voffB); PG8_STAGE(PG8_SA(0, 1), cA + hstepA, voffA);
        if (wr == 1) PG8_BAR;
        PG8_WAIT_V(4); PG8_BAR;
        PG8_STAGE(PG8_SB(1, 0), cB + kstep, voffB); PG8_STAGE(PG8_SA(1, 0), cA + kstep, voffA); PG8_STAGE(PG8_SB(1, 1), cB + hstepB + kstep, voffB);
        PG8_WAIT_V(6); PG8_BAR;
    }
    for (;;) {
        const bool has_next = S.next(ui + 1, nxt);
        const char* nA = has_next ? (const char*)g.A + (size_t)nxt.pm * tstepA : cA; const char* nB = has_next ? (const char*)g.Bt + (size_t)nxt.pn * tstepB : cB;
        for (int t = 0; t < nt; t += 2) {
            const bool last = (t == nt - 2);
            const char* a1 = cA + (size_t)(t + 1) * kstep;
            const char* a2 = last ? nA : cA + (size_t)(t + 2) * kstep; const char* b2 = last ? nB : cB + (size_t)(t + 2) * kstep;
            const char* a3 = a2 + kstep; const char* b3 = b2 + kstep;
            if (last && has_next) S.a_ready(nxt);
            if constexpr (SP2) {
            PG8_LDB(B0, 0, 0); PG8_LDB(B1, 0, 1); PG8_SCHED; PG8_LDA(At, 0, 0); PG8_STAGE(PG8_SA(1, 1), a1 + hstepA, voffA);
            PG8_WAIT_V(8); PG8_WAIT_L(0); PG8_BAR; PG8_MMA(0, 0, At, B0); PG8_MMA(0, 1, At, B1); PG8_BAR; PG8_SCHED;
            PG8_LDA(At, 0, 1); PG8_STAGE(PG8_SB(0, 0), b2, voffB); PG8_STAGE(PG8_SB(0, 1), b2 + hstepB, voffB); PG8_STAGE(PG8_SA(0, 0), a2, voffA);
            PG8_WAIT_V(8); PG8_WAIT_L(0); PG8_BAR; PG8_MMA(1, 0, At, B0); PG8_MMA(1, 1, At, B1); PG8_BAR; PG8_SCHED;
            PG8_LDB(B0, 1, 0); PG8_LDB(B1, 1, 1); PG8_SCHED; PG8_LDA(At, 1, 0); PG8_STAGE(PG8_SA(0, 1), a2 + hstepA, voffA);
            PG8_WAIT_V(8); PG8_WAIT_L(0); PG8_BAR; PG8_MMA(0, 0, At, B0); PG8_MMA(0, 1, At, B1); PG8_BAR; PG8_SCHED;
            PG8_LDA(At, 1, 1); PG8_STAGE(PG8_SB(1, 0), b3, voffB); PG8_STAGE(PG8_SB(1, 1), b3 + hstepB, voffB); PG8_STAGE(PG8_SA(1, 0), a3, voffA);
            PG8_WAIT_V(8); PG8_WAIT_L(0); PG8_BAR; PG8_MMA(1, 0, At, B0); PG8_MMA(1, 1, At, B1); PG8_BAR; PG8_SCHED;
            } else {
            PG8_LDB(B0, 0, 0); PG8_SCHED; PG8_LDA(At, 0, 0); PG8_STAGE(PG8_SA(1, 1), a1 + hstepA, voffA);
            PG8_WAIT_L(8); PG8_BAR; PG8_WAIT_L(0); PG8_MMA(0, 0, At, B0); PG8_BAR; PG8_SCHED;
            PG8_LDB(B1, 0, 1); PG8_STAGE(PG8_SB(0, 0), b2, voffB);
            PG8_BAR; PG8_WAIT_L(0); PG8_MMA(0, 1, At, B1); PG8_BAR;
            PG8_LDA(At, 0, 1); PG8_STAGE(PG8_SA(0, 0), a2, voffA);
            PG8_BAR; PG8_WAIT_L(0); PG8_MMA(1, 0, At, B0); PG8_BAR; PG8_SCHED;
            PG8_STAGE(PG8_SB(0, 1), b2 + hstepB, voffB);
            PG8_WAIT_V(6); PG8_BAR; PG8_MMA(1, 1, At, B1); PG8_BAR;
            PG8_LDB(B0, 1, 0); PG8_SCHED; PG8_LDA(At, 1, 0); PG8_STAGE(PG8_SA(0, 1), a2 + hstepA, voffA);
            PG8_WAIT_L(8); PG8_BAR; PG8_WAIT_L(0); PG8_MMA(0, 0, At, B0); PG8_BAR; PG8_SCHED;
            PG8_LDB(B1, 1, 1); PG8_STAGE(PG8_SB(1, 0), b3, voffB);
            PG8_BAR; PG8_WAIT_L(0); PG8_MMA(0, 1, At, B1); PG8_BAR;
            PG8_LDA(At, 1, 1); PG8_STAGE(PG8_SA(1, 0), a3, voffA);
            PG8_BAR; PG8_WAIT_L(0); PG8_MMA(1, 0, At, B0); PG8_BAR; PG8_SCHED;
            PG8_STAGE(PG8_SB(1, 1), b3 + hstepB, voffB);
            PG8_WAIT_V(6); PG8_BAR; PG8_MMA(1, 1, At, B1); PG8_BAR;
            }
        }
        if constexpr (ALIGN_EPI) { if (wr == 0) PG8_BAR; }
        if constexpr (DT == 1) {
#pragma unroll
            for (int a = 0; a < 2; ++a)
#pragma unroll
                for (int b = 0; b < 2; ++b)
#pragma unroll
                    for (int m = 0; m < 4; ++m)
#pragma unroll
                        for (int n = 0; n < 2; ++n) { const int o_ = (m * 2 + n) * 4; acc[a][b][m][n] = (f32x4){accq[a][b][o_], accq[a][b][o_ + 1], accq[a][b][o_ + 2], accq[a][b][o_ + 3]}; } }
        if constexpr (!Epi::AFTER_DRAIN) { E(acc, cur, wr, wc, fr, fq); S.done(cur); }
        if (!has_next) break;
#pragma unroll
        for (int a = 0; a < 2; ++a)
#pragma unroll
            for (int b = 0; b < 2; ++b)
#pragma unroll
                for (int m = 0; m < 4; ++m)
#pragma unroll
                    for (int n = 0; n < 2; ++n) acc[a][b][m][n] = (f32x4){0.f, 0.f, 0.f, 0.f};
        if constexpr (DT == 1) {
#pragma unroll
            for (int a = 0; a < 2; ++a)
#pragma unroll
                for (int b = 0; b < 2; ++b)
#pragma unroll
                    for (int i = 0; i < 32; ++i) accq[a][b][i] = 0.f; }
        cur = nxt; cA = nA; cB = nB; ++ui;
        if constexpr (ALIGN_EPI) { if (wr == 1) PG8_BAR; }
    }
    PG8_WAIT_V(0);
    if constexpr (!ALIGN_EPI) { if (wr == 0) PG8_BAR; }
    PG8_BAR;
    if constexpr (Epi::AFTER_DRAIN) { E.fused(acc, cur, wr, wc, fr, fq, lds, wid, lane); S.done(cur); }
#undef PG8_SA
#undef PG8_SB
#undef PG8_STAGE
#undef PG8_LDA
#undef PG8_LDB
#undef PG8_MMA
#undef PG8_WAIT_V
#undef PG8_WAIT_L
#undef PG8_BAR
#undef PG8_SCHED
}
}

constexpr int NWAVES = 8, NTHREADS = 512;
constexpr int DM = 2048, NBATCH = 8, SEQ = 4096, MTOK = NBATCH * SEQ, FF = 5632, DEPTH = 4;
constexpr float NORM_EPS = 1e-6f;
constexpr int ML_H = 8, ML_DK = 128, ML_DV = 256, ML_L = 64, ML_NC = SEQ / ML_L, ML_INCOLS = 6160, ML_NPAD = 6400, ML_ITEMS = NBATCH * ML_H * ML_NC;
constexpr int AT_DH = 64, AT_HQ = 32, AT_HKV = 4, AT_G = 8, AT_BLK = 128, AT_NB = SEQ / AT_BLK, AT_COLS = 2560, AT_UNITS = NBATCH * AT_NB * AT_HKV;
constexpr int RW_H = 32, RW_N = 64, RW_T = 32, RW_NBLK = SEQ / RW_T;
constexpr float RW_LN_EPS = 64e-5f;
enum { I_X = 0, I_POS, I_F1N, I_F1GU, I_F1DN, I_MN, I_F2N, I_F2GU, I_F2DN, I_MLWIN, I_MLBG, I_MLHG, I_MLWOUT, I_ATQKV, I_ATQG, I_ATKG, I_ATSINK, I_ATWO,
       I_RWMIX, I_RWRKV, I_RWW0, I_RWWLA, I_RWWLB, I_RWA0, I_RWALA, I_RWALB, I_RWGLA, I_RWGLB, I_RWKK, I_RWKA, I_RWRK, I_RWLNW, I_RWLNB, I_RWWO, N_IN };
constexpr size_t MiB = 1u << 20;
constexpr size_t WS_CTL = 0, CTL_ZERO_BYTES = 1 * MiB;
constexpr size_t WS_ROPE = 2 * MiB;
constexpr size_t WS_GATES = 4 * MiB;
constexpr size_t WS_STAT = 6 * MiB;
constexpr size_t WS_MST = 6 * MiB + 65536;
constexpr size_t WS_NV = 8 * MiB;
constexpr size_t WS_ROWQ = 10 * MiB;
constexpr int CW_CMAX = 65536;
constexpr int CW_CMAX2 = 65536 + 8 * 11264;
constexpr size_t WS_CSTEP2 = 11 * MiB + 512 * 1024;
constexpr size_t WS_CSTEP = 11 * MiB;
constexpr size_t WS_WGU1 = 16 * MiB, WS_WDN1 = 60 * MiB, WS_WGU2 = 82 * MiB, WS_WDN2 = 126 * MiB, WS_WMIX = 148 * MiB;
constexpr size_t WS_XN = 192 * MiB;
constexpr size_t WS_BIG = 320 * MiB;
constexpr size_t WS_END = WS_BIG + 1152 * MiB;
constexpr int CW_BAR = 4096;

#define GAS __attribute__((address_space(1)))
#define LAS __attribute__((address_space(3)))
typedef unsigned short bf16;
typedef unsigned v4u __attribute__((ext_vector_type(4)));
typedef unsigned v2u __attribute__((ext_vector_type(2)));
typedef float f32x4 __attribute__((ext_vector_type(4)));
typedef float f32x2 __attribute__((ext_vector_type(2)));
typedef float f32x16 __attribute__((ext_vector_type(16)));
typedef short bf16x8 __attribute__((ext_vector_type(8)));
typedef short s16x4 __attribute__((ext_vector_type(4)));
#define LDS_WAIT() asm volatile("s_waitcnt lgkmcnt(0)" ::: "memory")
#define VM_WAIT() asm volatile("s_waitcnt vmcnt(0)" ::: "memory")
#define MFMA32(a, b, c) __builtin_amdgcn_mfma_f32_32x32x16_bf16((a), (b), (c), 0, 0, 0)
__device__ __forceinline__ unsigned pk2(float lo, float hi) { return pg8::cvt_pk_bf16(lo, hi); }
__device__ __forceinline__ float bf2f(unsigned short h) { return __builtin_bit_cast(float, (unsigned)h << 16); }
__device__ __forceinline__ float bflo(unsigned w) { return __builtin_bit_cast(float, w << 16); }
__device__ __forceinline__ float bfhi(unsigned w) { return __builtin_bit_cast(float, w & 0xffff0000u); }
__device__ __forceinline__ unsigned short f2bf(float f) { return (unsigned short)(pk2(f, 0.f) & 0xffffu); }
__device__ __forceinline__ float wave_sum(float v) {
#pragma unroll
    for (int o = 1; o < 64; o <<= 1) v += __shfl_xor(v, o);
    return v;
}
__device__ __forceinline__ float wave_max(float v) {
#pragma unroll
    for (int o = 1; o < 64; o <<= 1) v = fmaxf(v, __shfl_xor(v, o));
    return v;
}

template <int CTRL, int RM> __device__ __forceinline__ float dpp_upd(float x) { return __builtin_bit_cast(float, __builtin_amdgcn_update_dpp(0, __builtin_bit_cast(int, x), CTRL, RM, 0xf, false)); }
__device__ __forceinline__ float wave_sum_dpp(float x) {
    x += dpp_upd<0xB1, 0xf>(x); x += dpp_upd<0x4E, 0xf>(x); x += dpp_upd<0x141, 0xf>(x); x += dpp_upd<0x140, 0xf>(x);
    x += dpp_upd<0x142, 0xa>(x); x += dpp_upd<0x143, 0xc>(x);
    return __builtin_bit_cast(float, __builtin_amdgcn_readlane(__builtin_bit_cast(int, x), 63));
}
__device__ __forceinline__ int crow(int reg, int h) { return (reg & 3) + 8 * (reg >> 2) + 4 * h; }
#define XB_TMO      128
#define XB_XCNT(j)  (256  + 64 * (j))
#define XB_XSUB(j)  (1280 + 64 * (j))
#define XB_XGEN(j)  (2304 + 64 * (j))
#define XB_TOP      3328
#define XB_TOPGEN   3392
#define XCD_BAR_WORDS 3456
#define XB_SPIN_CAP (1u << 18)

__device__ __forceinline__ unsigned xb_ld(unsigned* p)              { return __hip_atomic_load(p, __ATOMIC_RELAXED, __HIP_MEMORY_SCOPE_AGENT); }
__device__ __forceinline__ unsigned xb_add(unsigned* p, unsigned v) { return __hip_atomic_fetch_add(p, v, __ATOMIC_RELAXED, __HIP_MEMORY_SCOPE_AGENT); }
__device__ __forceinline__ unsigned xb_xcc_id() { return (unsigned)__builtin_amdgcn_s_getreg((3 << 11) | 20) & 0xFu; }
#define XB_SPIN(cond, bar) do { unsigned _sp = 0; while (cond) { __builtin_amdgcn_s_sleep(1); \
    if ((++_sp & 255u) == 0u) { if (xb_ld(&(bar)[XB_TMO])) break; if (_sp > XB_SPIN_CAP) { atomicAdd(&(bar)[XB_TMO], 1u); break; } } } } while (0)

struct XcdBarrier {
    unsigned* bar; unsigned x;
    volatile LAS unsigned* st;
};

__device__ __forceinline__ XcdBarrier xcd_barrier_post(unsigned* bar, volatile LAS unsigned* st) {
    XcdBarrier b; b.bar = bar; b.x = xb_xcc_id(); b.st = st;
    if (threadIdx.x == 0) (void)xb_add(&bar[XB_XCNT(b.x)], 1u);
    return b;
}
__device__ __forceinline__ void xcd_barrier_complete(unsigned* bar, unsigned x, unsigned& nloc, unsigned& nx) {
    const unsigned G = gridDim.x * gridDim.y * gridDim.z;
    unsigned sum, cnt, mine, sp = 0u;
    for (;;) {
        sum = 0u; cnt = 0u; mine = 0u;
#pragma unroll
        for (unsigned j = 0; j < 16; ++j) { const unsigned c = xb_ld(&bar[XB_XCNT(j)]); sum += c; cnt += (c > 0u) ? 1u : 0u; mine = (j == x) ? c : mine; }
        if (sum == G) break;
        __builtin_amdgcn_s_sleep(1);
        if ((++sp & 255u) == 0u) { if (xb_ld(&bar[XB_TMO])) break; if (sp > XB_SPIN_CAP) { atomicAdd(&bar[XB_TMO], 1u); break; } }
    }
    nloc = mine > 0u ? mine : 1u; nx = cnt > 0u ? cnt : 1u;
}

__device__ __forceinline__ void xcd_barrier(const XcdBarrier& b) {
    asm volatile("s_waitcnt vmcnt(0)" ::: "memory");
    __syncthreads();
    if (threadIdx.x == 0) {
        unsigned* bar = b.bar;
        __builtin_amdgcn_s_waitcnt(0);
        unsigned nloc = b.st[0], nx = b.st[1];
        if (nloc == 0u) { xcd_barrier_complete(bar, b.x, nloc, nx); b.st[0] = nloc; b.st[1] = nx; }
        const unsigned old = xb_add(&bar[XB_XSUB(b.x)], 1u);
        const unsigned gen = old / nloc;
        if (old + 1u == (gen + 1u) * nloc) {
            __builtin_amdgcn_fence(__ATOMIC_RELEASE, "agent");
            asm volatile("s_waitcnt vmcnt(0)" ::: "memory");
            const unsigned og = xb_add(&bar[XB_TOP], 1u);
            const unsigned tg = og / nx;
            if (og + 1u == (tg + 1u) * nx) xb_add(&bar[XB_TOPGEN], 1u);
            else XB_SPIN(xb_ld(&bar[XB_TOPGEN]) == tg, bar);
            __builtin_amdgcn_fence(__ATOMIC_ACQUIRE, "agent");
            xb_add(&bar[XB_XGEN(b.x)], 1u);
            asm volatile("s_waitcnt vmcnt(0)" ::: "memory");
        } else {
            XB_SPIN(xb_ld(&bar[XB_XGEN(b.x)]) == gen, bar);
            __builtin_amdgcn_fence(__ATOMIC_ACQUIRE, "agent");
            asm volatile("s_waitcnt vmcnt(0)" ::: "memory");
        }
    }
    __syncthreads();
}

struct Args { const float* in[N_IN]; float* out; unsigned char* ws; int ph_lo, ph_hi; };
struct Frame { LAS unsigned char* lds; int tid, lane, wave, G, bid; };

__device__ __forceinline__ void transpose_item(const float* W, int ldw, bf16* WT, int ldt, int k0, int n0, int dst_row0, LAS float* scr, int lane) {
#pragma unroll 8
    for (int i = 0; i < 32; ++i) { const int kk = 2 * i + (lane >> 5); scr[kk * 33 + (lane & 31)] = W[(size_t)(k0 + kk) * ldw + n0 + (lane & 31)]; }
    LDS_WAIT(); asm volatile("" ::: "memory");
    const int c = lane & 7;
#pragma unroll
    for (int j = 0; j < 4; ++j) { const int n = (lane >> 3) + 8 * j; const LAS float* s = scr + (8 * c) * 33 + n;
        v4u o; o.x = pk2(s[0 * 33], s[1 * 33]); o.y = pk2(s[2 * 33], s[3 * 33]); o.z = pk2(s[4 * 33], s[5 * 33]); o.w = pk2(s[6 * 33], s[7 * 33]);
        *(v4u*)(WT + (size_t)(dst_row0 + n) * ldt + k0 + 8 * c) = o; }
    LDS_WAIT(); asm volatile("" ::: "memory");
}
__device__ __forceinline__ void transpose_item_f8(const float* W, int ldw, unsigned char* WT, int ldt, int k0, int n0, int dst_row0, LAS float* scr, int lane, float scale) {
#pragma unroll 8
    for (int i = 0; i < 32; ++i) { const int kk = 2 * i + (lane >> 5); scr[kk * 33 + (lane & 31)] = __builtin_amdgcn_fmed3f(W[(size_t)(k0 + kk) * ldw + n0 + (lane & 31)] * scale, -448.f, 448.f); }
    LDS_WAIT(); asm volatile("" ::: "memory");
    const int c = lane & 7;
#pragma unroll
    for (int j = 0; j < 4; ++j) { const int n = (lane >> 3) + 8 * j; const LAS float* s = scr + (8 * c) * 33 + n; unsigned w0 = 0u, w1 = 0u;
        w0 = __builtin_amdgcn_cvt_pk_fp8_f32(s[0 * 33], s[1 * 33], w0, false); w0 = __builtin_amdgcn_cvt_pk_fp8_f32(s[2 * 33], s[3 * 33], w0, true);
        w1 = __builtin_amdgcn_cvt_pk_fp8_f32(s[4 * 33], s[5 * 33], w1, false); w1 = __builtin_amdgcn_cvt_pk_fp8_f32(s[6 * 33], s[7 * 33], w1, true);
        *(v2u*)(WT + (size_t)(dst_row0 + n) * ldt + k0 + 8 * c) = (v2u){w0, w1}; }
    LDS_WAIT(); asm volatile("" ::: "memory");
}
__device__ __forceinline__ void colmax_pass(Frame& F, const float* W, int K, int N, int ldw, unsigned* cmax) {
    const int nit = N * (K / 128);
    for (int it = F.bid * NTHREADS + F.tid; it < nit; it += F.G * NTHREADS) { const int n = it % N, k0 = (it / N) * 128; const float* p = W + (size_t)k0 * ldw + n; float m = 0.f;
#pragma unroll 8
        for (int k = 0; k < 128; ++k) m = fmaxf(m, fabsf(p[(size_t)k * ldw]));
        atomicMax(cmax + n, __builtin_bit_cast(unsigned, m)); }
}
__device__ __forceinline__ void colmax_wide(Frame& F, const float* W, int K, int N, unsigned* cmax, int ldw = 0) {
    LAS float* red = (LAS float*)F.lds;
    const int ncb = N / 256, nit = ncb * (K / 128), pitch = ldw ? ldw : N;
    for (int it = F.bid; it < nit; it += F.G) { const int cb = it % ncb, k0 = (it / ncb) * 128 + F.wave * 16;
        const f32x4* p = (const f32x4*)(W + (size_t)k0 * pitch + cb * 256) + F.lane; f32x4 m = {0.f, 0.f, 0.f, 0.f};
#pragma unroll
        for (int k = 0; k < 16; ++k) { const f32x4 v = p[(size_t)k * (pitch / 4)]; m.x = fmaxf(m.x, fabsf(v.x)); m.y = fmaxf(m.y, fabsf(v.y)); m.z = fmaxf(m.z, fabsf(v.z)); m.w = fmaxf(m.w, fabsf(v.w)); }
        *(LAS f32x4*)(red + F.wave * 256 + 4 * F.lane) = m;
        __syncthreads();
        if (F.tid < 256) { float r = red[F.tid];
#pragma unroll
            for (int w = 1; w < 8; ++w) r = fmaxf(r, red[w * 256 + F.tid]);
            atomicMax(cmax + cb * 256 + F.tid, __builtin_bit_cast(unsigned, r)); }
        __syncthreads(); }
}
__device__ __forceinline__ unsigned pack_i8x4(float a, float b, float c, float d) {
    const int ia = (int)rintf(a), ib = (int)rintf(b), ic = (int)rintf(c), id = (int)rintf(d);
    return (unsigned)(ia & 0xff) | ((unsigned)(ib & 0xff) << 8) | ((unsigned)(ic & 0xff) << 16) | ((unsigned)(id & 0xff) << 24);
}
__device__ __forceinline__ void conv_small_i8(Frame& F, const float* W, int ldw, int col_off, int K, int Nsrc, unsigned char* WT, int rows, const unsigned* cmax, float* cstep) {
    const int gt = F.bid * NTHREADS + F.tid, NT = F.G * NTHREADS;
    for (int idx = gt; idx < rows * (K / 4); idx += NT) { const int n = idx / (K / 4), k = 4 * (idx - n * (K / 4)); unsigned w = 0u;
        if (n < Nsrc) { const float cm = fmaxf(__builtin_bit_cast(float, __hip_atomic_load(cmax + col_off + n, __ATOMIC_RELAXED, __HIP_MEMORY_SCOPE_AGENT)), 1e-30f), sc = 127.0f / cm; const float* p = W + (size_t)k * ldw + col_off + n;
            w = pack_i8x4(p[0] * sc, p[ldw] * sc, p[2 * (size_t)ldw] * sc, p[3 * (size_t)ldw] * sc); if (k == 0) cstep[col_off + n] = cm * (1.0f / 127.0f); }
        else if (k == 0) cstep[col_off + n] = 1.0f;
        *(unsigned*)(WT + (size_t)n * K + k) = w; }
}
template <int MAP>
__device__ __forceinline__ void conv_T_i8(Frame& F, const float* W, int K, int N, int ldw, unsigned char* WT, const unsigned* cmax, float* cstep) {
    LAS float* scr = (LAS float*)(F.lds + F.wave * 16384);
    const int gw = F.bid * NWAVES + F.wave, NGW = F.G * NWAVES, nblk = N / 32, nitems = (K / 64) * nblk, lane = F.lane;
    for (int it = gw; it < nitems; it += NGW) { const int n0 = 32 * (it % nblk), k0 = 64 * (it / nblk); const int jj = n0 < FF ? n0 : n0 - FF; const int dr = MAP == 1 ? (jj >> 7) * 256 + (n0 < FF ? 0 : 128) + (jj & 127) : n0;
        const float cm = fmaxf(__builtin_bit_cast(float, __hip_atomic_load(cmax + n0 + (lane & 31), __ATOMIC_RELAXED, __HIP_MEMORY_SCOPE_AGENT)), 1e-30f), scale = 127.0f / cm;
        if (k0 == 0 && lane < 32) cstep[dr + lane] = cm * (1.0f / 127.0f);
#pragma unroll 8
        for (int i = 0; i < 32; ++i) { const int kk = 2 * i + (lane >> 5); scr[kk * 33 + (lane & 31)] = W[(size_t)(k0 + kk) * ldw + n0 + (lane & 31)] * scale; }
        LDS_WAIT(); asm volatile("" ::: "memory");
        const int c = lane & 7;
#pragma unroll
        for (int j = 0; j < 4; ++j) { const int n = (lane >> 3) + 8 * j; const LAS float* s = scr + (8 * c) * 33 + n;
            *(v2u*)(WT + (size_t)(dr + n) * K + k0 + 8 * c) = (v2u){pack_i8x4(s[0 * 33], s[1 * 33], s[2 * 33], s[3 * 33]), pack_i8x4(s[4 * 33], s[5 * 33], s[6 * 33], s[7 * 33])}; }
        LDS_WAIT(); asm volatile("" ::: "memory"); }
}
template <int MAP>
__device__ __forceinline__ void conv_T_f8(Frame& F, const float* W, int K, int N, unsigned char* WT, float scale) {
    LAS float* scr = (LAS float*)(F.lds + F.wave * 16384);
    const int gw = F.bid * NWAVES + F.wave, NGW = F.G * NWAVES, nblk = N / 32, nitems = (K / 64) * nblk;
    for (int it = gw; it < nitems; it += NGW) { const int n0 = 32 * (it % nblk); int dr = n0;
        if (MAP == 1) { const int jj = n0 < FF ? n0 : n0 - FF; dr = (jj >> 7) * 256 + (n0 < FF ? 0 : 128) + (jj & 127); }
        transpose_item_f8(W, N, WT, K, 64 * (it / nblk), n0, dr, scr, F.lane, scale); }
}
template <int MAP>
__device__ __forceinline__ void conv_T(Frame& F, const float* W, int K, int Nuse, int ldw, bf16* WT, int row_off) {
    LAS float* scr = (LAS float*)(F.lds + F.wave * 16384);
    const int gw = F.bid * NWAVES + F.wave, NGW = F.G * NWAVES, nblk = Nuse / 32, nitems = (K / 64) * nblk;
    for (int it = gw; it < nitems; it += NGW) { const int kb = it / nblk, n0 = 32 * (it % nblk); int dr;
        if (MAP == 1) { const int jj = n0 < FF ? n0 : n0 - FF; dr = (jj >> 7) * 256 + (n0 < FF ? 0 : 128) + (jj & 127); } else dr = row_off + n0;
        transpose_item(W, ldw, WT, K, 64 * kb, n0, dr, scr, F.lane); }
}
__device__ __forceinline__ void conv_small(Frame& F, const float* W, int ldw, int col_off, int Ksrc, int Nsrc, bf16* WT, int rows, int cols) {
    const int gt = F.bid * NTHREADS + F.tid, NT = F.G * NTHREADS;
    for (int idx = gt; idx < rows * cols; idx += NT) { const int n = idx / cols, k = idx - n * cols; const float v = (n < Nsrc && k < Ksrc) ? W[(size_t)k * ldw + col_off + n] : 0.f; WT[idx] = f2bf(v); }
}
template <class AT_>
__device__ __forceinline__ void conv_phase(const AT_& a, Frame& F, int l, bool f8dn1, bool f8dn2, bool f8gu1, bool f8gu2, bool i8gu1, bool i8gu2, bool i8mix) {
    unsigned char* ws = a.ws;
    if (i8gu1) conv_T_i8<1>(F, a.in[I_F1GU] + (size_t)l * DM * 2 * FF, DM, 2 * FF, 2 * FF, ws + WS_WGU1, (const unsigned*)(ws + WS_CTL) + CW_CMAX + (2 * l) * 2 * FF, (float*)(ws + WS_CSTEP) + (2 * l) * 2 * FF);
    else if (f8gu1) conv_T_f8<1>(F, a.in[I_F1GU] + (size_t)l * DM * 2 * FF, DM, 2 * FF, ws + WS_WGU1, pg8::W8_SCALE);
    else conv_T<1>(F, a.in[I_F1GU] + (size_t)l * DM * 2 * FF, DM, 2 * FF, 2 * FF, (bf16*)(ws + WS_WGU1), 0);
    if (f8dn1) conv_T_f8<0>(F, a.in[I_F1DN] + (size_t)l * FF * DM, FF, DM, ws + WS_WDN1, pg8::W8_SCALE);
    else conv_T<0>(F, a.in[I_F1DN] + (size_t)l * FF * DM, FF, DM, DM, (bf16*)(ws + WS_WDN1), 0);
    if (i8gu2) conv_T_i8<1>(F, a.in[I_F2GU] + (size_t)l * DM * 2 * FF, DM, 2 * FF, 2 * FF, ws + WS_WGU2, (const unsigned*)(ws + WS_CTL) + CW_CMAX + (2 * l + 1) * 2 * FF, (float*)(ws + WS_CSTEP) + (2 * l + 1) * 2 * FF);
    else if (f8gu2) conv_T_f8<1>(F, a.in[I_F2GU] + (size_t)l * DM * 2 * FF, DM, 2 * FF, ws + WS_WGU2, pg8::W8_SCALE);
    else conv_T<1>(F, a.in[I_F2GU] + (size_t)l * DM * 2 * FF, DM, 2 * FF, 2 * FF, (bf16*)(ws + WS_WGU2), 0);
    if (f8dn2) conv_T_f8<0>(F, a.in[I_F2DN] + (size_t)l * FF * DM, FF, DM, ws + WS_WDN2, pg8::W8_SCALE);
    else conv_T<0>(F, a.in[I_F2DN] + (size_t)l * FF * DM, FF, DM, DM, (bf16*)(ws + WS_WDN2), 0);
    bf16* WA = (bf16*)(ws + WS_WMIX); bf16* WO = (bf16*)(ws + WS_WMIX + 26 * MiB);
    const int kind = l % 3, j = l / 3;
    if (kind == 0) {
        const float* win = a.in[I_MLWIN] + (size_t)j * DM * ML_INCOLS;
        if (i8mix) { const unsigned* cm = (const unsigned*)(ws + WS_CTL) + CW_CMAX2 + 6400 * l; float* cs = (float*)(ws + WS_CSTEP2) + 6400 * l;
            conv_T_i8<0>(F, win, DM, 6144, ML_INCOLS, (unsigned char*)WA, cm, cs);
            conv_small_i8(F, win, ML_INCOLS, 6144, DM, 16, (unsigned char*)WA + (size_t)6144 * DM, 256, cm, cs); }
        else { conv_T<0>(F, win, DM, 6144, ML_INCOLS, WA, 0);
        conv_small(F, win, ML_INCOLS, 6144, DM, 16, WA + (size_t)6144 * DM, 256, DM); }
        conv_T<0>(F, a.in[I_MLWOUT] + (size_t)j * DM * DM, DM, DM, DM, WO, 0);
    } else if (kind == 1) {
        if (i8mix) conv_T_i8<0>(F, a.in[I_ATQKV] + (size_t)j * DM * AT_COLS, DM, AT_COLS, AT_COLS, (unsigned char*)WA, (const unsigned*)(ws + WS_CTL) + CW_CMAX2 + 6400 * l, (float*)(ws + WS_CSTEP2) + 6400 * l);
        else conv_T<0>(F, a.in[I_ATQKV] + (size_t)j * DM * AT_COLS, DM, AT_COLS, AT_COLS, WA, 0);
        conv_T<0>(F, a.in[I_ATWO] + (size_t)j * DM * DM, DM, DM, DM, WO, 0);
    } else {
        for (int z = 0; z < 3; ++z) conv_T<0>(F, a.in[I_RWRKV] + ((size_t)j * 3 + z) * DM * DM, DM, DM, DM, WA, z * DM);
        bf16* WLA = WA + (size_t)6144 * DM;
        conv_small(F, a.in[I_RWWLA] + (size_t)j * DM * 96, 96, 0, DM, 96, WLA, 256, DM);
        conv_small(F, a.in[I_RWALA] + (size_t)j * DM * 96, 96, 0, DM, 96, WLA + (size_t)256 * DM, 256, DM);
        conv_small(F, a.in[I_RWGLA] + (size_t)j * DM * 256, 256, 0, DM, 256, WLA + (size_t)512 * DM, 256, DM);
        bf16* WLB = (bf16*)(ws + WS_WMIX + 28 * MiB);
        conv_small(F, a.in[I_RWWLB] + (size_t)j * 96 * DM, DM, 0, 96, DM, WLB, DM, 256);
        conv_small(F, a.in[I_RWALB] + (size_t)j * 96 * DM, DM, 0, 96, DM, WLB + (size_t)DM * 256, DM, 256);
        conv_small(F, a.in[I_RWGLB] + (size_t)j * 256 * DM, DM, 0, 256, DM, WLB + (size_t)2 * DM * 256, DM, 256);
        conv_T<0>(F, a.in[I_RWWO] + (size_t)j * DM * DM, DM, DM, DM, (bf16*)(ws + WS_WMIX + 32 * MiB), 0);
    }
}

template <bool SB> __device__ __forceinline__ void load_row(const void* xin, size_t row, int lane, f32x4 (&v)[8]) {
    if (SB) { typedef _Float16 h16x4_t __attribute__((ext_vector_type(4))); const h16x4_t* xr = (const h16x4_t*)((const bf16*)xin + row * DM) + lane;
#pragma unroll
        for (int q = 0; q < 8; ++q) { const h16x4_t w = xr[64 * q]; v[q] = (f32x4){(float)w[0], (float)w[1], (float)w[2], (float)w[3]}; } }
    else { const f32x4* xr = (const f32x4*)((const float*)xin + row * DM) + lane;
#pragma unroll
        for (int q = 0; q < 8; ++q) v[q] = xr[64 * q]; }
}
template <int MODE, bool SB, int F8 = 0, class AT_>
__device__ __forceinline__ void norm_phase(const AT_& a, Frame& F, const void* xin, const float* gain, int j) {
    unsigned char* ws = a.ws; const int lane = F.lane;
    const int gw = F.bid * NWAVES + F.wave, NGW = F.G * NWAVES;
    f32x4 gn[8];
#pragma unroll
    for (int q = 0; q < 8; ++q) gn[q] = *(const f32x4*)(gain + 4 * lane + 256 * q);
    if (MODE != 2) {
        bf16* xn = (bf16*)(ws + WS_XN);
        for (int row = gw; row < MTOK; row += NGW) {
            f32x4 v[8]; float ss = 0.f; load_row<SB>(xin, (size_t)row, lane, v);
#pragma unroll
            for (int q = 0; q < 8; ++q) ss += (v[q].x * v[q].x + v[q].y * v[q].y) + (v[q].z * v[q].z + v[q].w * v[q].w);
            const float rstd = 1.0f / sqrtf(wave_sum(ss) * (1.0f / DM) + NORM_EPS);
            if (F8 == 2) { unsigned* o4 = (unsigned*)((unsigned char*)xn + (size_t)row * DM) + lane; float mx = 0.f;
#pragma unroll
                for (int q = 0; q < 8; ++q) { v[q] = v[q] * rstd * gn[q]; mx = fmaxf(fmaxf(mx, fmaxf(fabsf(v[q].x), fabsf(v[q].y))), fmaxf(fabsf(v[q].z), fabsf(v[q].w))); }
                mx = fmaxf(wave_max(mx), 1e-30f); const float qs = 127.0f / mx;
#pragma unroll
                for (int q = 0; q < 8; ++q) o4[64 * q] = pack_i8x4(v[q].x * qs, v[q].y * qs, v[q].z * qs, v[q].w * qs);
                if (lane == 0) ((float*)(ws + WS_ROWQ))[row] = mx * (1.0f / 127.0f); }
            else if (F8 == 1) { unsigned* o4 = (unsigned*)((unsigned char*)xn + (size_t)row * DM) + lane;
#pragma unroll
                for (int q = 0; q < 8; ++q) { const f32x4 y = v[q] * (rstd * pg8::X8_SCALE) * gn[q]; unsigned w = 0u;
                    w = __builtin_amdgcn_cvt_pk_fp8_f32(__builtin_amdgcn_fmed3f(y.x, -448.f, 448.f), __builtin_amdgcn_fmed3f(y.y, -448.f, 448.f), w, false);
                    w = __builtin_amdgcn_cvt_pk_fp8_f32(__builtin_amdgcn_fmed3f(y.z, -448.f, 448.f), __builtin_amdgcn_fmed3f(y.w, -448.f, 448.f), w, true); o4[64 * q] = w; } }
            else { v2u* o8 = (v2u*)(xn + (size_t)row * DM) + lane;
#pragma unroll
                for (int q = 0; q < 8; ++q) { const f32x4 y = v[q] * rstd * gn[q]; v2u w; w.x = pk2(y.x, y.y); w.y = pk2(y.z, y.w); o8[64 * q] = w; } }
            if (MODE == 1 && lane < 8) {
                const int pos = ((const int*)a.in[I_POS])[row];
                const float inv_freq = powf(500000.0f, -(float)(2 * lane) / 16.0f); const float ang = (float)pos * inv_freq;
                const double rev = (double)ang * 0.15915494309189535; const float fr = (float)(rev - floor(rev));
                float* rp = (float*)(ws + WS_ROPE) + (size_t)row * 16; rp[lane] = __builtin_amdgcn_cosf(fr); rp[8 + lane] = __builtin_amdgcn_sinf(fr);
            }
        }
    } else {
        LAS float* mixs = (LAS float*)F.lds; const float* mix = a.in[I_RWMIX] + (size_t)j * 6 * DM;
        for (int i = F.tid; i < 6 * DM; i += NTHREADS) mixs[i] = mix[i];
        __syncthreads();
        bf16* xm = (bf16*)(ws + WS_BIG);
        for (int blk = gw; blk < MTOK / 16; blk += NGW) {
            const int row0 = blk * 16; f32x4 prev[8];
            if ((row0 % SEQ) == 0) {
#pragma unroll
                for (int q = 0; q < 8; ++q) prev[q] = (f32x4){0.f, 0.f, 0.f, 0.f};
            } else {
                float ss = 0.f; load_row<SB>(xin, (size_t)(row0 - 1), lane, prev);
#pragma unroll
                for (int q = 0; q < 8; ++q) ss += (prev[q].x * prev[q].x + prev[q].y * prev[q].y) + (prev[q].z * prev[q].z + prev[q].w * prev[q].w);
                const float rstd = 1.0f / sqrtf(wave_sum(ss) * (1.0f / DM) + NORM_EPS);
#pragma unroll
                for (int q = 0; q < 8; ++q) prev[q] = prev[q] * rstd * gn[q];
            }
            for (int rr = 0; rr < 16; ++rr) {
                const int row = row0 + rr; f32x4 v[8]; float ss = 0.f; load_row<SB>(xin, (size_t)row, lane, v);
#pragma unroll
                for (int q = 0; q < 8; ++q) ss += (v[q].x * v[q].x + v[q].y * v[q].y) + (v[q].z * v[q].z + v[q].w * v[q].w);
                const float rstd = 1.0f / sqrtf(wave_sum(ss) * (1.0f / DM) + NORM_EPS);
#pragma unroll
                for (int q = 0; q < 8; ++q) v[q] = v[q] * rstd * gn[q];
#pragma unroll 1
                for (int z = 0; z < 6; ++z) { v2u* o8 = (v2u*)(xm + ((size_t)z * MTOK + row) * DM) + lane;
#pragma unroll
                    for (int q = 0; q < 8; ++q) { const f32x4 mx = *(const LAS f32x4*)(mixs + z * DM + 4 * lane + 256 * q); const f32x4 y = v[q] + (prev[q] - v[q]) * mx;
                        v2u w; w.x = pk2(y.x, y.y); w.y = pk2(y.z, y.w); o8[64 * q] = w; } }
#pragma unroll
                for (int q = 0; q < 8; ++q) prev[q] = v[q];
            }
        }
    }
}
__device__ __forceinline__ float log_sigmoid(float x) { return fminf(x, 0.f) - __logf(1.0f + __expf(-fabsf(x))); }
__device__ __forceinline__ float wave_incl_scan(float v, int lane) {
#pragma unroll
    for (int o = 1; o < 64; o <<= 1) { const float n = __shfl_up(v, o); if (lane >= o) v += n; }
    return v;
}
#define WG_BAR() do { asm volatile("s_waitcnt lgkmcnt(0)" ::: "memory"); __builtin_amdgcn_s_barrier(); asm volatile("" ::: "memory"); } while (0)
template <class AT_>
__device__ __forceinline__ void mlstm_phase_ab(const AT_& a, Frame& F, int j) {
    unsigned char* ws = a.ws; const int tid = F.tid, lane = F.lane, w = F.wave, r = lane & 31, hh = lane >> 5;
    const bf16* QKVO = (const bf16*)(ws + WS_BIG); const float* GT = (const float*)(ws + WS_GATES);
    bf16* UC = (bf16*)(ws + WS_BIG + 384 * MiB); float* NV = (float*)(ws + WS_NV); float* MST = (float*)(ws + WS_MST);
    const float* bg = a.in[I_MLBG] + j * 16;
    LAS bf16* Vwt = (LAS bf16*)F.lds; LAS bf16* Kt = (LAS bf16*)(F.lds + 9216);
    LAS float* WQ = (LAS float*)(F.lds + 65536); LAS float* GS = (LAS float*)(F.lds + 65536 + 16384);
    const float kscale = 0.08838834764831845f;
    const int vb = w & 1, kb = w >> 1;
    for (int u = F.bid; u < NBATCH * ML_H * 4; u += F.G) {
        const int qd = (u >> 3) & 3, bh = (u & 7) + 8 * (u >> 5), b = bh >> 3, h = bh & 7;
        const float bgi = bg[h], bgf = bg[8 + h];
        v4u xvA, xvB, xvC, xvD, xkA0, xkA1, xkB0, xkB1, xkC0, xkC1, xkD0, xkD1;
#define MLAB_LOAD(CC, XV, XK0, XK1) do { const bf16* rowp = QKVO + (size_t)(b * SEQ + (CC) * ML_L + lane) * 6144; \
            XV = *(const v4u*)(rowp + 2048 + h * 256 + 64 * qd + 8 * w); XK0 = *(const v4u*)(rowp + 1024 + h * 128 + 8 * w); XK1 = *(const v4u*)(rowp + 1024 + h * 128 + 8 * (w + 8)); } while (0)
        MLAB_LOAD(0, xvA, xkA0, xkA1); MLAB_LOAD(1, xvB, xkB0, xkB1); MLAB_LOAD(2, xvC, xkC0, xkC1); MLAB_LOAD(3, xvD, xkD0, xkD1);
#pragma unroll
        for (int k = 0; k < 8; ++k) { const int cc = 8 * w + k; const size_t t = (size_t)(b * SEQ + cc * ML_L + lane) * 16;
            const float li = GT[t + h] + bgi; const float lf = log_sigmoid(GT[t + 8 + h] + bgf);
            const float bs = wave_incl_scan(lf, lane); const float g = __shfl(bs, 63); const float lw = g - bs + li; const float am = wave_max(lw);
            WQ[cc * 64 + lane] = __expf(lw - am);
            if (qd == 0) { float* blg = (float*)(ws + 12 * MiB); blg[t + h] = bs; blg[t + 8 + h] = li - bs; }
            if (lane == 0) { GS[2 * cc] = g; GS[2 * cc + 1] = am; } }
        f32x16 Cst; float m = 0.f, nn = 0.f;
#pragma unroll
        for (int i = 0; i < 16; ++i) Cst[i] = 0.f;
        WG_BAR();
#define MLAB_CHUNK(CC, XV, XK0, XK1) do { const int c_ = (CC), it = bh * ML_NC + c_; LAS bf16* Vw = Vwt + (c_ & 1) * 14336; LAS bf16* Kk = Kt + (c_ & 1) * 14336; const LAS float* wqc = WQ + c_ * 64; \
            {   const float wsv = wqc[lane];        \
                _Pragma("unroll") for (int e = 0; e < 4; ++e) { const unsigned wd = XV[e]; Vw[(8 * w + 2 * e) * 72 + lane] = f2bf(bflo(wd) * wsv); Vw[(8 * w + 2 * e + 1) * 72 + lane] = f2bf(bfhi(wd) * wsv); } \
                _Pragma("unroll") for (int e = 0; e < 4; ++e) { const unsigned wd = XK0[e]; Kk[(8 * w + 2 * e) * 72 + lane] = f2bf(bflo(wd) * kscale); Kk[(8 * w + 2 * e + 1) * 72 + lane] = f2bf(bfhi(wd) * kscale); } \
                _Pragma("unroll") for (int e = 0; e < 4; ++e) { const unsigned wd = XK1[e]; Kk[(8 * (w + 8) + 2 * e) * 72 + lane] = f2bf(bflo(wd) * kscale); Kk[(8 * (w + 8) + 2 * e + 1) * 72 + lane] = f2bf(bfhi(wd) * kscale); } } \
            WG_BAR(); \
            if (c_ + 4 < ML_NC) MLAB_LOAD(c_ + 4, XV, XK0, XK1); \
            const float g = GS[2 * c_], am = GS[2 * c_ + 1]; \
            float uu = 0.f; \
            if (tid < 128) { \
                _Pragma("unroll") for (int s8 = 0; s8 < 8; ++s8) { const v4u kk = *(const LAS v4u*)(Kk + tid * 72 + 8 * s8); const f32x4 wa = *(const LAS f32x4*)(wqc + 8 * s8), wb = *(const LAS f32x4*)(wqc + 8 * s8 + 4); \
                    uu += (bflo(kk.x) * wa.x + bfhi(kk.x) * wa.y) + (bflo(kk.y) * wa.z + bfhi(kk.y) * wa.w) + (bflo(kk.z) * wb.x + bfhi(kk.z) * wb.y) + (bflo(kk.w) * wb.z + bfhi(kk.w) * wb.w); } } \
            f32x16 acc; \
            _Pragma("unroll") for (int i = 0; i < 16; ++i) acc[i] = 0.f; \
            _Pragma("unroll") for (int ks = 0; ks < 4; ++ks) { const bf16x8 af = *(const LAS bf16x8*)(Vw + (32 * vb + r) * 72 + 16 * ks + 8 * hh); const bf16x8 bfr = *(const LAS bf16x8*)(Kk + (32 * kb + r) * 72 + 16 * ks + 8 * hh); \
                acc = MFMA32(bfr, af, acc); }        \
            bf16* Uo = UC + (size_t)it * 32768 + (size_t)(64 * qd + 32 * vb + r) * 128 + 32 * kb + 4 * hh;        \
            _Pragma("unroll") for (int g4 = 0; g4 < 4; ++g4) { v2u o; o.x = pk2(Cst[4 * g4], Cst[4 * g4 + 1]); o.y = pk2(Cst[4 * g4 + 2], Cst[4 * g4 + 3]); *(v2u*)(Uo + 8 * g4) = o; } \
            if (qd == 0) { if (tid < 128) NV[(size_t)it * 128 + tid] = nn; if (tid == 0) MST[it] = m; } \
            const float mn = fmaxf(g + m, am), dec = __expf(g + m - mn), sc = __expf(am - mn); \
            _Pragma("unroll") for (int i = 0; i < 16; ++i) Cst[i] = dec * Cst[i] + sc * acc[i]; \
            nn = dec * nn + sc * uu; m = mn; } while (0)
        for (int c = 0; c < ML_NC; c += 4) { MLAB_CHUNK(c, xvA, xkA0, xkA1); MLAB_CHUNK(c + 1, xvB, xkB0, xkB1); MLAB_CHUNK(c + 2, xvC, xkC0, xkC1); MLAB_CHUNK(c + 3, xvD, xkD0, xkD1); }
        WG_BAR();
#undef MLAB_CHUNK
#undef MLAB_LOAD
    }
}
template <class AT_>
__device__ __forceinline__ void mlstm_phase_c(const AT_& a, Frame& F, int j) {
    unsigned char* ws = a.ws; const int tid = F.tid, lane = F.lane, w = F.wave, r = lane & 31, hh = lane >> 5;
    const bf16* QKVO = (const bf16*)(ws + WS_BIG); const float* GT = (const float*)(ws + WS_GATES);
    const bf16* UC = (const bf16*)(ws + WS_BIG + 384 * MiB); const float* NV = (const float*)(ws + WS_NV); const float* MST = (const float*)(ws + WS_MST);
    bf16* HS = (bf16*)(ws + WS_XN);
    const float* bg = a.in[I_MLBG] + j * 16; const float* hgain = a.in[I_MLHG] + (size_t)j * ML_H * ML_DV;
    LAS float* bb = (LAS float*)F.lds; LAS float* lis = bb + 64; LAS float* nvs = bb + 128;
    LAS bf16* Qs = (LAS bf16*)(F.lds + 1024); LAS bf16* Ks = (LAS bf16*)(F.lds + 1024 + 17408); LAS bf16* Vt = (LAS bf16*)(F.lds + 1024 + 34816);
    LAS float* hbuf = (LAS float*)(F.lds + 1024);
    LAS unsigned char* CL = F.lds + 73728;
#define MLC_FRAG(f) ((f) * 1024 + ((f) >= 56 ? 1024 : 0))
    const float kscale = 0.08838834764831845f;
    const int qb2 = w >> 2, dq = w & 3;
    v4u xq[2], xk[2], xv[4]; v2u ogw[8]; float gli = 0.f, glf = 0.f, nv_r = 0.f, mst_r = 0.f;
#define MLC_LOAD_X(IT) do { const int it_ = (IT), h_ = (it_ >> 6) & 7, t0_ = (it_ >> 9) * SEQ + (it_ & 63) * ML_L; \
        _Pragma("unroll") for (int i = 0; i < 2; ++i) { const int q = tid + 512 * i, s = q >> 4, c8 = q & 15; const bf16* rowp = QKVO + (size_t)(t0_ + s) * 6144 + h_ * 128 + 8 * c8; xq[i] = *(const v4u*)rowp; xk[i] = *(const v4u*)(rowp + 1024); } \
        { const bf16* rowp = QKVO + (size_t)(t0_ + lane) * 6144 + 2048 + h_ * 256; _Pragma("unroll") for (int i = 0; i < 4; ++i) xv[i] = *(const v4u*)(rowp + 8 * (w + 8 * i)); } \
        if (w == 0) { const float* blg = (const float*)(ws + 12 * MiB); gli = blg[(size_t)(t0_ + lane) * 16 + h_]; glf = blg[(size_t)(t0_ + lane) * 16 + 8 + h_]; } \
        if (tid < 128) nv_r = NV[(size_t)it_ * 128 + tid]; \
        mst_r = MST[it_]; } while (0)
#define MLC_LOAD_C(IT) do { const bf16* Cg = UC + (size_t)(IT) * 32768;        \
        _Pragma("unroll") for (int s4 = 0; s4 < 4; ++s4) _Pragma("unroll") for (int db = 0; db < 2; ++db) { const int s = 4 * qb2 + s4; \
            __builtin_amdgcn_global_load_lds((const unsigned*)(Cg + (64 * dq + 32 * db + r) * 128 + 16 * s + 8 * hh), (LAS unsigned*)(CL + MLC_FRAG((dq * 8 + s) * 2 + db)), 16, 0, 0); } } while (0)
#define MLC_LOAD_O(IT) do { const int it_ = (IT), h_ = (it_ >> 6) & 7, t0_ = (it_ >> 9) * SEQ + (it_ & 63) * ML_L; \
        _Pragma("unroll") for (int i = 0; i < 8; ++i) ogw[i] = *(const v2u*)(QKVO + (size_t)(t0_ + 8 * w + i) * 6144 + 4096 + h_ * 256 + 4 * lane); } while (0)
    if (F.bid < ML_ITEMS) { MLC_LOAD_X(F.bid); MLC_LOAD_C(F.bid); MLC_LOAD_O(F.bid); }
    for (int it = F.bid; it < ML_ITEMS; it += F.G) {
        const int b = it >> 9, h = (it >> 6) & 7, c = it & 63, tok0 = b * SEQ + c * ML_L; const int nit = it + F.G; const bool has = nit < ML_ITEMS;
        if (w == 0) { bb[lane] = gli; lis[lane] = glf; }
        if (tid < 128) nvs[tid] = nv_r;
#pragma unroll
        for (int i = 0; i < 2; ++i) { const int q = tid + 512 * i, s = q >> 4, c8 = q & 15;
            *(LAS v4u*)(Qs + s * 136 + 8 * c8) = xq[i];
            const v4u x = xk[i]; v4u y;
#pragma unroll
            for (int e = 0; e < 4; ++e) y[e] = pk2(bflo(x[e]) * kscale, bfhi(x[e]) * kscale);
            *(LAS v4u*)(Ks + s * 136 + 8 * c8) = y; }
        {
#pragma unroll
            for (int i = 0; i < 4; ++i) { const int c8 = w + 8 * i; const v4u x = xv[i];
#pragma unroll
                for (int e = 0; e < 4; ++e) { Vt[(8 * c8 + 2 * e) * 72 + lane] = (bf16)(x[e] & 0xffffu); Vt[(8 * c8 + 2 * e + 1) * 72 + lane] = (bf16)(x[e] >> 16); } } }
        const float mst = mst_r;
        asm volatile("s_waitcnt vmcnt(0) lgkmcnt(0)" ::: "memory"); __builtin_amdgcn_s_barrier(); asm volatile("" ::: "memory");
        if (has) MLC_LOAD_X(nit);
        const int t = 32 * qb2 + r; const float bt = bb[t];
        bf16x8 Qf[8]; f32x4 blv[2][4];
#pragma unroll
        for (int s = 0; s < 8; ++s) Qf[s] = *(const LAS bf16x8*)(Qs + t * 136 + 16 * s + 8 * hh);
#pragma unroll
        for (int kb = 0; kb < 2; ++kb) if (kb <= qb2) {
#pragma unroll
            for (int g = 0; g < 4; ++g) blv[kb][g] = *(const LAS f32x4*)(lis + 32 * kb + 8 * g + 4 * hh); }
        f32x16 accs[2];
#pragma unroll
        for (int kb = 0; kb < 2; ++kb)
#pragma unroll
            for (int i = 0; i < 16; ++i) accs[kb][i] = 0.f;
#pragma unroll
        for (int kb = 0; kb < 2; ++kb) if (kb <= qb2) { bf16x8 kf[8];
#pragma unroll
            for (int s = 0; s < 8; ++s) kf[s] = *(const LAS bf16x8*)(Ks + (32 * kb + r) * 136 + 16 * s + 8 * hh);
            asm volatile("" : "+v"(kf[0]), "+v"(kf[1]), "+v"(kf[2]), "+v"(kf[3]), "+v"(kf[4]), "+v"(kf[5]), "+v"(kf[6]), "+v"(kf[7]));
#pragma unroll
            for (int s = 0; s < 8; ++s) accs[kb] = MFMA32(kf[s], Qf[s], accs[kb]); }
        float mi = -INFINITY;
#pragma unroll
        for (int kb = 0; kb < 2; ++kb) if (kb <= qb2) {
#pragma unroll
            for (int i = 0; i < 16; ++i) { const int sp = 32 * kb + crow(i, hh); const float ld = bt + blv[kb][i >> 2][i & 3]; mi = fmaxf(mi, sp <= t ? ld : -INFINITY); } }
        mi = fmaxf(mi, __shfl_xor(mi, 32));
        const float mout = fmaxf(bt + mst, mi); float den = 0.f;
#pragma unroll
        for (int kb = 0; kb < 2; ++kb) if (kb <= qb2) {
#pragma unroll
            for (int i = 0; i < 16; ++i) { const int sp = 32 * kb + crow(i, hh); const float ex = __expf(bt + blv[kb][i >> 2][i & 3] - mout); const float d = (sp <= t) ? ex : 0.f; const float sv = accs[kb][i] * d; accs[kb][i] = sv; den += sv; } }
        den += __shfl_xor(den, 32);
        const float winter = __expf(bt + mst - mout);
        f32x16 accn[2];
#pragma unroll
        for (int db = 0; db < 2; ++db)
#pragma unroll
            for (int i = 0; i < 16; ++i) accn[db][i] = 0.f;
#pragma unroll
        for (int s = 0; s < 8; ++s)
#pragma unroll
            for (int db = 0; db < 2; ++db) accn[db] = MFMA32(*(const LAS bf16x8*)(CL + MLC_FRAG((dq * 8 + s) * 2 + db) + lane * 16), Qf[s], accn[db]);
#pragma unroll
        for (int db = 0; db < 2; ++db)
#pragma unroll
            for (int i = 0; i < 16; ++i) accn[db][i] *= winter;
#pragma unroll
        for (int kb = 0; kb < 2; ++kb) if (kb <= qb2) {
#pragma unroll
            for (int s2 = 0; s2 < 2; ++s2) {
                v4u pw;
#pragma unroll
                for (int e = 0; e < 4; ++e) pw[e] = pk2(accs[kb][8 * s2 + 2 * e], accs[kb][8 * s2 + 2 * e + 1]);
                const bf16x8 pf = __builtin_bit_cast(bf16x8, pw);
#pragma unroll
                for (int db = 0; db < 2; ++db) { const LAS bf16* vp = Vt + (64 * dq + 32 * db + r) * 72 + 32 * kb + 16 * s2 + 4 * hh;
                    const v2u lo = *(const LAS v2u*)vp, hi = *(const LAS v2u*)(vp + 8); v4u vw; vw.x = lo.x; vw.y = lo.y; vw.z = hi.x; vw.w = hi.y;
                    accn[db] = MFMA32(__builtin_bit_cast(bf16x8, vw), pf, accn[db]); } } }
        float dn = 0.f;
#pragma unroll
        for (int s0 = 0; s0 < 8; s0 += 4) { f32x4 nva[4], nvb[4];
#pragma unroll
            for (int s = 0; s < 4; ++s) { nva[s] = *(const LAS f32x4*)(nvs + 16 * (s0 + s) + 8 * hh); nvb[s] = *(const LAS f32x4*)(nvs + 16 * (s0 + s) + 8 * hh + 4); }
#pragma unroll
            for (int s = 0; s < 4; ++s) { const v4u qw = __builtin_bit_cast(v4u, Qf[s0 + s]);
                dn += (bflo(qw[0]) * nva[s].x + bfhi(qw[0]) * nva[s].y) + (bflo(qw[1]) * nva[s].z + bfhi(qw[1]) * nva[s].w) + (bflo(qw[2]) * nvb[s].x + bfhi(qw[2]) * nvb[s].y) + (bflo(qw[3]) * nvb[s].z + bfhi(qw[3]) * nvb[s].w); } }
        dn += __shfl_xor(dn, 32);
        den += winter * dn;
        const float inv = 1.0f / fmaxf(fabsf(den), __expf(-mout));
        WG_BAR();
        if (has) MLC_LOAD_C(nit);
#pragma unroll
        for (int db = 0; db < 2; ++db)
#pragma unroll
            for (int g4 = 0; g4 < 4; ++g4) { f32x4 o; o.x = accn[db][4 * g4] * inv; o.y = accn[db][4 * g4 + 1] * inv; o.z = accn[db][4 * g4 + 2] * inv; o.w = accn[db][4 * g4 + 3] * inv;
                *(LAS f32x4*)(hbuf + t * 260 + 64 * dq + 32 * db + 8 * g4 + 4 * hh) = o; }
        WG_BAR();
        const f32x4 gn = *(const f32x4*)(hgain + h * ML_DV + 4 * lane);
#pragma unroll
        for (int i = 0; i < 8; ++i) { const int tt = 8 * w + i; const f32x4 v = *(const LAS f32x4*)(hbuf + tt * 260 + 4 * lane);
            const float ss = wave_sum((v.x * v.x + v.y * v.y) + (v.z * v.z + v.w * v.w)); const float rstd = 1.0f / sqrtf(ss * (1.0f / ML_DV) + NORM_EPS);
            const v2u ow = ogw[i];
            f32x4 y = v * rstd * gn; y.x *= pg8::fast_sigmoid(bflo(ow.x)); y.y *= pg8::fast_sigmoid(bfhi(ow.x)); y.z *= pg8::fast_sigmoid(bflo(ow.y)); y.w *= pg8::fast_sigmoid(bfhi(ow.y));
            v2u o; o.x = pk2(y.x, y.y); o.y = pk2(y.z, y.w);
            *(v2u*)(HS + (size_t)(tok0 + tt) * DM + h * 256 + 4 * lane) = o; }
        if (has) MLC_LOAD_O(nit);
        WG_BAR();
    }
#undef MLC_LOAD_X
#undef MLC_LOAD_C
#undef MLC_FRAG
#undef MLC_LOAD_O
}
template <class AT_>
__device__ __forceinline__ void attn_phase(const AT_& a, Frame& F, int j) {
    unsigned char* ws = a.ws; const int tid = F.tid, lane = F.lane, w = F.wave, r = lane & 31, hh = lane >> 5;
    const bf16* QKV = (const bf16*)(ws + WS_BIG); const float* ROPE = (const float*)(ws + WS_ROPE); bf16* O = (bf16*)(ws + WS_XN);
    const float* qg = a.in[I_ATQG] + j * 64; const float* kg = a.in[I_ATKG] + j * 64; const float* sinks = a.in[I_ATSINK] + j * 32;
    LAS bf16* Ks = (LAS bf16*)F.lds; LAS bf16* Vt = (LAS bf16*)(F.lds + 36864);
    for (int u = F.bid; u < AT_UNITS; u += F.G) {
        const int b = u >> 7, qb = (u >> 2) & 31, hk = u & 3, tok0 = b * SEQ + qb * AT_BLK, kt0 = tok0 - AT_BLK;
        if (tid < 256) {
            const int J = tid; const bool valid = (qb > 0) || (J >= AT_BLK);
            float v[64];
            if (valid) {
                const v4u* rp = (const v4u*)(QKV + (size_t)(kt0 + J) * AT_COLS + 2048 + hk * 64); float ss = 0.f;
#pragma unroll
                for (int q = 0; q < 8; ++q) { const v4u x = rp[q];
#pragma unroll
                    for (int e = 0; e < 4; ++e) { v[8 * q + 2 * e] = bflo(x[e]); v[8 * q + 2 * e + 1] = bfhi(x[e]); } }
#pragma unroll
                for (int d = 0; d < 64; ++d) ss += v[d] * v[d];
                const float rstd = 1.0f / sqrtf(ss * (1.0f / 64.0f) + NORM_EPS);
#pragma unroll
                for (int d = 0; d < 64; ++d) v[d] = v[d] * rstd * kg[d];
                const float* rp2 = ROPE + (size_t)(kt0 + J) * 16;
#pragma unroll
                for (int i = 0; i < 8; ++i) { const float cs = rp2[i], sn = rp2[8 + i], x1 = v[i], x2 = v[8 + i]; v[i] = x1 * cs - x2 * sn; v[8 + i] = x2 * cs + x1 * sn; }
            } else {
#pragma unroll
                for (int d = 0; d < 64; ++d) v[d] = 0.f;
            }
#pragma unroll
            for (int q = 0; q < 8; ++q) { v4u y;
#pragma unroll
                for (int e = 0; e < 4; ++e) y[e] = pk2(v[8 * q + 2 * e], v[8 * q + 2 * e + 1]);
                *(LAS v4u*)(Ks + J * 72 + 8 * q) = y; }
        } else {
            const int J = tid - 256; const bool valid = (qb > 0) || (J >= AT_BLK);
            const v4u* rp = (const v4u*)(QKV + (size_t)(valid ? kt0 + J : tok0) * AT_COLS + 2304 + hk * 64);
            v4u xr[8];
#pragma unroll
            for (int q = 0; q < 8; ++q) xr[q] = rp[q];
#pragma unroll
            for (int q = 0; q < 8; ++q) { const v4u x = valid ? xr[q] : (v4u){0u, 0u, 0u, 0u};
#pragma unroll
                for (int e = 0; e < 4; ++e) { Vt[(8 * q + 2 * e) * 264 + J] = (bf16)(x[e] & 0xffffu); Vt[(8 * q + 2 * e + 1) * 264 + J] = (bf16)(x[e] >> 16); } }
        }
        __syncthreads();
        const int hq = hk * 8 + w; const float sink = sinks[hq];
        for (int qi = 0; qi < 4; ++qi) {
            const int I = 32 * qi + r, tq = tok0 + I;
            float qv[4][8]; float ss = 0.f;
#pragma unroll
            for (int s = 0; s < 4; ++s) { const v4u x = *(const v4u*)(QKV + (size_t)tq * AT_COLS + hq * 64 + 16 * s + 8 * hh);
#pragma unroll
                for (int e = 0; e < 4; ++e) { qv[s][2 * e] = bflo(x[e]); qv[s][2 * e + 1] = bfhi(x[e]); } }
#pragma unroll
            for (int s = 0; s < 4; ++s)
#pragma unroll
                for (int e = 0; e < 8; ++e) ss += qv[s][e] * qv[s][e];
            ss += __shfl_xor(ss, 32);
            const float rstd = 0.125f / sqrtf(ss * (1.0f / 64.0f) + NORM_EPS);
#pragma unroll
            for (int s = 0; s < 4; ++s)
#pragma unroll
                for (int e = 0; e < 8; ++e) qv[s][e] = qv[s][e] * rstd * qg[16 * s + 8 * hh + e];
            {   const float* rp2 = ROPE + (size_t)tq * 16;
#pragma unroll
                for (int e = 0; e < 8; ++e) { const float mine = qv[0][e], other = __shfl_xor(mine, 32), cs = rp2[e], sn = rp2[8 + e];
                    qv[0][e] = (hh == 0) ? (mine * cs - other * sn) : (mine * cs + other * sn); } }
            bf16x8 Qf[4];
#pragma unroll
            for (int s = 0; s < 4; ++s) { v4u y;
#pragma unroll
                for (int e = 0; e < 4; ++e) y[e] = pk2(qv[s][2 * e], qv[s][2 * e + 1]);
                Qf[s] = __builtin_bit_cast(bf16x8, y); }
            f32x16 accs[5];
#pragma unroll
            for (int c = 0; c < 5; ++c) {
#pragma unroll
                for (int i = 0; i < 16; ++i) accs[c][i] = 0.f;
                const int kj = qi + c;
#pragma unroll
                for (int s = 0; s < 4; ++s) { const bf16x8 kf = *(const LAS bf16x8*)(Ks + (32 * kj + r) * 72 + 16 * s + 8 * hh); accs[c] = MFMA32(kf, Qf[s], accs[c]); } }
            float mx = sink;
#pragma unroll
            for (int c = 0; c < 5; ++c)
#pragma unroll
                for (int i = 0; i < 16; ++i) { const int J = 32 * (qi + c) + crow(i, hh); const bool ok = (J > I) && (J <= I + AT_BLK) && (qb > 0 || J >= AT_BLK); if (ok) mx = fmaxf(mx, accs[c][i]); }
            mx = fmaxf(mx, __shfl_xor(mx, 32));
            float sum = 0.f;
#pragma unroll
            for (int c = 0; c < 5; ++c)
#pragma unroll
                for (int i = 0; i < 16; ++i) { const int J = 32 * (qi + c) + crow(i, hh); const bool ok = (J > I) && (J <= I + AT_BLK) && (qb > 0 || J >= AT_BLK);
                    const float p = ok ? __expf(accs[c][i] - mx) : 0.f; accs[c][i] = p; sum += p; }
            sum += __shfl_xor(sum, 32);
            const float inv = 1.0f / (sum + __expf(sink - mx));
            f32x16 acco[2];
#pragma unroll
            for (int db = 0; db < 2; ++db)
#pragma unroll
                for (int i = 0; i < 16; ++i) acco[db][i] = 0.f;
#pragma unroll
            for (int c = 0; c < 5; ++c)
#pragma unroll
                for (int s2 = 0; s2 < 2; ++s2) { v4u pw;
#pragma unroll
                    for (int e = 0; e < 4; ++e) pw[e] = pk2(accs[c][8 * s2 + 2 * e], accs[c][8 * s2 + 2 * e + 1]);
                    const bf16x8 pf = __builtin_bit_cast(bf16x8, pw);
#pragma unroll
                    for (int db = 0; db < 2; ++db) { const LAS bf16* vp = Vt + (32 * db + r) * 264 + 32 * (qi + c) + 16 * s2 + 4 * hh;
                        const v2u lo = *(const LAS v2u*)vp, hi = *(const LAS v2u*)(vp + 8); v4u vw; vw.x = lo.x; vw.y = lo.y; vw.z = hi.x; vw.w = hi.y;
                        acco[db] = MFMA32(__builtin_bit_cast(bf16x8, vw), pf, acco[db]); } }
            bf16* orow = O + (size_t)tq * DM + hq * 64;
#pragma unroll
            for (int db = 0; db < 2; ++db)
#pragma unroll
                for (int g4 = 0; g4 < 4; ++g4) { v2u o; o.x = pk2(acco[db][4 * g4] * inv, acco[db][4 * g4 + 1] * inv); o.y = pk2(acco[db][4 * g4 + 2] * inv, acco[db][4 * g4 + 3] * inv);
                    *(v2u*)(orow + 32 * db + 8 * g4 + 4 * hh) = o; }
        }
        __syncthreads();
    }
}

template <int CTRL> __device__ __forceinline__ float dpp_f(float x) { return __builtin_bit_cast(float, __builtin_amdgcn_mov_dpp(__builtin_bit_cast(int, x), CTRL, 0xf, 0xf, true)); }
__device__ __forceinline__ float row8_allsum(float x) { x += dpp_f<0xB1>(x); x += dpp_f<0x4E>(x); x += dpp_f<0x141>(x); return x; }
struct RwOps { f32x4 a0, a1, r0, r1, w0, w1, b0, b1, k0, k1; f32x2 v, sc; };
template <class AT_>
__device__ __forceinline__ void rwkv_scan_phase(const AT_& a, Frame& F, int j) {
    unsigned char* ws = a.ws; const int lane = F.lane, w = F.wave;
    const bf16* RKV = (const bf16*)(ws + WS_BIG + 768 * MiB); const float* DEC = (const float*)(ws + WS_BIG);
    const bf16* AG = (const bf16*)(ws + WS_BIG + 256 * MiB); const bf16* GG = (const bf16*)(ws + WS_BIG + 384 * MiB); bf16* YG = (bf16*)(ws + WS_XN);
    const float* k_k = a.in[I_RWKK] + (size_t)j * DM; const float* k_a = a.in[I_RWKA] + (size_t)j * DM; const float* r_k = a.in[I_RWRK] + (size_t)j * DM;
    const float* ln_w = a.in[I_RWLNW] + (size_t)j * DM; const float* ln_b = a.in[I_RWLNB] + (size_t)j * DM;
    constexpr int OPB = 6 * RW_T * 64 * 4 + RW_T * 16;
    LAS float* Ybase = (LAS float*)(F.lds + 2 * OPB);
    const int vg = lane >> 3, kg = lane & 7, v0 = 16 * (w & 3) + 2 * vg;
    for (int bh = F.bid; bh < NBATCH * RW_H; bh += F.G) {
        const int b = bh >> 5, h = bh & 31, col = h * 64 + lane; const size_t tokb = (size_t)b * SEQ;
        const float kkc = k_k[col], kac = k_a[col], rkc = r_k[col], lnw = ln_w[col], lnb = ln_b[col];
        f32x2 S0[4], S1[4];
#pragma unroll
        for (int i = 0; i < 4; ++i) { S0[i] = (f32x2){0.f, 0.f}; S1[i] = (f32x2){0.f, 0.f}; }
        for (int blk = -1; blk <= RW_NBLK; ++blk) {
            if (w < 4) {
                if (blk >= 0 && blk < RW_NBLK) {
                    const LAS float* ob = (const LAS float*)(F.lds + (blk & 1) * OPB); LAS float* Yb = Ybase + (blk & 1) * (RW_T * 64);
                    auto ld = [&](int t) { RwOps o; const LAS float* p = ob + t * 64 + 8 * kg;
                        o.a0 = *(const LAS f32x4*)p; o.a1 = *(const LAS f32x4*)(p + 4); p += RW_T * 64; o.r0 = *(const LAS f32x4*)p; o.r1 = *(const LAS f32x4*)(p + 4); p += RW_T * 64;
                        o.w0 = *(const LAS f32x4*)p; o.w1 = *(const LAS f32x4*)(p + 4); p += RW_T * 64; o.b0 = *(const LAS f32x4*)p; o.b1 = *(const LAS f32x4*)(p + 4); p += RW_T * 64;
                        o.k0 = *(const LAS f32x4*)p; o.k1 = *(const LAS f32x4*)(p + 4);
                        o.v = *(const LAS f32x2*)(ob + 5 * RW_T * 64 + t * 64 + v0); o.sc = *(const LAS f32x2*)(ob + 6 * RW_T * 64 + t * 4); return o; };
                    auto step = [&](const RwOps& cur, int t) {
                        const f32x2 a01 = {cur.a0.x, cur.a0.y}, a23 = {cur.a0.z, cur.a0.w}, a45 = {cur.a1.x, cur.a1.y}, a67 = {cur.a1.z, cur.a1.w};
                        const f32x2 r01 = {cur.r0.x, cur.r0.y}, r23 = {cur.r0.z, cur.r0.w}, r45 = {cur.r1.x, cur.r1.y}, r67 = {cur.r1.z, cur.r1.w};
                        f32x2 sA0 = S0[0] * a01, sA1 = S1[0] * a01, sY0 = S0[0] * r01, sY1 = S1[0] * r01;
                        sA0 = S0[1] * a23 + sA0; sA1 = S1[1] * a23 + sA1; sY0 = S0[1] * r23 + sY0; sY1 = S1[1] * r23 + sY1;
                        sA0 = S0[2] * a45 + sA0; sA1 = S1[2] * a45 + sA1; sY0 = S0[2] * r45 + sY0; sY1 = S1[2] * r45 + sY1;
                        sA0 = S0[3] * a67 + sA0; sA1 = S1[3] * a67 + sA1; sY0 = S0[3] * r67 + sY0; sY1 = S1[3] * r67 + sY1;
                        const float sa0 = row8_allsum(sA0.x + sA0.y), sa1 = row8_allsum(sA1.x + sA1.y), yy0 = row8_allsum(sY0.x + sY0.y), yy1 = row8_allsum(sY1.x + sY1.y);
                        if (kg == 0) { f32x2 yo; yo.x = yy0 + sa0 * cur.sc.x + cur.v.x * cur.sc.y; yo.y = yy1 + sa1 * cur.sc.x + cur.v.y * cur.sc.y; *(LAS f32x2*)(Yb + t * 64 + v0) = yo; }
                        const f32x2 w01 = {cur.w0.x, cur.w0.y}, w23 = {cur.w0.z, cur.w0.w}, w45 = {cur.w1.x, cur.w1.y}, w67 = {cur.w1.z, cur.w1.w};
                        const f32x2 b01 = {cur.b0.x, cur.b0.y}, b23 = {cur.b0.z, cur.b0.w}, b45 = {cur.b1.x, cur.b1.y}, b67 = {cur.b1.z, cur.b1.w};
                        const f32x2 k01 = {cur.k0.x, cur.k0.y}, k23 = {cur.k0.z, cur.k0.w}, k45 = {cur.k1.x, cur.k1.y}, k67 = {cur.k1.z, cur.k1.w};
                        const f32x2 s0 = {sa0, sa0}, s1 = {sa1, sa1}, x0 = {cur.v.x, cur.v.x}, x1 = {cur.v.y, cur.v.y};
                        S0[0] = S0[0] * w01 + (s0 * b01 + x0 * k01); S0[1] = S0[1] * w23 + (s0 * b23 + x0 * k23); S0[2] = S0[2] * w45 + (s0 * b45 + x0 * k45); S0[3] = S0[3] * w67 + (s0 * b67 + x0 * k67);
                        S1[0] = S1[0] * w01 + (s1 * b01 + x1 * k01); S1[1] = S1[1] * w23 + (s1 * b23 + x1 * k23); S1[2] = S1[2] * w45 + (s1 * b45 + x1 * k45); S1[3] = S1[3] * w67 + (s1 * b67 + x1 * k67);
                    };
                    RwOps oa = ld(0);
                    for (int t = 0; t < RW_T; t += 2) {
                        const RwOps ob2 = ld(t + 1);
                        step(oa, t);
                        oa = ld(t + 2 < RW_T ? t + 2 : t + 1);
                        step(ob2, t + 1);
                    }
                }
            } else {
                const int tw = w - 4; const bool do_post = blk >= 1, do_prep = blk + 1 < RW_NBLK;
                float pr[8], pk[8], pv[8], pd[8], pa[8], pg[8];
#pragma unroll
                for (int i = 0; i < 8; ++i) { pr[i] = 0.f; pk[i] = 0.f; pv[i] = 0.f; pd[i] = 0.f; pa[i] = 0.f; pg[i] = 0.f; }
                if (do_prep) {
#pragma unroll
                    for (int i = 0; i < 8; ++i) { const size_t off = (tokb + (size_t)(blk + 1) * RW_T + tw + 4 * i) * DM + col;
                        pr[i] = bf2f(RKV[off]); pk[i] = bf2f(RKV[(size_t)MTOK * DM + off]); pv[i] = bf2f(RKV[(size_t)2 * MTOK * DM + off]); pd[i] = DEC[off]; pa[i] = bf2f(AG[off]); } }
                if (do_post) {
#pragma unroll
                    for (int i = 0; i < 8; ++i) pg[i] = bf2f(GG[(tokb + (size_t)(blk - 1) * RW_T + tw + 4 * i) * DM + col]); }
                if (do_post) {
                    const int pb = blk - 1; const LAS float* ob = (const LAS float*)(F.lds + (pb & 1) * OPB); const LAS float* Yb = Ybase + (pb & 1) * (RW_T * 64);
#pragma unroll
                    for (int i = 0; i < 8; ++i) { const int t = tw + 4 * i; const size_t tok = tokb + (size_t)pb * RW_T + t;
                        const float y = Yb[t * 64 + lane], vv = ob[5 * RW_T * 64 + t * 64 + lane], bon = ob[6 * RW_T * 64 + t * 4 + 2];
                        const float mu = wave_sum_dpp(y) * (1.0f / 64.0f), dlt = y - mu, var = wave_sum_dpp(dlt * dlt) * (1.0f / 64.0f);
                        const float yn = dlt * __builtin_amdgcn_rsqf(var + RW_LN_EPS) * lnw + lnb + bon * vv;
                        YG[tok * DM + col] = f2bf(yn * pg[i]); }
                }
                if (do_prep) {
                    LAS float* ob = (LAS float*)(F.lds + ((blk + 1) & 1) * OPB);
#pragma unroll
                    for (int i = 0; i < 8; ++i) { const int t = tw + 4 * i; const float rr = pr[i], kk0 = pk[i], vv = pv[i];
                        const float dec = __expf(-0.6065306597f * pg8::fast_sigmoid(pd[i])), ag = pg8::fast_sigmoid(pa[i]);
                        float kkv = kk0 * kkc; kkv = kkv * __builtin_amdgcn_rsqf(fmaxf(wave_sum_dpp(kkv * kkv), 1e-24f));
                        const float kp = kk0 * (1.0f + (ag - 1.0f) * kac); const float bv = kkv * ag;
                        ob[t * 64 + lane] = -kkv; ob[RW_T * 64 + t * 64 + lane] = dec * rr; ob[2 * RW_T * 64 + t * 64 + lane] = dec;
                        ob[3 * RW_T * 64 + t * 64 + lane] = bv; ob[4 * RW_T * 64 + t * 64 + lane] = kp; ob[5 * RW_T * 64 + t * 64 + lane] = vv;
                        const float br = wave_sum_dpp(bv * rr), kr = wave_sum_dpp(kp * rr), bon = wave_sum_dpp(rr * kp * rkc);
                        if (lane == 0) { ob[6 * RW_T * 64 + t * 4] = br; ob[6 * RW_T * 64 + t * 4 + 1] = kr; ob[6 * RW_T * 64 + t * 4 + 2] = bon; } }
                }
            }
            __syncthreads();
        }
    }
}
constexpr int RING_BYTES = 131072, MISC_OFF = RING_BYTES + 320, LDS_BYTES = 147456;
#ifndef MK_PER_PHASE
#define MK_PER_PHASE 0
#endif
constexpr int N_PHASES_MAX = 64;
#ifndef REP_CONV
#define REP_CONV 1
#endif
#ifndef REP_NORM
#define REP_NORM 1
#endif
#ifndef REP_GU
#define REP_GU 1
#endif
#ifndef REP_MIXG
#define REP_MIXG 1
#endif
#ifndef REP_MLA
#define REP_MLA 1
#endif
#ifndef REP_MLC
#define REP_MLC 1
#endif
#ifndef REP_ATTN
#define REP_ATTN 1
#endif
#ifndef REP_SCAN
#define REP_SCAN 1
#endif
template <int N> __device__ __forceinline__ int nrep() { if (N == 1) return 1; int v = N; asm volatile("" : "+s"(v)); return v; }
#define PH_REP(N) for (int rep_ = 0, nrep_ = nrep<N>(); rep_ < nrep_; ++rep_)
typedef const __attribute__((address_space(4))) Args CArgs;
__device__ __forceinline__ CArgs* kargs() { CArgs* p = (CArgs*)__builtin_amdgcn_kernarg_segment_ptr(); asm volatile("" : "+s"(p)); return p; }
struct Ctx { XcdBarrier bar; int lo, hi; };
#define PH_BEGIN if (ph >= C.lo && ph < C.hi) { CArgs& a = *kargs(); unsigned char* ws = a.ws; Frame F; { int t_ = threadIdx.x, g_ = gridDim.x, b_ = blockIdx.x; asm volatile("" : "+v"(t_), "+s"(g_), "+s"(b_)); \
                 unsigned lb_ = 0u; asm volatile("" : "+s"(lb_)); F.lds = (LAS unsigned char*)(size_t)lb_ + (size_t)(LAS unsigned char*)lds_raw; F.tid = t_; F.lane = t_ & 63; F.wave = __builtin_amdgcn_readfirstlane(t_ >> 6); F.G = g_; F.bid = b_; } \
                 bf16* XN = (bf16*)(ws + WS_XN); bf16* BIG = (bf16*)(ws + WS_BIG); bf16* WMA = (bf16*)(ws + WS_WMIX); bf16* WMO = (bf16*)(ws + WS_WMIX + 26 * MiB); (void)XN; (void)BIG; (void)WMA; (void)WMO;
#define PH_END   if (ph + 1 < C.hi) { XcdBarrier b2_ = C.bar; asm volatile("" : "+s"(b2_.bar)); xcd_barrier(b2_); } } ++ph;
#define XS0 ((bf16*)a.out)
#define XS1 ((bf16*)(ws + WS_BIG + 512 * MiB))

#ifndef GU_WGM
#define GU_WGM 8
#endif
#ifndef DN_WGM
#define DN_WGM 4
#endif
#ifndef I8_MIX_MASK
#define I8_MIX_MASK 0x2
#endif
#ifndef I8_GU_MASK
#define I8_GU_MASK 0xFF
#endif
#ifndef FP8_GU_MASK
#define FP8_GU_MASK 0x00
#endif
#ifndef FP8_DN_MASK
#define FP8_DN_MASK 0xC0
#endif
constexpr int RT_TAGS_OFF = RING_BYTES + 512, RT_TAB_OFF = RING_BYTES + 1024;
template <class Sched>
__device__ __forceinline__ pg8::RowTab build_row_tab(Frame& F, const Sched& S, const float* rowq, float wstep) {
    LAS int* tags = (LAS int*)(F.lds + RT_TAGS_OFF); LAS float* tab = (LAS float*)(F.lds + RT_TAB_OFF);
    if (F.tid == 0) { int n = 0;
        for (int k = 0; k < 8; ++k) tags[k] = -1;
        pg8::Unit u;
        for (int i = 0; S.next(i, u); ++i) { bool seen = false; for (int k = 0; k < n; ++k) seen = seen || (tags[k] == u.pm); if (!seen && n < 8) tags[n++] = u.pm; } }
    __syncthreads();
    for (int k = F.tid >> 8; k < 8; k += 2) { const int pm = tags[k]; if (pm >= 0) tab[k * 256 + (F.tid & 255)] = rowq[(size_t)pm * 256 + (F.tid & 255)] * wstep; }
    __syncthreads();
    return pg8::RowTab{tab, tags};
}
template <int L, int FI>
__device__ __forceinline__ void run_ffn(unsigned char* lds_raw, const Ctx& C, int& ph) {
    constexpr bool FIRST = (L == 0 && FI == 0), LAST = (L == DEPTH - 1 && FI == 1);
    constexpr bool F8 = ((FP8_DN_MASK >> (2 * L + FI)) & 1) != 0, I8G = ((I8_GU_MASK >> (2 * L + FI)) & 1) != 0, F8G = !I8G && ((FP8_GU_MASK >> (2 * L + FI)) & 1) != 0;
    constexpr int GDT = I8G ? 2 : (F8G ? 1 : 0);
    PH_BEGIN PH_REP(REP_NORM) { if (FIRST) norm_phase<0, false, GDT>(a, F, a.in[I_X], a.in[FI ? I_F2N : I_F1N] + (size_t)L * DM, 0);
                                else norm_phase<0, true, GDT>(a, F, LAST ? XS1 : XS0, a.in[FI ? I_F2N : I_F1N] + (size_t)L * DM, 0); } PH_END
    PH_BEGIN { bf16* WGU = (bf16*)(ws + (FI ? WS_WGU2 : WS_WGU1)); constexpr int KG = GDT ? DM / 2 : DM;
               pg8::Gemm g{XN, WGU, KG, KG, KG}; pg8::StaticOrder S; S.init(MTOK, 2 * FF, F.G, F.bid, GU_WGM);
               pg8::RowTab rt{nullptr, nullptr};
               if (I8G) rt = build_row_tab(F, S, (const float*)(ws + WS_ROWQ), 1.0f);
               pg8::EpiSwiGLU<F8, I8G> E{BIG, FF, F8G ? 1.0f / (pg8::X8_SCALE * pg8::W8_SCALE) : 1.0f, rt, (const float*)(ws + WS_CSTEP) + (2 * L + FI) * 2 * FF};
               PH_REP(REP_GU) { pg8::gemm_phase<pg8::EpiSwiGLU<F8, I8G>, pg8::StaticOrder, true, true, GDT>(F.lds, g, S, E, F.tid); } } PH_END
    PH_BEGIN { bf16* WDN = (bf16*)(ws + (FI ? WS_WDN2 : WS_WDN1));
               constexpr int KE = F8 ? FF / 2 : FF;
               constexpr float SC = F8 ? 0.5f / (pg8::H8_SCALE * pg8::W8_SCALE) : 0.5f;
               pg8::Gemm g{BIG, WDN, KE, KE, KE}; pg8::StaticOrder S; S.init(MTOK, DM, F.G, F.bid, DN_WGM);
               if (FIRST) { pg8::EpiResid<false, true> E{a.in[I_X], XS0, DM, SC}; pg8::gemm_phase<pg8::EpiResid<false, true>, pg8::StaticOrder, true, true, F8 ? 1 : 0>(F.lds, g, S, E, F.tid); }
               else if (LAST) { pg8::EpiResid<true, false> E{XS1, a.out, DM, SC}; pg8::gemm_phase<pg8::EpiResid<true, false>, pg8::StaticOrder, true, true, F8 ? 1 : 0>(F.lds, g, S, E, F.tid); }
               else { pg8::EpiResid<true, true> E{XS0, XS0, DM, SC}; pg8::gemm_phase<pg8::EpiResid<true, true>, pg8::StaticOrder, true, true, F8 ? 1 : 0>(F.lds, g, S, E, F.tid); } } PH_END
}
template <int L>
__device__ __forceinline__ void run_layer(unsigned char* lds_raw, const Ctx& C, int& ph) {
    constexpr int kind = L % 3, j = L / 3;
    constexpr bool I8A = ((I8_GU_MASK >> (2 * L)) & 1) != 0, I8B = ((I8_GU_MASK >> (2 * L + 1)) & 1) != 0, I8M = kind != 2 && ((I8_MIX_MASK >> L) & 1) != 0;
    if constexpr (I8A || I8B || I8M) {
        PH_BEGIN { if (I8A) colmax_wide(F, a.in[I_F1GU] + (size_t)L * DM * 2 * FF, DM, 2 * FF, (unsigned*)(ws + WS_CTL) + CW_CMAX + (2 * L) * 2 * FF);
                   if (I8B) colmax_wide(F, a.in[I_F2GU] + (size_t)L * DM * 2 * FF, DM, 2 * FF, (unsigned*)(ws + WS_CTL) + CW_CMAX + (2 * L + 1) * 2 * FF);
                   if (I8M && kind == 0) { colmax_wide(F, a.in[I_MLWIN] + (size_t)j * DM * ML_INCOLS, DM, 6144, (unsigned*)(ws + WS_CTL) + CW_CMAX2 + 6400 * L, ML_INCOLS);
                                          colmax_pass(F, a.in[I_MLWIN] + (size_t)j * DM * ML_INCOLS + 6144, DM, 16, ML_INCOLS, (unsigned*)(ws + WS_CTL) + CW_CMAX2 + 6400 * L + 6144); }
                   if (I8M && kind == 1) colmax_wide(F, a.in[I_ATQKV] + (size_t)j * DM * AT_COLS, DM, AT_COLS, (unsigned*)(ws + WS_CTL) + CW_CMAX2 + 6400 * L); } PH_END
    }
    PH_BEGIN PH_REP(REP_CONV) { conv_phase(a, F, L, ((FP8_DN_MASK >> (2 * L)) & 1) != 0, ((FP8_DN_MASK >> (2 * L + 1)) & 1) != 0, ((FP8_GU_MASK >> (2 * L)) & 1) != 0, ((FP8_GU_MASK >> (2 * L + 1)) & 1) != 0, I8A, I8B, I8M); } PH_END
    run_ffn<L, 0>(lds_raw, C, ph);
    if constexpr (kind == 0) {
        PH_BEGIN PH_REP(REP_NORM) { norm_phase<0, true, I8M ? 2 : 0>(a, F, XS0, a.in[I_MN] + (size_t)L * DM, j); } PH_END
        PH_BEGIN { constexpr int KM = I8M ? DM / 2 : DM; pg8::Gemm g{XN, WMA, KM, KM, KM}; pg8::StaticOrder S; S.init(MTOK, ML_NPAD, F.G, F.bid);
                   pg8::RowTab rt{nullptr, nullptr}; if (I8M) rt = build_row_tab(F, S, (const float*)(ws + WS_ROWQ), 1.0f);
                   pg8::EpiStore<I8M> E{BIG, 6144, 24, (float*)(ws + WS_GATES), rt, (const float*)(ws + WS_CSTEP2) + 6400 * L};
                   PH_REP(REP_MIXG) { pg8::gemm_phase<pg8::EpiStore<I8M>, pg8::StaticOrder, true, true, I8M ? 2 : 0>(F.lds, g, S, E, F.tid); } } PH_END
        PH_BEGIN PH_REP(REP_MLA) { mlstm_phase_ab(a, F, j); } PH_END
        PH_BEGIN PH_REP(REP_MLC) { mlstm_phase_c(a, F, j); } PH_END
    } else if constexpr (kind == 1) {
        PH_BEGIN PH_REP(REP_NORM) { norm_phase<1, true, I8M ? 2 : 0>(a, F, XS0, a.in[I_MN] + (size_t)L * DM, j); } PH_END
        PH_BEGIN { constexpr int KM = I8M ? DM / 2 : DM; pg8::Gemm g{XN, WMA, KM, KM, KM}; pg8::StaticOrder S; S.init(MTOK, AT_COLS, F.G, F.bid);
                   pg8::RowTab rt{nullptr, nullptr}; if (I8M) rt = build_row_tab(F, S, (const float*)(ws + WS_ROWQ), 1.0f);
                   pg8::EpiStore<I8M> E{BIG, AT_COLS, 1 << 30, nullptr, rt, (const float*)(ws + WS_CSTEP2) + 6400 * L};
                   PH_REP(REP_MIXG) { pg8::gemm_phase<pg8::EpiStore<I8M>, pg8::StaticOrder, true, true, I8M ? 2 : 0>(F.lds, g, S, E, F.tid); } } PH_END
        PH_BEGIN PH_REP(REP_ATTN) { attn_phase(a, F, j); } PH_END
    } else {
        PH_BEGIN PH_REP(REP_NORM) { norm_phase<2, true>(a, F, XS0, a.in[I_MN] + (size_t)L * DM, j); } PH_END
        PH_BEGIN { pg8::Gemm g{BIG, WMA, DM, DM, DM}; pg8::RwkvOrder1 S; S.b.init(MTOK, 27 * 256, F.G, F.bid);
                   pg8::EpiRwkv1 E{BIG + (size_t)384 * MiB, XN, MTOK};
                   PH_REP(REP_MIXG) { pg8::gemm_phase<pg8::EpiRwkv1, pg8::RwkvOrder1, true, true>(F.lds, g, S, E, F.tid); } } PH_END
        PH_BEGIN { pg8::Gemm g{XN, (bf16*)(ws + WS_WMIX + 28 * MiB), 256, 256, 256}; pg8::RwkvOrder2 S; S.b.init(MTOK, 24 * 256, F.G, F.bid);
                   pg8::EpiRwkv2 E{(float*)(ws + WS_BIG), (bf16*)(ws + WS_BIG + 256 * MiB), (bf16*)(ws + WS_BIG + 384 * MiB), a.in[I_RWW0] + (size_t)j * DM, a.in[I_RWA0] + (size_t)j * DM};
                   PH_REP(REP_MIXG) { pg8::gemm_phase<pg8::EpiRwkv2, pg8::RwkvOrder2, true, true>(F.lds, g, S, E, F.tid); } } PH_END
        PH_BEGIN PH_REP(REP_SCAN) { rwkv_scan_phase(a, F, j); } PH_END
    }
    PH_BEGIN { pg8::Gemm g{XN, kind == 2 ? (bf16*)(ws + WS_WMIX + 32 * MiB) : WMO, DM, DM, DM}; pg8::StaticOrder S; S.init(MTOK, DM, F.G, F.bid, DN_WGM);
               pg8::EpiResid<true, true> E{XS0, L == DEPTH - 1 ? XS1 : XS0, DM, 1.0f};
               pg8::gemm_phase<pg8::EpiResid<true, true>, pg8::StaticOrder, true, true>(F.lds, g, S, E, F.tid); } PH_END
    run_ffn<L, 1>(lds_raw, C, ph);
}
#undef PH_BEGIN
#undef PH_END

__global__ void __launch_bounds__(NTHREADS, 2) hybrid_fwd(Args a_unused) {
    extern __shared__ __attribute__((aligned(16))) unsigned char lds_raw[];
    volatile LAS unsigned* MISC = (volatile LAS unsigned*)((LAS unsigned char*)lds_raw + MISC_OFF);
    if (threadIdx.x < 32) MISC[threadIdx.x] = 0u;
    __syncthreads();
    Ctx C; C.bar = xcd_barrier_post((unsigned*)(kargs()->ws + WS_CTL) + CW_BAR, MISC + 8);
    C.lo = kargs()->ph_lo; C.hi = kargs()->ph_hi; int ph = 0;
    run_layer<0>(lds_raw, C, ph);
    run_layer<1>(lds_raw, C, ph);
    run_layer<2>(lds_raw, C, ph);
    run_layer<3>(lds_raw, C, ph);
}

extern "C" void kernel_launch(void* const* d_in, const int* in_sizes, int n_in, void* d_out, int out_size, void* d_ws, size_t ws_size, hipStream_t stream) {
    static int grid = 0;
    if (grid == 0) {
        if (n_in != N_IN || in_sizes[0] != MTOK * DM || out_size != MTOK * DM || ws_size < WS_END) {
            fprintf(stderr, "kernel_launch: unexpected shapes (n_in %d, in0 %d, out %d, ws %zu < %zu); nothing launched\n", n_in, n_in > 0 ? in_sizes[0] : -1, out_size, ws_size, (size_t)WS_END); grid = -1; return; }
        int dev = 0, cus = 0, per_cu = 0;
        if (hipGetDevice(&dev) != hipSuccess || hipDeviceGetAttribute(&cus, hipDeviceAttributeMultiprocessorCount, dev) != hipSuccess) { grid = -1; return; }
        if (hipFuncSetAttribute((const void*)hybrid_fwd, hipFuncAttributeMaxDynamicSharedMemorySize, LDS_BYTES) != hipSuccess) { fprintf(stderr, "kernel_launch: hipFuncSetAttribute failed\n"); grid = -1; return; }
        if (hipOccupancyMaxActiveBlocksPerMultiprocessor(&per_cu, (const void*)hybrid_fwd, NTHREADS, LDS_BYTES) != hipSuccess || per_cu < 1) { fprintf(stderr, "kernel_launch: occupancy query says %d blocks per CU\n", per_cu); }
        (void)hipGetLastError();
        grid = cus;
    }
    if (grid < 0) return;
    if (hipMemsetAsync((char*)d_ws + WS_CTL, 0, CTL_ZERO_BYTES, stream) != hipSuccess) return;
    Args a{};
    for (int i = 0; i < N_IN; ++i) a.in[i] = (const float*)d_in[i];
    a.out = (float*)d_out; a.ws = (unsigned char*)d_ws;
#if MK_PER_PHASE
    for (int p = 0; p < N_PHASES_MAX; ++p) { a.ph_lo = p; a.ph_hi = p + 1; hipLaunchKernelGGL(hybrid_fwd, dim3(grid), dim3(NTHREADS), LDS_BYTES, stream, a); }
#else
    a.ph_lo = 0; a.ph_hi = 1 << 30;
    hipLaunchKernelGGL(hybrid_fwd, dim3(grid), dim3(NTHREADS), LDS_BYTES, stream, a);
#endif
    const hipError_t le = hipPeekAtLastError();
    if (le != hipSuccess) fprintf(stderr, "kernel_launch: launch failed: %s\n", hipGetErrorName(le));
}
```

```cpp
#include <hip/hip_runtime.h>
#include <cstdio>
#include <cstdint>
#define I8_MIX_MASK 0xA
namespace pg8 {
#define PG8_LAS __attribute__((address_space(3)))
typedef unsigned short bf16_t;
typedef short bf16x8 __attribute__((ext_vector_type(8)));
typedef float f32x4 __attribute__((ext_vector_type(4)));
typedef unsigned u32x4 __attribute__((ext_vector_type(4)));
constexpr int BM = 256, BK = 64, HALF = 128, HTB = HALF * BK * 2  , STAGE_BYTES = 8 * HTB, NXCD = 8, WGM = 8;

__host__ __device__ __forceinline__ int lds_byte(int r, int c) { const int st = (r >> 4) * 2 + (c >> 5), rr = r & 15, cc = c & 31, ob = rr * 64 + cc * 2; return st * 1024 + (ob ^ (((ob >> 9) & 1) << 5)); }
__host__ __device__ __forceinline__ void stage_rc(int b, int& R, int& C) { const int st = b / 1024, sb = b % 1024, swz = sb ^ (((sb >> 9) & 1) << 5); R = (st >> 1) * 16 + swz / 64; C = (st & 1) * 32 + (swz % 64) / 2; }
__host__ __device__ __forceinline__ int perm32(int rho) { const int n = rho >> 4, i = rho & 15; return 8 * (i >> 2) + 4 * n + (i & 3); }

typedef int i32x8 __attribute__((ext_vector_type(8)));
__device__ __forceinline__ i32x8 ld32(const PG8_LAS unsigned char* p) { typedef int i32x4_ __attribute__((ext_vector_type(4))); const i32x4_ lo = *(const PG8_LAS i32x4_*)p, hi = *(const PG8_LAS i32x4_*)(p + 16); return __builtin_shufflevector(lo, hi, 0, 1, 2, 3, 4, 5, 6, 7); }
struct Unit { int pm, pn; };
struct Gemm { const bf16_t* A; const bf16_t* Bt; int lda, ldb, K; };

struct StaticOrder {
    int nM, nN, nwg, G, c, wgm;
    __host__ __device__ void init(int M, int N, int G_, int c_, int wgm_ = WGM) { nM = M / BM; nN = N / BM; nwg = nM * nN; G = G_; c = c_; wgm = wgm_; }
    __host__ __device__ bool next(int i, Unit& u) const {
        const long L = (long)i * G + c; if (L >= nwg) return false;
        int wgid = (int)L; { const int q = nwg / NXCD, r = nwg % NXCD, xcd = wgid % NXCD, off = wgid / NXCD; wgid = (xcd < r ? xcd * (q + 1) : r * (q + 1) + (xcd - r) * q) + off; }
        const int nig = wgm * nN, gid = wgid / nig, fm = gid * wgm, gsz = (nM - fm) < wgm ? (nM - fm) : wgm;
        u.pm = fm + ((wgid % nig) % gsz); u.pn = (wgid % nig) / gsz; return true;
    }
    __device__ __forceinline__ void a_ready(const Unit&) const {}
    __device__ __forceinline__ void done(const Unit&) const {}
};

typedef __bf16 bf16v2_t __attribute__((ext_vector_type(2)));
__device__ __forceinline__ unsigned cvt_pk_bf16(float lo, float hi) { bf16v2_t v; v.x = (__bf16)lo; v.y = (__bf16)hi; return __builtin_bit_cast(unsigned, v); }
__device__ __forceinline__ float fast_sigmoid(float x) { return __builtin_amdgcn_rcpf(1.0f + __expf(-x)); }
constexpr int MROWS_TILES = 128;

constexpr float H8_SCALE = 4.0f, W8_SCALE = 64.0f, X8_SCALE = 16.0f;
struct RowTab { const PG8_LAS float* tab; const PG8_LAS int* tags;
    __device__ __forceinline__ int slot(int pm) const { int s = 0;
#pragma unroll
        for (int k = 0; k < 8; ++k) if (tags[k] == pm) s = k;
        return __builtin_amdgcn_readfirstlane(s); } };
template <bool F8, bool IN8 = false>
struct EpiSwiGLU {
    static constexpr bool PERM = true, AFTER_DRAIN = false;
    void* O; int ldc; float isc; RowTab rt; const float* cstep;
    __device__ __forceinline__ void operator()(const f32x4 (&acc)[2][2][4][2], const Unit& u, int wr, int wc, int fr, int fq) const {
        const int row0 = u.pm * BM + wr * 64 + fr, col0 = u.pn * HALF + wc * 32 + 8 * fq; const int sl = IN8 ? rt.slot(u.pm) : 0;
        f32x4 cg[2], cu[2];
#pragma unroll
        for (int n = 0; n < 2; ++n) { cg[n] = IN8 ? *(const f32x4*)(cstep + u.pn * BM + wc * 32 + 8 * fq + 4 * n) : (f32x4){1.f, 1.f, 1.f, 1.f}; cu[n] = IN8 ? *(const f32x4*)(cstep + u.pn * BM + HALF + wc * 32 + 8 * fq + 4 * n) : (f32x4){1.f, 1.f, 1.f, 1.f}; }
#pragma unroll
        for (int ai = 0; ai < 2; ++ai)
#pragma unroll
            for (int m = 0; m < 4; ++m) { const size_t off = (size_t)(row0 + ai * HALF + m * 16) * ldc + col0;
                const float rs = IN8 ? rt.tab[sl * 256 + wr * 64 + ai * HALF + m * 16 + fr] : isc;
                float o[8];
#pragma unroll
                for (int n = 0; n < 2; ++n)
#pragma unroll
                    for (int e = 0; e < 4; ++e) { const float ga = acc[ai][0][m][n][e], ua = acc[ai][1][m][n][e];
                        const float g = (IN8 ? (float)__float_as_int(ga) * cg[n][e] : ga) * rs, up = (IN8 ? (float)__float_as_int(ua) * cu[n][e] : ua) * rs; o[4 * n + e] = g * fast_sigmoid(g) * up; }
                if (F8) { unsigned w0 = 0u, w1 = 0u;
#pragma unroll
                    for (int e = 0; e < 8; ++e) o[e] = __builtin_amdgcn_fmed3f(o[e] * H8_SCALE, -448.0f, 448.0f);
                    w0 = __builtin_amdgcn_cvt_pk_fp8_f32(o[0], o[1], w0, false); w0 = __builtin_amdgcn_cvt_pk_fp8_f32(o[2], o[3], w0, true);
                    w1 = __builtin_amdgcn_cvt_pk_fp8_f32(o[4], o[5], w1, false); w1 = __builtin_amdgcn_cvt_pk_fp8_f32(o[6], o[7], w1, true);
                    typedef unsigned u32x2_ __attribute__((ext_vector_type(2))); *(u32x2_*)((unsigned char*)O + off) = (u32x2_){w0, w1}; }
                else { u32x4 w; w.x = cvt_pk_bf16(o[0], o[1]); w.y = cvt_pk_bf16(o[2], o[3]); w.z = cvt_pk_bf16(o[4], o[5]); w.w = cvt_pk_bf16(o[6], o[7]);
                    __builtin_nontemporal_store(w, (u32x4*)((bf16_t*)O + off)); } }
    }
};
typedef _Float16 h16x8_t __attribute__((ext_vector_type(8)));
template <bool BB, bool OB>
struct EpiResid {
    static constexpr bool PERM = true, AFTER_DRAIN = false;
    const void* base; void* out; int ldc; float s;
    __device__ __forceinline__ void operator()(const f32x4 (&acc)[2][2][4][2], const Unit& u, int wr, int wc, int fr, int fq) const {
        const int row0 = u.pm * BM + wr * 64 + fr, col0 = u.pn * BM + wc * 32 + 8 * fq;
#pragma unroll
        for (int ai = 0; ai < 2; ++ai) {
            if constexpr (BB) {
                h16x8_t wv[4][2];
#pragma unroll
                for (int m = 0; m < 4; ++m)
#pragma unroll
                    for (int bj = 0; bj < 2; ++bj) wv[m][bj] = *(const h16x8_t*)((const bf16_t*)base + (size_t)(row0 + ai * HALF + m * 16) * ldc + col0 + bj * HALF);
#pragma unroll
                for (int m = 0; m < 4; ++m) { const size_t off = (size_t)(row0 + ai * HALF + m * 16) * ldc + col0;
#pragma unroll
                    for (int bj = 0; bj < 2; ++bj) { const h16x8_t w = wv[m][bj];
                        const f32x4 b0 = (f32x4){(float)w[0], (float)w[1], (float)w[2], (float)w[3]}, b1 = (f32x4){(float)w[4], (float)w[5], (float)w[6], (float)w[7]};
                        const f32x4 o0 = b0 + acc[ai][bj][m][0] * s, o1 = b1 + acc[ai][bj][m][1] * s;
                        if (OB) { h16x8_t wo; wo[0] = (_Float16)o0[0]; wo[1] = (_Float16)o0[1]; wo[2] = (_Float16)o0[2]; wo[3] = (_Float16)o0[3]; wo[4] = (_Float16)o1[0]; wo[5] = (_Float16)o1[1]; wo[6] = (_Float16)o1[2]; wo[7] = (_Float16)o1[3];
                            *(h16x8_t*)((bf16_t*)out + off + bj * HALF) = wo; }
                        else { *(f32x4*)((float*)out + off + bj * HALF) = o0; *(f32x4*)((float*)out + off + bj * HALF + 4) = o1; } } }
            } else {
#pragma unroll
                for (int m = 0; m < 4; ++m) { const size_t off = (size_t)(row0 + ai * HALF + m * 16) * ldc + col0; f32x4 bb[2][2];
#pragma unroll
                    for (int bj = 0; bj < 2; ++bj) { bb[bj][0] = *(const f32x4*)((const float*)base + off + bj * HALF); bb[bj][1] = *(const f32x4*)((const float*)base + off + bj * HALF + 4); }
#pragma unroll
                    for (int bj = 0; bj < 2; ++bj) { const f32x4 o0 = bb[bj][0] + acc[ai][bj][m][0] * s, o1 = bb[bj][1] + acc[ai][bj][m][1] * s;
                        if (OB) { h16x8_t wo; wo[0] = (_Float16)o0[0]; wo[1] = (_Float16)o0[1]; wo[2] = (_Float16)o0[2]; wo[3] = (_Float16)o0[3]; wo[4] = (_Float16)o1[0]; wo[5] = (_Float16)o1[1]; wo[6] = (_Float16)o1[2]; wo[7] = (_Float16)o1[3];
                            *(h16x8_t*)((bf16_t*)out + off + bj * HALF) = wo; }
                        else { *(f32x4*)((float*)out + off + bj * HALF) = o0; *(f32x4*)((float*)out + off + bj * HALF + 4) = o1; } } }
            }
        }
    }
};
__device__ __forceinline__ f32x4 i32bits_to_f32(f32x4 v) { return (f32x4){(float)__float_as_int(v.x), (float)__float_as_int(v.y), (float)__float_as_int(v.z), (float)__float_as_int(v.w)}; }
template <bool IN8 = false>
struct EpiStore {
    static constexpr bool PERM = true, AFTER_DRAIN = false;
    bf16_t* O; int ldc; int gate_tile; float* G; RowTab rt; const float* cstep;
    __device__ __forceinline__ void operator()(const f32x4 (&acc)[2][2][4][2], const Unit& u, int wr, int wc, int fr, int fq) const {
        const int row0 = u.pm * BM + wr * 64 + fr, colt = u.pn * BM, cl = wc * 32 + 8 * fq; const int sl = IN8 ? rt.slot(u.pm) : 0;
        f32x4 cs[2][2];
#pragma unroll
        for (int bj = 0; bj < 2; ++bj)
#pragma unroll
            for (int n = 0; n < 2; ++n) cs[bj][n] = IN8 ? *(const f32x4*)(cstep + colt + bj * HALF + cl + 4 * n) : (f32x4){1.f, 1.f, 1.f, 1.f};
        if (u.pn >= gate_tile) {
            if (wc == 0 && fq < 2) {
#pragma unroll
                for (int ai = 0; ai < 2; ++ai)
#pragma unroll
                    for (int m = 0; m < 4; ++m) { const int rl = wr * 64 + ai * HALF + m * 16 + fr; float* gp = G + (size_t)(u.pm * BM + rl) * 16 + 8 * fq;
                        if (IN8) { const float rs = rt.tab[sl * 256 + rl]; *(f32x4*)gp = i32bits_to_f32(acc[ai][0][m][0]) * cs[0][0] * rs; *(f32x4*)(gp + 4) = i32bits_to_f32(acc[ai][0][m][1]) * cs[0][1] * rs; }
                        else { *(f32x4*)gp = acc[ai][0][m][0]; *(f32x4*)(gp + 4) = acc[ai][0][m][1]; } }
            }
            return;
        }
#pragma unroll
        for (int ai = 0; ai < 2; ++ai)
#pragma unroll
            for (int m = 0; m < 4; ++m) { const int rl = wr * 64 + ai * HALF + m * 16 + fr; bf16_t* rowp = O + (size_t)(u.pm * BM + rl) * ldc + colt + cl;
                const float rs = IN8 ? rt.tab[sl * 256 + rl] : 1.0f;
#pragma unroll
                for (int bj = 0; bj < 2; ++bj) { f32x4 v0 = acc[ai][bj][m][0], v1 = acc[ai][bj][m][1];
                    if (IN8) { v0 = i32bits_to_f32(v0) * cs[bj][0] * rs; v1 = i32bits_to_f32(v1) * cs[bj][1] * rs; }
                    u32x4 w; w.x = cvt_pk_bf16(v0[0], v0[1]); w.y = cvt_pk_bf16(v0[2], v0[3]); w.z = cvt_pk_bf16(v1[0], v1[1]); w.w = cvt_pk_bf16(v1[2], v1[3]);
                    *(u32x4*)(rowp + bj * HALF) = w; } }
    }
};
struct EpiRwkv1 {
    static constexpr bool PERM = true, AFTER_DRAIN = false;
    bf16_t* RKV; bf16_t* L; int Mrows;
    __device__ __forceinline__ void operator()(const f32x4 (&acc)[2][2][4][2], const Unit& u, int wr, int wc, int fr, int fq) const {
        const int pml = u.pm & (MROWS_TILES - 1), row0 = pml * BM + wr * 64 + fr, cl = wc * 32 + 8 * fq;
        bf16_t* base; int ldc, colt, mode;
        if (u.pn < 24) { base = RKV + (size_t)(u.pn >> 3) * Mrows * 2048; ldc = 2048; colt = (u.pn & 7) * BM; mode = 0; }
        else { base = L + (size_t)(u.pn - 24) * Mrows * 256; ldc = 256; colt = 0; mode = u.pn - 23; }
#pragma unroll
        for (int ai = 0; ai < 2; ++ai)
#pragma unroll
            for (int m = 0; m < 4; ++m) { bf16_t* rowp = base + (size_t)(row0 + ai * HALF + m * 16) * ldc + colt + cl;
#pragma unroll
                for (int bj = 0; bj < 2; ++bj) { float o[8];
#pragma unroll
                    for (int n = 0; n < 2; ++n)
#pragma unroll
                        for (int e = 0; e < 4; ++e) { float v = acc[ai][bj][m][n][e];
                            if (mode == 1) { const float t = __expf(-2.0f * fabsf(v)); const float th = (1.0f - t) * __builtin_amdgcn_rcpf(1.0f + t); v = v < 0.f ? -th : th; }
                            else if (mode == 3) v = fast_sigmoid(v);
                            o[4 * n + e] = v; }
                    u32x4 w; w.x = cvt_pk_bf16(o[0], o[1]); w.y = cvt_pk_bf16(o[2], o[3]); w.z = cvt_pk_bf16(o[4], o[5]); w.w = cvt_pk_bf16(o[6], o[7]);
                    *(u32x4*)(rowp + bj * HALF) = w; } }
    }
};
struct EpiRwkv2 {
    static constexpr bool PERM = true, AFTER_DRAIN = false;
    float* DEC; bf16_t* AG; bf16_t* GG; const float* w0; const float* a0;
    __device__ __forceinline__ void operator()(const f32x4 (&acc)[2][2][4][2], const Unit& u, int wr, int wc, int fr, int fq) const {
        const int pml = u.pm & (MROWS_TILES - 1), row0 = pml * BM + wr * 64 + fr, seg = u.pn >> 3, col0 = (u.pn & 7) * BM + wc * 32 + 8 * fq;
        const float* bias = seg == 0 ? w0 : a0;
        f32x4 bv[2][2];
#pragma unroll
        for (int bj = 0; bj < 2; ++bj)
#pragma unroll
            for (int n = 0; n < 2; ++n) bv[bj][n] = seg < 2 ? *(const f32x4*)(bias + col0 + bj * HALF + 4 * n) : (f32x4){0.f, 0.f, 0.f, 0.f};
#pragma unroll
        for (int ai = 0; ai < 2; ++ai)
#pragma unroll
            for (int m = 0; m < 4; ++m) { const size_t ro = (size_t)(row0 + ai * HALF + m * 16) * 2048;
#pragma unroll
                for (int bj = 0; bj < 2; ++bj) { const int col = col0 + bj * HALF; const f32x4 v0 = acc[ai][bj][m][0] + bv[bj][0], v1 = acc[ai][bj][m][1] + bv[bj][1];
                    if (seg == 0) { *(f32x4*)(DEC + ro + col) = v0; *(f32x4*)(DEC + ro + col + 4) = v1; }
                    else { u32x4 w; w.x = cvt_pk_bf16(v0[0], v0[1]); w.y = cvt_pk_bf16(v0[2], v0[3]); w.z = cvt_pk_bf16(v1[0], v1[1]); w.w = cvt_pk_bf16(v1[2], v1[3]);
                        *(u32x4*)((seg == 1 ? AG : GG) + ro + col) = w; } } }
    }
};
struct RwkvOrder1 { StaticOrder b;
    __device__ bool next(int i, Unit& u) const { if (!b.next(i, u)) return false; const int seg = u.pn < 24 ? (u.pn >> 3) : u.pn - 21; u.pm += ((0x541320 >> (4 * seg)) & 7) * MROWS_TILES; return true; }
    __device__ __forceinline__ void a_ready(const Unit&) const {}
    __device__ __forceinline__ void done(const Unit&) const {} };
struct RwkvOrder2 { StaticOrder b;
    __device__ bool next(int i, Unit& u) const { if (!b.next(i, u)) return false; u.pm += (u.pn >> 3) * MROWS_TILES; return true; }
    __device__ __forceinline__ void a_ready(const Unit&) const {}
    __device__ __forceinline__ void done(const Unit&) const {} };

template <class Epi, class Sched, bool ALIGN_EPI = false, bool SP2 = false, int DT = 0>
__device__ __forceinline__ void gemm_phase(PG8_LAS unsigned char* lds, const Gemm g, const Sched& S, const Epi& E, const int tid_in) {
    const int tid = tid_in, wid = __builtin_amdgcn_readfirstlane(tid >> 6), lane = tid & 63, wr = wid >> 2, wc = wid & 3, fr = lane & 15, fq = lane >> 4;
    int K_ = g.K; asm volatile("" : "+s"(K_));
    const int K = K_, nt = K / BK;
    unsigned voffA[2], voffB[2];
#pragma unroll
    for (int i = 0; i < 2; ++i) { int R, C; stage_rc(tid * 16 + i * 8192, R, C); const int Rb = Epi::PERM ? ((R & ~31) + perm32(R & 31)) : R;
        voffA[i] = (unsigned)(R * g.lda + C) * 2u; voffB[i] = (unsigned)(Rb * g.ldb + C) * 2u; }
    const size_t kstep = (size_t)(BK * 2);
    const size_t hstepA = (size_t)HALF * g.lda * 2, hstepB = (size_t)HALF * g.ldb * 2;
    const size_t tstepA = 2 * hstepA, tstepB = 2 * hstepB;
    const unsigned ldsw = (unsigned)wid * 1024u;
    const int aoff = lds_byte(wr * 64 + fr, fq * (DT == 1 ? 16 : 8)), boff = lds_byte(wc * 32 + fr, fq * (DT == 1 ? 16 : 8));
#define PG8_SA(b, h) (((b) * 2 + (h)) * HTB)
#define PG8_SB(b, h) ((4 + (b) * 2 + (h)) * HTB)
#define PG8_STAGE(bufoff, gbase, voff) do { _Pragma("unroll") for (int _i = 0; _i < 2; ++_i) \
        __builtin_amdgcn_global_load_lds((const unsigned*)((const char*)(gbase) + (voff)[_i]), (PG8_LAS unsigned*)(lds + (bufoff) + ldsw + _i * 8192), 16, 0, 0); } while (0)
#define PG8_LDA(dst, b, h) do { if constexpr (DT != 1) { _Pragma("unroll") for (int m = 0; m < 4; ++m) _Pragma("unroll") for (int k = 0; k < 2; ++k) dst[m][k] = *(const PG8_LAS bf16x8*)(lds + PG8_SA(b, h) + aoff + m * 2048 + k * 1024); } \
        else { _Pragma("unroll") for (int m = 0; m < 4; ++m) dst##8[m] = ld32(lds + PG8_SA(b, h) + aoff + m * 2048); } } while (0)
#define PG8_LDB(dst, b, h) do { if constexpr (DT != 1) { _Pragma("unroll") for (int n = 0; n < 2; ++n) _Pragma("unroll") for (int k = 0; k < 2; ++k) dst[n][k] = *(const PG8_LAS bf16x8*)(lds + PG8_SB(b, h) + boff + n * 2048 + k * 1024); } \
        else { _Pragma("unroll") for (int n = 0; n < 2; ++n) dst##8[n] = ld32(lds + PG8_SB(b, h) + boff + n * 2048); } } while (0)
#define PG8_MMA(ai, bj, At, Bt) do { __builtin_amdgcn_s_setprio(1); \
        if constexpr (DT == 0) { _Pragma("unroll") for (int m = 0; m < 4; ++m) _Pragma("unroll") for (int n = 0; n < 2; ++n) _Pragma("unroll") for (int k = 0; k < 2; ++k) \
            acc[ai][bj][m][n] = __builtin_amdgcn_mfma_f32_16x16x32_bf16(Bt[n][k], At[m][k], acc[ai][bj][m][n], 0, 0, 0); } \
        else if constexpr (DT == 2) { typedef int i32x4_ __attribute__((ext_vector_type(4))); _Pragma("unroll") for (int m = 0; m < 4; ++m) _Pragma("unroll") for (int n = 0; n < 2; ++n) _Pragma("unroll") for (int k = 0; k < 2; ++k) \
            acc[ai][bj][m][n] = __builtin_bit_cast(f32x4, __builtin_amdgcn_mfma_i32_16x16x64_i8(__builtin_bit_cast(i32x4_, Bt[n][k]), __builtin_bit_cast(i32x4_, At[m][k]), __builtin_bit_cast(i32x4_, acc[ai][bj][m][n]), 0, 0, 0)); } \
        else { _Pragma("unroll") for (int m = 0; m < 4; ++m) _Pragma("unroll") for (int n = 0; n < 2; ++n) \
            { constexpr int O_ = 0; const int o_ = (m * 2 + n) * 4; f32x4 c_ = {accq[ai][bj][o_], accq[ai][bj][o_ + 1], accq[ai][bj][o_ + 2], accq[ai][bj][o_ + 3]}; (void)O_; \
              c_ = __builtin_amdgcn_mfma_scale_f32_16x16x128_f8f6f4(Bt##8[n], At##8[m], c_, 0, 0, 0, 0x7F7F7F7F, 0, 0x7F7F7F7F); \
              accq[ai][bj][o_] = c_[0]; accq[ai][bj][o_ + 1] = c_[1]; accq[ai][bj][o_ + 2] = c_[2]; accq[ai][bj][o_ + 3] = c_[3]; } } \
        __builtin_amdgcn_s_setprio(0); } while (0)
#define PG8_WAIT_V(n) asm volatile("s_waitcnt vmcnt(" #n ")" ::: "memory")
#define PG8_WAIT_L(n) asm volatile("s_waitcnt lgkmcnt(" #n ")" ::: "memory")
#define PG8_BAR __builtin_amdgcn_s_barrier()
#define PG8_SCHED __builtin_amdgcn_sched_barrier(0)
    Unit cur, nxt; int ui = 0;
    if (!S.next(0, cur)) return;
    f32x4 acc[2][2][4][2];
    typedef float f32x32 __attribute__((ext_vector_type(32)));
    f32x32 accq[2][2];
    if constexpr (DT == 1) {
#pragma unroll
        for (int a = 0; a < 2; ++a)
#pragma unroll
            for (int b = 0; b < 2; ++b)
#pragma unroll
                for (int i = 0; i < 32; ++i) accq[a][b][i] = 0.f; }
#pragma unroll
    for (int a = 0; a < 2; ++a)
#pragma unroll
        for (int b = 0; b < 2; ++b)
#pragma unroll
            for (int m = 0; m < 4; ++m)
#pragma unroll
                for (int n = 0; n < 2; ++n) acc[a][b][m][n] = (f32x4){0.f, 0.f, 0.f, 0.f};
    bf16x8 At[4][2], B0[2][2], B1[2][2];
    i32x8 At8[4], B08[2], B18[2];
    const char* cA = (const char*)g.A + (size_t)cur.pm * tstepA; const char* cB = (const char*)g.Bt + (size_t)cur.pn * tstepB;
    S.a_ready(cur);
    if constexpr (SP2) {
        PG8_STAGE(PG8_SB(0, 0), cB, voffB); PG8_STAGE(PG8_SB(0, 1), cB + hstepB, voffB); PG8_STAGE(PG8_SA(0, 0), cA, voffA); PG8_STAGE(PG8_SA(0, 1), cA + hstepA, voffA);
        if (wr == 1) PG8_BAR;
        PG8_WAIT_V(2); PG8_BAR;
        PG8_STAGE(PG8_SB(1, 0), cB + kstep, voffB); PG8_STAGE(PG8_SA(1, 0), cA + kstep, voffA); PG8_STAGE(PG8_SB(1, 1), cB + hstepB + kstep, voffB);
        PG8_WAIT_V(6); PG8_BAR;
    } else {
        PG8_STAGE(PG8_SB(0, 0), cB, voffB); PG8_STAGE(PG8_SA(0, 0), cA, voffA); PG8_STAGE(PG8_SB(0, 1), cB + hstepB, voffB); PG8_STAGE(PG8_SA(0, 1), cA + hstepA, voffA);
        if (wr == 1) PG8_BAR;
        PG8_WAIT_V(4); PG8_BAR;
        PG8_STAGE(PG8_SB(1, 0), cB + kstep, voffB); PG8_STAGE(PG8_SA(1, 0), cA + kstep, voffA); PG8_STAGE(PG8_SB(1, 1), cB + hstepB + kstep, voffB);
        PG8_WAIT_V(6); PG8_BAR;
    }
    for (;;) {
        const bool has_next = S.next(ui + 1, nxt);
        const char* nA = has_next ? (const char*)g.A + (size_t)nxt.pm * tstepA : cA; const char* nB = has_next ? (const char*)g.Bt + (size_t)nxt.pn * tstepB : cB;
        for (int t = 0; t < nt; t += 2) {
            const bool last = (t == nt - 2);
            const char* a1 = cA + (size_t)(t + 1) * kstep;
            const char* a2 = last ? nA : cA + (size_t)(t + 2) * kstep; const char* b2 = last ? nB : cB + (size_t)(t + 2) * kstep;
            const char* a3 = a2 + kstep; const char* b3 = b2 + kstep;
            if (last && has_next) S.a_ready(nxt);
            if constexpr (SP2) {
            PG8_LDB(B0, 0, 0); PG8_LDB(B1, 0, 1); PG8_SCHED; PG8_LDA(At, 0, 0); PG8_STAGE(PG8_SA(1, 1), a1 + hstepA, voffA);
            PG8_WAIT_V(8); PG8_WAIT_L(0); PG8_BAR; PG8_MMA(0, 0, At, B0); PG8_MMA(0, 1, At, B1); PG8_BAR; PG8_SCHED;
            PG8_LDA(At, 0, 1); PG8_STAGE(PG8_SB(0, 0), b2, voffB); PG8_STAGE(PG8_SB(0, 1), b2 + hstepB, voffB); PG8_STAGE(PG8_SA(0, 0), a2, voffA);
            PG8_WAIT_V(8); PG8_WAIT_L(0); PG8_BAR; PG8_MMA(1, 0, At, B0); PG8_MMA(1, 1, At, B1); PG8_BAR; PG8_SCHED;
            PG8_LDB(B0, 1, 0); PG8_LDB(B1, 1, 1); PG8_SCHED; PG8_LDA(At, 1, 0); PG8_STAGE(PG8_SA(0, 1), a2 + hstepA, voffA);
            PG8_WAIT_V(8); PG8_WAIT_L(0); PG8_BAR; PG8_MMA(0, 0, At, B0); PG8_MMA(0, 1, At, B1); PG8_BAR; PG8_SCHED;
            PG8_LDA(At, 1, 1); PG8_STAGE(PG8_SB(1, 0), b3, voffB); PG8_STAGE(PG8_SB(1, 1), b3 + hstepB, voffB); PG8_STAGE(PG8_SA(1, 0), a3, voffA);
            PG8_WAIT_V(8); PG8_WAIT_L(0); PG8_BAR; PG8_MMA(1, 0, At, B0); PG8_MMA(1, 1, At, B1); PG8_BAR; PG8_SCHED;
            } else {
            PG8_LDB(B0, 0, 0); PG8_SCHED; PG8_LDA(At, 0, 0); PG8_STAGE(PG8_SA(1, 1), a1 + hstepA, voffA);
            PG8_WAIT_L(8); PG8_BAR; PG8_WAIT_L(0); PG8_MMA(0, 0, At, B0); PG8_BAR; PG8_SCHED;
            PG8_LDB(B1, 0, 1); PG8_STAGE(PG8_SB(0, 0), b2, voffB);
            PG8_BAR; PG8_WAIT_L(0); PG8_MMA(0, 1, At, B1); PG8_BAR;
            PG8_LDA(At, 0, 1); PG8_STAGE(PG8_SA(0, 0), a2, voffA);
            PG8_BAR; PG8_WAIT_L(0); PG8_MMA(1, 0, At, B0); PG8_BAR; PG8_SCHED;
            PG8_STAGE(PG8_SB(0, 1), b2 + hstepB, voffB);
            PG8_WAIT_V(6); PG8_BAR; PG8_MMA(1, 1, At, B1); PG8_BAR;
            PG8_LDB(B0, 1, 0); PG8_SCHED; PG8_LDA(At, 1, 0); PG8_STAGE(PG8_SA(0, 1), a2 + hstepA, voffA);
            PG8_WAIT_L(8); PG8_BAR; PG8_WAIT_L(0); PG8_MMA(0, 0, At, B0); PG8_BAR; PG8_SCHED;
            PG8_LDB(B1, 1, 1); PG8_STAGE(PG8_SB(1, 0), b3, voffB);
            PG8_BAR; PG8_WAIT_L(0); PG8_MMA(0, 1, At, B1); PG8_BAR;
            PG8_LDA(At, 1, 1); PG8_STAGE(PG8_SA(1, 0), a3, voffA);
            PG8_BAR; PG8_WAIT_L(0); PG8_MMA(1, 0, At, B0); PG8_BAR; PG8_SCHED;
            PG8_STAGE(PG8_SB(1, 1), b3 + hstepB, voffB);
            PG8_WAIT_V(6); PG8_BAR; PG8_MMA(1, 1, At, B1); PG8_BAR;
            }
        }
        if constexpr (ALIGN_EPI) { if (wr == 0) PG8_BAR; }
        if constexpr (DT == 1) {
#pragma unroll
            for (int a = 0; a < 2; ++a)
#pragma unroll
                for (int b = 0; b < 2; ++b)
#pragma unroll
                    for (int m = 0; m < 4; ++m)
#pragma unroll
                        for (int n = 0; n < 2; ++n) { const int o_ = (m * 2 + n) * 4; acc[a][b][m][n] = (f32x4){accq[a][b][o_], accq[a][b][o_ + 1], accq[a][b][o_ + 2], accq[a][b][o_ + 3]}; } }
        if constexpr (!Epi::AFTER_DRAIN) { E(acc, cur, wr, wc, fr, fq); S.done(cur); }
        if (!has_next) break;
#pragma unroll
        for (int a = 0; a < 2; ++a)
#pragma unroll
            for (int b = 0; b < 2; ++b)
#pragma unroll
                for (int m = 0; m < 4; ++m)
#pragma unroll
                    for (int n = 0; n < 2; ++n) acc[a][b][m][n] = (f32x4){0.f, 0.f, 0.f, 0.f};
        if constexpr (DT == 1) {
#pragma unroll
            for (int a = 0; a < 2; ++a)
#pragma unroll
                for (int b = 0; b < 2; ++b)
#pragma unroll
                    for (int i = 0; i < 32; ++i) accq[a][b][i] = 0.f; }
        cur = nxt; cA = nA; cB = nB; ++ui;
        if constexpr (ALIGN_EPI) { if (wr == 1) PG8_BAR; }
    }
    PG8_WAIT_V(0);
    if constexpr (!ALIGN_EPI) { if (wr == 0) PG8_BAR; }
    PG8_BAR;
    if constexpr (Epi::AFTER_DRAIN) { E.fused(acc, cur, wr, wc, fr, fq, lds, wid, lane); S.done(cur); }
#undef PG8_SA
#undef PG8_SB
#undef PG8_STAGE
#undef PG8_LDA
#undef PG8_LDB
#undef PG8_MMA
#undef PG8_WAIT_V
#undef PG8_WAIT_L
#undef PG8_BAR
#undef PG8_SCHED
}
}

constexpr int NWAVES = 8, NTHREADS = 512;
constexpr int DM = 2048, NBATCH = 8, SEQ = 4096, MTOK = NBATCH * SEQ, FF = 5632, DEPTH = 4;
constexpr float NORM_EPS = 1e-6f;
constexpr int ML_H = 8, ML_DK = 128, ML_DV = 256, ML_L = 64, ML_NC = SEQ / ML_L, ML_INCOLS = 6160, ML_NPAD = 6400, ML_ITEMS = NBATCH * ML_H * ML_NC;
constexpr int AT_DH = 64, AT_HQ = 32, AT_HKV = 4, AT_G = 8, AT_BLK = 128, AT_NB = SEQ / AT_BLK, AT_COLS = 2560, AT_UNITS = NBATCH * AT_NB * AT_HKV;
constexpr int RW_H = 32, RW_N = 64, RW_T = 32, RW_NBLK = SEQ / RW_T;
constexpr float RW_LN_EPS = 64e-5f;
enum { I_X = 0, I_POS, I_F1N, I_F1GU, I_F1DN, I_MN, I_F2N, I_F2GU, I_F2DN, I_MLWIN, I_MLBG, I_MLHG, I_MLWOUT, I_ATQKV, I_ATQG, I_ATKG, I_ATSINK, I_ATWO,
       I_RWMIX, I_RWRKV, I_RWW0, I_RWWLA, I_RWWLB, I_RWA0, I_RWALA, I_RWALB, I_RWGLA, I_RWGLB, I_RWKK, I_RWKA, I_RWRK, I_RWLNW, I_RWLNB, I_RWWO, N_IN };
constexpr size_t MiB = 1u << 20;
constexpr size_t WS_CTL = 0, CTL_ZERO_BYTES = 1 * MiB;
constexpr size_t WS_ROPE = 2 * MiB;
constexpr size_t WS_GATES = 4 * MiB;
constexpr size_t WS_STAT = 6 * MiB;
constexpr size_t WS_MST = 6 * MiB + 65536;
constexpr size_t WS_NV = 8 * MiB;
constexpr size_t WS_ROWQ = 10 * MiB;
constexpr int CW_CMAX = 65536;
constexpr int CW_CMAX2 = 65536 + 8 * 11264;
constexpr size_t WS_CSTEP2 = 11 * MiB + 512 * 1024;
constexpr size_t WS_CSTEP = 11 * MiB;
constexpr size_t WS_WGU1 = 16 * MiB, WS_WDN1 = 60 * MiB, WS_WGU2 = 82 * MiB, WS_WDN2 = 126 * MiB, WS_WMIX = 148 * MiB;
constexpr size_t WS_XN = 192 * MiB;
constexpr size_t WS_BIG = 320 * MiB;
constexpr size_t WS_END = WS_BIG + 1152 * MiB;
constexpr int CW_BAR = 4096;

#define GAS __attribute__((address_space(1)))
#define LAS __attribute__((address_space(3)))
typedef unsigned short bf16;
typedef unsigned v4u __attribute__((ext_vector_type(4)));
typedef unsigned v2u __attribute__((ext_vector_type(2)));
typedef float f32x4 __attribute__((ext_vector_type(4)));
typedef float f32x2 __attribute__((ext_vector_type(2)));
typedef float f32x16 __attribute__((ext_vector_type(16)));
typedef short bf16x8 __attribute__((ext_vector_type(8)));
typedef short s16x4 __attribute__((ext_vector_type(4)));
#define LDS_WAIT() asm volatile("s_waitcnt lgkmcnt(0)" ::: "memory")
#define VM_WAIT() asm volatile("s_waitcnt vmcnt(0)" ::: "memory")
#define MFMA32(a, b, c) __builtin_amdgcn_mfma_f32_32x32x16_bf16((a), (b), (c), 0, 0, 0)
__device__ __forceinline__ unsigned pk2(float lo, float hi) { return pg8::cvt_pk_bf16(lo, hi); }
__device__ __forceinline__ float bf2f(unsigned short h) { return __builtin_bit_cast(float, (unsigned)h << 16); }
__device__ __forceinline__ float bflo(unsigned w) { return __builtin_bit_cast(float, w << 16); }
__device__ __forceinline__ float bfhi(unsigned w) { return __builtin_bit_cast(float, w & 0xffff0000u); }
__device__ __forceinline__ unsigned short f2bf(float f) { return (unsigned short)(pk2(f, 0.f) & 0xffffu); }
__device__ __forceinline__ float wave_sum(float v) {
#pragma unroll
    for (int o = 1; o < 64; o <<= 1) v += __shfl_xor(v, o);
    return v;
}
__device__ __forceinline__ float wave_max(float v) {
#pragma unroll
    for (int o = 1; o < 64; o <<= 1) v = fmaxf(v, __shfl_xor(v, o));
    return v;
}

template <int CTRL, int RM> __device__ __forceinline__ float dpp_upd(float x) { return __builtin_bit_cast(float, __builtin_amdgcn_update_dpp(0, __builtin_bit_cast(int, x), CTRL, RM, 0xf, false)); }
__device__ __forceinline__ float wave_sum_dpp(float x) {
    x += dpp_upd<0xB1, 0xf>(x); x += dpp_upd<0x4E, 0xf>(x); x += dpp_upd<0x141, 0xf>(x); x += dpp_upd<0x140, 0xf>(x);
    x += dpp_upd<0x142, 0xa>(x); x += dpp_upd<0x143, 0xc>(x);
    return __builtin_bit_cast(float, __builtin_amdgcn_readlane(__builtin_bit_cast(int, x), 63));
}
__device__ __forceinline__ int crow(int reg, int h) { return (reg & 3) + 8 * (reg >> 2) + 4 * h; }
#define XB_TMO      128
#define XB_XCNT(j)  (256  + 64 * (j))
#define XB_XSUB(j)  (1280 + 64 * (j))
#define XB_XGEN(j)  (2304 + 64 * (j))
#define XB_TOP      3328
#define XB_TOPGEN   3392
#define XCD_BAR_WORDS 3456
#define XB_SPIN_CAP (1u << 18)

__device__ __forceinline__ unsigned xb_ld(unsigned* p)              { return __hip_atomic_load(p, __ATOMIC_RELAXED, __HIP_MEMORY_SCOPE_AGENT); }
__device__ __forceinline__ unsigned xb_add(unsigned* p, unsigned v) { return __hip_atomic_fetch_add(p, v, __ATOMIC_RELAXED, __HIP_MEMORY_SCOPE_AGENT); }
__device__ __forceinline__ unsigned xb_xcc_id() { return (unsigned)__builtin_amdgcn_s_getreg((3 << 11) | 20) & 0xFu; }
#define XB_SPIN(cond, bar) do { unsigned _sp = 0; while (cond) { __builtin_amdgcn_s_sleep(1); \
    if ((++_sp & 255u) == 0u) { if (xb_ld(&(bar)[XB_TMO])) break; if (_sp > XB_SPIN_CAP) { atomicAdd(&(bar)[XB_TMO], 1u); break; } } } } while (0)

struct XcdBarrier {
    unsigned* bar; unsigned x;
    volatile LAS unsigned* st;
};

__device__ __forceinline__ XcdBarrier xcd_barrier_post(unsigned* bar, volatile LAS unsigned* st) {
    XcdBarrier b; b.bar = bar; b.x = xb_xcc_id(); b.st = st;
    if (threadIdx.x == 0) (void)xb_add(&bar[XB_XCNT(b.x)], 1u);
    return b;
}
__device__ __forceinline__ void xcd_barrier_complete(unsigned* bar, unsigned x, unsigned& nloc, unsigned& nx) {
    const unsigned G = gridDim.x * gridDim.y * gridDim.z;
    unsigned sum, cnt, mine, sp = 0u;
    for (;;) {
        sum = 0u; cnt = 0u; mine = 0u;
#pragma unroll
        for (unsigned j = 0; j < 16; ++j) { const unsigned c = xb_ld(&bar[XB_XCNT(j)]); sum += c; cnt += (c > 0u) ? 1u : 0u; mine = (j == x) ? c : mine; }
        if (sum == G) break;
        __builtin_amdgcn_s_sleep(1);
        if ((++sp & 255u) == 0u) { if (xb_ld(&bar[XB_TMO])) break; if (sp > XB_SPIN_CAP) { atomicAdd(&bar[XB_TMO], 1u); break; } }
    }
    nloc = mine > 0u ? mine : 1u; nx = cnt > 0u ? cnt : 1u;
}

__device__ __forceinline__ void xcd_barrier(const XcdBarrier& b) {
    asm volatile("s_waitcnt vmcnt(0)" ::: "memory");
    __syncthreads();
    if (threadIdx.x == 0) {
        unsigned* bar = b.bar;
        __builtin_amdgcn_s_waitcnt(0);
        unsigned nloc = b.st[0], nx = b.st[1];
        if (nloc == 0u) { xcd_barrier_complete(bar, b.x, nloc, nx); b.st[0] = nloc; b.st[1] = nx; }
        const unsigned old = xb_add(&bar[XB_XSUB(b.x)], 1u);
        const unsigned gen = old / nloc;
        if (old + 1u == (gen + 1u) * nloc) {
            __builtin_amdgcn_fence(__ATOMIC_RELEASE, "agent");
            asm volatile("s_waitcnt vmcnt(0)" ::: "memory");
            const unsigned og = xb_add(&bar[XB_TOP], 1u);
            const unsigned tg = og / nx;
            if (og + 1u == (tg + 1u) * nx) xb_add(&bar[XB_TOPGEN], 1u);
            else XB_SPIN(xb_ld(&bar[XB_TOPGEN]) == tg, bar);
            __builtin_amdgcn_fence(__ATOMIC_ACQUIRE, "agent");
            xb_add(&bar[XB_XGEN(b.x)], 1u);
            asm volatile("s_waitcnt vmcnt(0)" ::: "memory");
        } else {
            XB_SPIN(xb_ld(&bar[XB_XGEN(b.x)]) == gen, bar);
            __builtin_amdgcn_fence(__ATOMIC_ACQUIRE, "agent");
            asm volatile("s_waitcnt vmcnt(0)" ::: "memory");
        }
    }
    __syncthreads();
}

struct Args { const float* in[N_IN]; float* out; unsigned char* ws; int ph_lo, ph_hi; };
struct Frame { LAS unsigned char* lds; int tid, lane, wave, G, bid; };

__device__ __forceinline__ void transpose_item(const float* W, int ldw, bf16* WT, int ldt, int k0, int n0, int dst_row0, LAS float* scr, int lane) {
#pragma unroll 8
    for (int i = 0; i < 32; ++i) { const int kk = 2 * i + (lane >> 5); scr[kk * 33 + (lane & 31)] = __builtin_nontemporal_load(W + (size_t)(k0 + kk) * ldw + n0 + (lane & 31)); }
    LDS_WAIT(); asm volatile("" ::: "memory");
    const int c = lane & 7;
#pragma unroll
    for (int j = 0; j < 4; ++j) { const int n = (lane >> 3) + 8 * j; const LAS float* s = scr + (8 * c) * 33 + n;
        v4u o; o.x = pk2(s[0 * 33], s[1 * 33]); o.y = pk2(s[2 * 33], s[3 * 33]); o.z = pk2(s[4 * 33], s[5 * 33]); o.w = pk2(s[6 * 33], s[7 * 33]);
        __builtin_nontemporal_store(o, (v4u*)(WT + (size_t)(dst_row0 + n) * ldt + k0 + 8 * c)); }
    LDS_WAIT(); asm volatile("" ::: "memory");
}
__device__ __forceinline__ void transpose_item_f8(const float* W, int ldw, unsigned char* WT, int ldt, int k0, int n0, int dst_row0, LAS float* scr, int lane, float scale) {
#pragma unroll 8
    for (int i = 0; i < 32; ++i) { const int kk = 2 * i + (lane >> 5); scr[kk * 33 + (lane & 31)] = __builtin_amdgcn_fmed3f(__builtin_nontemporal_load(W + (size_t)(k0 + kk) * ldw + n0 + (lane & 31)) * scale, -448.f, 448.f); }
    LDS_WAIT(); asm volatile("" ::: "memory");
    const int c = lane & 7;
#pragma unroll
    for (int j = 0; j < 4; ++j) { const int n = (lane >> 3) + 8 * j; const LAS float* s = scr + (8 * c) * 33 + n; unsigned w0 = 0u, w1 = 0u;
        w0 = __builtin_amdgcn_cvt_pk_fp8_f32(s[0 * 33], s[1 * 33], w0, false); w0 = __builtin_amdgcn_cvt_pk_fp8_f32(s[2 * 33], s[3 * 33], w0, true);
        w1 = __builtin_amdgcn_cvt_pk_fp8_f32(s[4 * 33], s[5 * 33], w1, false); w1 = __builtin_amdgcn_cvt_pk_fp8_f32(s[6 * 33], s[7 * 33], w1, true);
        __builtin_nontemporal_store((v2u){w0, w1}, (v2u*)(WT + (size_t)(dst_row0 + n) * ldt + k0 + 8 * c)); }
    LDS_WAIT(); asm volatile("" ::: "memory");
}
__device__ __forceinline__ void colmax_pass(Frame& F, const float* W, int K, int N, int ldw, unsigned* cmax) {
    const int nit = N * (K / 128);
    for (int it = F.bid * NTHREADS + F.tid; it < nit; it += F.G * NTHREADS) { const int n = it % N, k0 = (it / N) * 128; const float* p = W + (size_t)k0 * ldw + n; float m = 0.f;
#pragma unroll 8
        for (int k = 0; k < 128; ++k) m = fmaxf(m, fabsf(p[(size_t)k * ldw]));
        atomicMax(cmax + n, __builtin_bit_cast(unsigned, m)); }
}
__device__ __forceinline__ void colmax_wide(Frame& F, const float* W, int K, int N, unsigned* cmax, int ldw = 0) {
    LAS float* red = (LAS float*)F.lds;
    const int ncb = N / 256, nit = ncb * (K / 128), pitch = ldw ? ldw : N;
    for (int it = F.bid; it < nit; it += F.G) { const int cb = it % ncb, k0 = (it / ncb) * 128 + F.wave * 16;
        const f32x4* p = (const f32x4*)(W + (size_t)k0 * pitch + cb * 256) + F.lane; f32x4 m = {0.f, 0.f, 0.f, 0.f};
#pragma unroll
        for (int k = 0; k < 16; ++k) { const f32x4 v = p[(size_t)k * (pitch / 4)]; m.x = fmaxf(m.x, fabsf(v.x)); m.y = fmaxf(m.y, fabsf(v.y)); m.z = fmaxf(m.z, fabsf(v.z)); m.w = fmaxf(m.w, fabsf(v.w)); }
        *(LAS f32x4*)(red + F.wave * 256 + 4 * F.lane) = m;
        __syncthreads();
        if (F.tid < 256) { float r = red[F.tid];
#pragma unroll
            for (int w = 1; w < 8; ++w) r = fmaxf(r, red[w * 256 + F.tid]);
            atomicMax(cmax + cb * 256 + F.tid, __builtin_bit_cast(unsigned, r)); }
        __syncthreads(); }
}
__device__ __forceinline__ unsigned pack_i8x4(float a, float b, float c, float d) {
    const int ia = (int)rintf(a), ib = (int)rintf(b), ic = (int)rintf(c), id = (int)rintf(d);
    return (unsigned)(ia & 0xff) | ((unsigned)(ib & 0xff) << 8) | ((unsigned)(ic & 0xff) << 16) | ((unsigned)(id & 0xff) << 24);
}
__device__ __forceinline__ void conv_small_i8(Frame& F, const float* W, int ldw, int col_off, int K, int Nsrc, unsigned char* WT, int rows, const unsigned* cmax, float* cstep) {
    const int gt = F.bid * NTHREADS + F.tid, NT = F.G * NTHREADS;
    for (int idx = gt; idx < rows * (K / 4); idx += NT) { const int n = idx / (K / 4), k = 4 * (idx - n * (K / 4)); unsigned w = 0u;
        if (n < Nsrc) { const float cm = fmaxf(__builtin_bit_cast(float, __hip_atomic_load(cmax + col_off + n, __ATOMIC_RELAXED, __HIP_MEMORY_SCOPE_AGENT)), 1e-30f), sc = 127.0f / cm; const float* p = W + (size_t)k * ldw + col_off + n;
            w = pack_i8x4(p[0] * sc, p[ldw] * sc, p[2 * (size_t)ldw] * sc, p[3 * (size_t)ldw] * sc); if (k == 0) cstep[col_off + n] = cm * (1.0f / 127.0f); }
        else if (k == 0) cstep[col_off + n] = 1.0f;
        *(unsigned*)(WT + (size_t)n * K + k) = w; }
}
template <int MAP>
__device__ __forceinline__ void conv_T_i8(Frame& F, const float* W, int K, int N, int ldw, unsigned char* WT, const unsigned* cmax, float* cstep) {
    LAS float* scr = (LAS float*)(F.lds + F.wave * 16384);
    const int gw = F.bid * NWAVES + F.wave, NGW = F.G * NWAVES, nblk = N / 32, nitems = (K / 64) * nblk, lane = F.lane;
    for (int it = gw; it < nitems; it += NGW) { const int n0 = 32 * (it % nblk), k0 = 64 * (it / nblk); const int jj = n0 < FF ? n0 : n0 - FF; const int dr = MAP == 1 ? (jj >> 7) * 256 + (n0 < FF ? 0 : 128) + (jj & 127) : n0;
        const float cm = fmaxf(__builtin_bit_cast(float, __hip_atomic_load(cmax + n0 + (lane & 31), __ATOMIC_RELAXED, __HIP_MEMORY_SCOPE_AGENT)), 1e-30f), scale = 127.0f / cm;
        if (k0 == 0 && lane < 32) cstep[dr + lane] = cm * (1.0f / 127.0f);
#pragma unroll 8
        for (int i = 0; i < 32; ++i) { const int kk = 2 * i + (lane >> 5); scr[kk * 33 + (lane & 31)] = W[(size_t)(k0 + kk) * ldw + n0 + (lane & 31)] * scale; }
        LDS_WAIT(); asm volatile("" ::: "memory");
        const int c = lane & 7;
#pragma unroll
        for (int j = 0; j < 4; ++j) { const int n = (lane >> 3) + 8 * j; const LAS float* s = scr + (8 * c) * 33 + n;
            __builtin_nontemporal_store((v2u){pack_i8x4(s[0 * 33], s[1 * 33], s[2 * 33], s[3 * 33]), pack_i8x4(s[4 * 33], s[5 * 33], s[6 * 33], s[7 * 33])}, (v2u*)(WT + (size_t)(dr + n) * K + k0 + 8 * c)); }
        LDS_WAIT(); asm volatile("" ::: "memory"); }
}
template <int MAP>
__device__ __forceinline__ void conv_T_f8(Frame& F, const float* W, int K, int N, unsigned char* WT, float scale) {
    LAS float* scr = (LAS float*)(F.lds + F.wave * 16384);
    const int gw = F.bid * NWAVES + F.wave, NGW = F.G * NWAVES, nblk = N / 32, nitems = (K / 64) * nblk;
    for (int it = gw; it < nitems; it += NGW) { const int n0 = 32 * (it % nblk); int dr = n0;
        if (MAP == 1) { const int jj = n0 < FF ? n0 : n0 - FF; dr = (jj >> 7) * 256 + (n0 < FF ? 0 : 128) + (jj & 127); }
        transpose_item_f8(W, N, WT, K, 64 * (it / nblk), n0, dr, scr, F.lane, scale); }
}
template <int MAP>
__device__ __forceinline__ void conv_T(Frame& F, const float* W, int K, int Nuse, int ldw, bf16* WT, int row_off) {
    LAS float* scr = (LAS float*)(F.lds + F.wave * 16384);
    const int gw = F.bid * NWAVES + F.wave, NGW = F.G * NWAVES, nblk = Nuse / 32, nitems = (K / 64) * nblk;
    for (int it = gw; it < nitems; it += NGW) { const int kb = it / nblk, n0 = 32 * (it % nblk); int dr;
        if (MAP == 1) { const int jj = n0 < FF ? n0 : n0 - FF; dr = (jj >> 7) * 256 + (n0 < FF ? 0 : 128) + (jj & 127); } else dr = row_off + n0;
        transpose_item(W, ldw, WT, K, 64 * kb, n0, dr, scr, F.lane); }
}
__device__ __forceinline__ void conv_small(Frame& F, const float* W, int ldw, int col_off, int Ksrc, int Nsrc, bf16* WT, int rows, int cols) {
    const int gt = F.bid * NTHREADS + F.tid, NT = F.G * NTHREADS;
    for (int idx = gt; idx < rows * cols; idx += NT) { const int n = idx / cols, k = idx - n * cols; const float v = (n < Nsrc && k < Ksrc) ? W[(size_t)k * ldw + col_off + n] : 0.f; WT[idx] = f2bf(v); }
}
template <class AT_>
__device__ __forceinline__ void conv_phase(const AT_& a, Frame& F, int l, bool f8dn1, bool f8dn2, bool f8gu1, bool f8gu2, bool i8gu1, bool i8gu2, bool i8mix) {
    unsigned char* ws = a.ws;
    if (i8gu1) conv_T_i8<1>(F, a.in[I_F1GU] + (size_t)l * DM * 2 * FF, DM, 2 * FF, 2 * FF, ws + WS_WGU1, (const unsigned*)(ws + WS_CTL) + CW_CMAX + (2 * l) * 2 * FF, (float*)(ws + WS_CSTEP) + (2 * l) * 2 * FF);
    else if (f8gu1) conv_T_f8<1>(F, a.in[I_F1GU] + (size_t)l * DM * 2 * FF, DM, 2 * FF, ws + WS_WGU1, pg8::W8_SCALE);
    else conv_T<1>(F, a.in[I_F1GU] + (size_t)l * DM * 2 * FF, DM, 2 * FF, 2 * FF, (bf16*)(ws + WS_WGU1), 0);
    if (f8dn1) conv_T_f8<0>(F, a.in[I_F1DN] + (size_t)l * FF * DM, FF, DM, ws + WS_WDN1, pg8::W8_SCALE);
    else conv_T<0>(F, a.in[I_F1DN] + (size_t)l * FF * DM, FF, DM, DM, (bf16*)(ws + WS_WDN1), 0);
    if (i8gu2) conv_T_i8<1>(F, a.in[I_F2GU] + (size_t)l * DM * 2 * FF, DM, 2 * FF, 2 * FF, ws + WS_WGU2, (const unsigned*)(ws + WS_CTL) + CW_CMAX + (2 * l + 1) * 2 * FF, (float*)(ws + WS_CSTEP) + (2 * l + 1) * 2 * FF);
    else if (f8gu2) conv_T_f8<1>(F, a.in[I_F2GU] + (size_t)l * DM * 2 * FF, DM, 2 * FF, ws + WS_WGU2, pg8::W8_SCALE);
    else conv_T<1>(F, a.in[I_F2GU] + (size_t)l * DM * 2 * FF, DM, 2 * FF, 2 * FF, (bf16*)(ws + WS_WGU2), 0);
    if (f8dn2) conv_T_f8<0>(F, a.in[I_F2DN] + (size_t)l * FF * DM, FF, DM, ws + WS_WDN2, pg8::W8_SCALE);
    else conv_T<0>(F, a.in[I_F2DN] + (size_t)l * FF * DM, FF, DM, DM, (bf16*)(ws + WS_WDN2), 0);
    bf16* WA = (bf16*)(ws + WS_WMIX); bf16* WO = (bf16*)(ws + WS_WMIX + 26 * MiB);
    const int kind = l % 3, j = l / 3;
    if (kind == 0) {
        const float* win = a.in[I_MLWIN] + (size_t)j * DM * ML_INCOLS;
        if (i8mix) { const unsigned* cm = (const unsigned*)(ws + WS_CTL) + CW_CMAX2 + 6400 * l; float* cs = (float*)(ws + WS_CSTEP2) + 6400 * l;
            conv_T_i8<0>(F, win, DM, 6144, ML_INCOLS, (unsigned char*)WA, cm, cs);
            conv_small_i8(F, win, ML_INCOLS, 6144, DM, 16, (unsigned char*)WA + (size_t)6144 * DM, 256, cm, cs); }
        else { conv_T<0>(F, win, DM, 6144, ML_INCOLS, WA, 0);
        conv_small(F, win, ML_INCOLS, 6144, DM, 16, WA + (size_t)6144 * DM, 256, DM); }
        conv_T<0>(F, a.in[I_MLWOUT] + (size_t)j * DM * DM, DM, DM, DM, WO, 0);
    } else if (kind == 1) {
        if (i8mix) conv_T_i8<0>(F, a.in[I_ATQKV] + (size_t)j * DM * AT_COLS, DM, AT_COLS, AT_COLS, (unsigned char*)WA, (const unsigned*)(ws + WS_CTL) + CW_CMAX2 + 6400 * l, (float*)(ws + WS_CSTEP2) + 6400 * l);
        else conv_T<0>(F, a.in[I_ATQKV] + (size_t)j * DM * AT_COLS, DM, AT_COLS, AT_COLS, WA, 0);
        conv_T<0>(F, a.in[I_ATWO] + (size_t)j * DM * DM, DM, DM, DM, WO, 0);
    } else {
        for (int z = 0; z < 3; ++z) conv_T<0>(F, a.in[I_RWRKV] + ((size_t)j * 3 + z) * DM * DM, DM, DM, DM, WA, z * DM);
        bf16* WLA = WA + (size_t)6144 * DM;
        conv_small(F, a.in[I_RWWLA] + (size_t)j * DM * 96, 96, 0, DM, 96, WLA, 256, DM);
        conv_small(F, a.in[I_RWALA] + (size_t)j * DM * 96, 96, 0, DM, 96, WLA + (size_t)256 * DM, 256, DM);
        conv_small(F, a.in[I_RWGLA] + (size_t)j * DM * 256, 256, 0, DM, 256, WLA + (size_t)512 * DM, 256, DM);
        bf16* WLB = (bf16*)(ws + WS_WMIX + 28 * MiB);
        conv_small(F, a.in[I_RWWLB] + (size_t)j * 96 * DM, DM, 0, 96, DM, WLB, DM, 256);
        conv_small(F, a.in[I_RWALB] + (size_t)j * 96 * DM, DM, 0, 96, DM, WLB + (size_t)DM * 256, DM, 256);
        conv_small(F, a.in[I_RWGLB] + (size_t)j * 256 * DM, DM, 0, 256, DM, WLB + (size_t)2 * DM * 256, DM, 256);
        conv_T<0>(F, a.in[I_RWWO] + (size_t)j * DM * DM, DM, DM, DM, (bf16*)(ws + WS_WMIX + 32 * MiB), 0);
    }
}

template <bool SB> __device__ __forceinline__ void load_row(const void* xin, size_t row, int lane, f32x4 (&v)[8]) {
    if (SB) { typedef _Float16 h16x4_t __attribute__((ext_vector_type(4))); const h16x4_t* xr = (const h16x4_t*)((const bf16*)xin + row * DM) + lane;
#pragma unroll
        for (int q = 0; q < 8; ++q) { const h16x4_t w = xr[64 * q]; v[q] = (f32x4){(float)w[0], (float)w[1], (float)w[2], (float)w[3]}; } }
    else { const f32x4* xr = (const f32x4*)((const float*)xin + row * DM) + lane;
#pragma unroll
        for (int q = 0; q < 8; ++q) v[q] = xr[64 * q]; }
}
template <int MODE, bool SB, int F8 = 0, class AT_>
__device__ __forceinline__ void norm_phase(const AT_& a, Frame& F, const void* xin, const float* gain, int j) {
    unsigned char* ws = a.ws; const int lane = F.lane;
    const int gw = F.bid * NWAVES + F.wave, NGW = F.G * NWAVES;
    f32x4 gn[8];
#pragma unroll
    for (int q = 0; q < 8; ++q) gn[q] = *(const f32x4*)(gain + 4 * lane + 256 * q);
    if (MODE != 2) {
        bf16* xn = (bf16*)(ws + WS_XN);
        for (int row = gw; row < MTOK; row += NGW) {
            f32x4 v[8]; float ss = 0.f; load_row<SB>(xin, (size_t)row, lane, v);
#pragma unroll
            for (int q = 0; q < 8; ++q) ss += (v[q].x * v[q].x + v[q].y * v[q].y) + (v[q].z * v[q].z + v[q].w * v[q].w);
            const float rstd = 1.0f / sqrtf(wave_sum(ss) * (1.0f / DM) + NORM_EPS);
            if (F8 == 2) { unsigned* o4 = (unsigned*)((unsigned char*)xn + (size_t)row * DM) + lane; float mx = 0.f;
#pragma unroll
                for (int q = 0; q < 8; ++q) { v[q] = v[q] * rstd * gn[q]; mx = fmaxf(fmaxf(mx, fmaxf(fabsf(v[q].x), fabsf(v[q].y))), fmaxf(fabsf(v[q].z), fabsf(v[q].w))); }
                mx = fmaxf(wave_max(mx), 1e-30f); const float qs = 127.0f / mx;
#pragma unroll
                for (int q = 0; q < 8; ++q) o4[64 * q] = pack_i8x4(v[q].x * qs, v[q].y * qs, v[q].z * qs, v[q].w * qs);
                if (lane == 0) ((float*)(ws + WS_ROWQ))[row] = mx * (1.0f / 127.0f); }
            else if (F8 == 1) { unsigned* o4 = (unsigned*)((unsigned char*)xn + (size_t)row * DM) + lane;
#pragma unroll
                for (int q = 0; q < 8; ++q) { const f32x4 y = v[q] * (rstd * pg8::X8_SCALE) * gn[q]; unsigned w = 0u;
                    w = __builtin_amdgcn_cvt_pk_fp8_f32(__builtin_amdgcn_fmed3f(y.x, -448.f, 448.f), __builtin_amdgcn_fmed3f(y.y, -448.f, 448.f), w, false);
                    w = __builtin_amdgcn_cvt_pk_fp8_f32(__builtin_amdgcn_fmed3f(y.z, -448.f, 448.f), __builtin_amdgcn_fmed3f(y.w, -448.f, 448.f), w, true); o4[64 * q] = w; } }
            else { v2u* o8 = (v2u*)(xn + (size_t)row * DM) + lane;
#pragma unroll
                for (int q = 0; q < 8; ++q) { const f32x4 y = v[q] * rstd * gn[q]; v2u w; w.x = pk2(y.x, y.y); w.y = pk2(y.z, y.w); o8[64 * q] = w; } }
            if (MODE == 1 && lane < 8) {
                const int pos = ((const int*)a.in[I_POS])[row];
                const float inv_freq = powf(500000.0f, -(float)(2 * lane) / 16.0f); const float ang = (float)pos * inv_freq;
                const double rev = (double)ang * 0.15915494309189535; const float fr = (float)(rev - floor(rev));
                float* rp = (float*)(ws + WS_ROPE) + (size_t)row * 16; rp[lane] = __builtin_amdgcn_cosf(fr); rp[8 + lane] = __builtin_amdgcn_sinf(fr);
            }
        }
    } else {
        LAS float* mixs = (LAS float*)F.lds; const float* mix = a.in[I_RWMIX] + (size_t)j * 6 * DM;
        for (int i = F.tid; i < 6 * DM; i += NTHREADS) mixs[i] = mix[i];
        __syncthreads();
        bf16* xm = (bf16*)(ws + WS_BIG);
        for (int blk = gw; blk < MTOK / 16; blk += NGW) {
            const int row0 = blk * 16; f32x4 prev[8];
            if ((row0 % SEQ) == 0) {
#pragma unroll
                for (int q = 0; q < 8; ++q) prev[q] = (f32x4){0.f, 0.f, 0.f, 0.f};
            } else {
                float ss = 0.f; load_row<SB>(xin, (size_t)(row0 - 1), lane, prev);
#pragma unroll
                for (int q = 0; q < 8; ++q) ss += (prev[q].x * prev[q].x + prev[q].y * prev[q].y) + (prev[q].z * prev[q].z + prev[q].w * prev[q].w);
                const float rstd = 1.0f / sqrtf(wave_sum(ss) * (1.0f / DM) + NORM_EPS);
#pragma unroll
                for (int q = 0; q < 8; ++q) prev[q] = prev[q] * rstd * gn[q];
            }
            for (int rr = 0; rr < 16; ++rr) {
                const int row = row0 + rr; f32x4 v[8]; float ss = 0.f; load_row<SB>(xin, (size_t)row, lane, v);
#pragma unroll
                for (int q = 0; q < 8; ++q) ss += (v[q].x * v[q].x + v[q].y * v[q].y) + (v[q].z * v[q].z + v[q].w * v[q].w);
                const float rstd = 1.0f / sqrtf(wave_sum(ss) * (1.0f / DM) + NORM_EPS);
#pragma unroll
                for (int q = 0; q < 8; ++q) v[q] = v[q] * rstd * gn[q];
#pragma unroll 1
                for (int z = 0; z < 6; ++z) { v2u* o8 = (v2u*)(xm + ((size_t)z * MTOK + row) * DM) + lane;
#pragma unroll
                    for (int q = 0; q < 8; ++q) { const f32x4 mx = *(const LAS f32x4*)(mixs + z * DM + 4 * lane + 256 * q); const f32x4 y = v[q] + (prev[q] - v[q]) * mx;
                        v2u w; w.x = pk2(y.x, y.y); w.y = pk2(y.z, y.w); o8[64 * q] = w; } }
#pragma unroll
                for (int q = 0; q < 8; ++q) prev[q] = v[q];
            }
        }
    }
}
__device__ __forceinline__ float log_sigmoid(float x) { return fminf(x, 0.f) - __logf(1.0f + __expf(-fabsf(x))); }
__device__ __forceinline__ float wave_incl_scan(float v, int lane) {
#pragma unroll
    for (int o = 1; o < 64; o <<= 1) { const float n = __shfl_up(v, o); if (lane >= o) v += n; }
    return v;
}
#define WG_BAR() do { asm volatile("s_waitcnt lgkmcnt(0)" ::: "memory"); __builtin_amdgcn_s_barrier(); asm volatile("" ::: "memory"); } while (0)
template <class AT_>
__device__ __forceinline__ void mlstm_phase_ab(const AT_& a, Frame& F, int j) {
    unsigned char* ws = a.ws; const int tid = F.tid, lane = F.lane, w = F.wave, r = lane & 31, hh = lane >> 5;
    const bf16* QKVO = (const bf16*)(ws + WS_BIG); const float* GT = (const float*)(ws + WS_GATES);
    bf16* UC = (bf16*)(ws + WS_BIG + 384 * MiB); float* NV = (float*)(ws + WS_NV); float* MST = (float*)(ws + WS_MST);
    const float* bg = a.in[I_MLBG] + j * 16;
    LAS bf16* Vwt = (LAS bf16*)F.lds; LAS bf16* Kt = (LAS bf16*)(F.lds + 9216);
    LAS float* WQ = (LAS float*)(F.lds + 65536); LAS float* GS = (LAS float*)(F.lds + 65536 + 16384);
    const float kscale = 0.08838834764831845f;
    const int vb = w & 1, kb = w >> 1;
    for (int u = F.bid; u < NBATCH * ML_H * 4; u += F.G) {
        const int qd = (u >> 3) & 3, bh = (u & 7) + 8 * (u >> 5), b = bh >> 3, h = bh & 7;
        const float bgi = bg[h], bgf = bg[8 + h];
        v4u xvA, xvB, xvC, xvD, xkA0, xkA1, xkB0, xkB1, xkC0, xkC1, xkD0, xkD1;
#define MLAB_LOAD(CC, XV, XK0, XK1) do { const bf16* rowp = QKVO + (size_t)(b * SEQ + (CC) * ML_L + lane) * 6144; \
            XV = *(const v4u*)(rowp + 2048 + h * 256 + 64 * qd + 8 * w); XK0 = *(const v4u*)(rowp + 1024 + h * 128 + 8 * w); XK1 = *(const v4u*)(rowp + 1024 + h * 128 + 8 * (w + 8)); } while (0)
        MLAB_LOAD(0, xvA, xkA0, xkA1); MLAB_LOAD(1, xvB, xkB0, xkB1); MLAB_LOAD(2, xvC, xkC0, xkC1); MLAB_LOAD(3, xvD, xkD0, xkD1);
#pragma unroll
        for (int k = 0; k < 8; ++k) { const int cc = 8 * w + k; const size_t t = (size_t)(b * SEQ + cc * ML_L + lane) * 16;
            const float li = GT[t + h] + bgi; const float lf = log_sigmoid(GT[t + 8 + h] + bgf);
            const float bs = wave_incl_scan(lf, lane); const float g = __shfl(bs, 63); const float lw = g - bs + li; const float am = wave_max(lw);
            WQ[cc * 64 + lane] = __expf(lw - am);
            if (qd == 0) { float* blg = (float*)(ws + 12 * MiB); blg[t + h] = bs; blg[t + 8 + h] = li - bs; }
            if (lane == 0) { GS[2 * cc] = g; GS[2 * cc + 1] = am; } }
        f32x16 Cst; float m = 0.f, nn = 0.f;
#pragma unroll
        for (int i = 0; i < 16; ++i) Cst[i] = 0.f;
        WG_BAR();
#define MLAB_CHUNK(CC, XV, XK0, XK1) do { const int c_ = (CC), it = bh * ML_NC + c_; LAS bf16* Vw = Vwt + (c_ & 1) * 14336; LAS bf16* Kk = Kt + (c_ & 1) * 14336; const LAS float* wqc = WQ + c_ * 64; \
            {   const float wsv = wqc[lane];        \
                _Pragma("unroll") for (int e = 0; e < 4; ++e) { const unsigned wd = XV[e]; Vw[(8 * w + 2 * e) * 72 + lane] = f2bf(bflo(wd) * wsv); Vw[(8 * w + 2 * e + 1) * 72 + lane] = f2bf(bfhi(wd) * wsv); } \
                _Pragma("unroll") for (int e = 0; e < 4; ++e) { const unsigned wd = XK0[e]; Kk[(8 * w + 2 * e) * 72 + lane] = f2bf(bflo(wd) * kscale); Kk[(8 * w + 2 * e + 1) * 72 + lane] = f2bf(bfhi(wd) * kscale); } \
                _Pragma("unroll") for (int e = 0; e < 4; ++e) { const unsigned wd = XK1[e]; Kk[(8 * (w + 8) + 2 * e) * 72 + lane] = f2bf(bflo(wd) * kscale); Kk[(8 * (w + 8) + 2 * e + 1) * 72 + lane] = f2bf(bfhi(wd) * kscale); } } \
            WG_BAR(); \
            if (c_ + 4 < ML_NC) MLAB_LOAD(c_ + 4, XV, XK0, XK1); \
            const float g = GS[2 * c_], am = GS[2 * c_ + 1]; \
            float uu = 0.f; \
            if (tid < 128) { \
                _Pragma("unroll") for (int s8 = 0; s8 < 8; ++s8) { const v4u kk = *(const LAS v4u*)(Kk + tid * 72 + 8 * s8); const f32x4 wa = *(const LAS f32x4*)(wqc + 8 * s8), wb = *(const LAS f32x4*)(wqc + 8 * s8 + 4); \
                    uu += (bflo(kk.x) * wa.x + bfhi(kk.x) * wa.y) + (bflo(kk.y) * wa.z + bfhi(kk.y) * wa.w) + (bflo(kk.z) * wb.x + bfhi(kk.z) * wb.y) + (bflo(kk.w) * wb.z + bfhi(kk.w) * wb.w); } } \
            f32x16 acc; \
            _Pragma("unroll") for (int i = 0; i < 16; ++i) acc[i] = 0.f; \
            _Pragma("unroll") for (int ks = 0; ks < 4; ++ks) { const bf16x8 af = *(const LAS bf16x8*)(Vw + (32 * vb + r) * 72 + 16 * ks + 8 * hh); const bf16x8 bfr = *(const LAS bf16x8*)(Kk + (32 * kb + r) * 72 + 16 * ks + 8 * hh); \
                acc = MFMA32(bfr, af, acc); }        \
            bf16* Uo = UC + (size_t)it * 32768 + (size_t)(64 * qd + 32 * vb + r) * 128 + 32 * kb + 4 * hh;        \
            _Pragma("unroll") for (int g4 = 0; g4 < 4; ++g4) { v2u o; o.x = pk2(Cst[4 * g4], Cst[4 * g4 + 1]); o.y = pk2(Cst[4 * g4 + 2], Cst[4 * g4 + 3]); *(v2u*)(Uo + 8 * g4) = o; } \
            if (qd == 0) { if (tid < 128) NV[(size_t)it * 128 + tid] = nn; if (tid == 0) MST[it] = m; } \
            const float mn = fmaxf(g + m, am), dec = __expf(g + m - mn), sc = __expf(am - mn); \
            _Pragma("unroll") for (int i = 0; i < 16; ++i) Cst[i] = dec * Cst[i] + sc * acc[i]; \
            nn = dec * nn + sc * uu; m = mn; } while (0)
        for (int c = 0; c < ML_NC; c += 4) { MLAB_CHUNK(c, xvA, xkA0, xkA1); MLAB_CHUNK(c + 1, xvB, xkB0, xkB1); MLAB_CHUNK(c + 2, xvC, xkC0, xkC1); MLAB_CHUNK(c + 3, xvD, xkD0, xkD1); }
        WG_BAR();
#undef MLAB_CHUNK
#undef MLAB_LOAD
    }
}
template <class AT_>
__device__ __forceinline__ void mlstm_phase_c(const AT_& a, Frame& F, int j) {
    unsigned char* ws = a.ws; const int tid = F.tid, lane = F.lane, w = F.wave, r = lane & 31, hh = lane >> 5;
    const bf16* QKVO = (const bf16*)(ws + WS_BIG); const float* GT = (const float*)(ws + WS_GATES);
    const bf16* UC = (const bf16*)(ws + WS_BIG + 384 * MiB); const float* NV = (const float*)(ws + WS_NV); const float* MST = (const float*)(ws + WS_MST);
    bf16* HS = (bf16*)(ws + WS_XN);
    const float* bg = a.in[I_MLBG] + j * 16; const float* hgain = a.in[I_MLHG] + (size_t)j * ML_H * ML_DV;
    LAS float* bb = (LAS float*)F.lds; LAS float* lis = bb + 64; LAS float* nvs = bb + 128;
    LAS bf16* Qs = (LAS bf16*)(F.lds + 1024); LAS bf16* Ks = (LAS bf16*)(F.lds + 1024 + 17408); LAS bf16* Vt = (LAS bf16*)(F.lds + 1024 + 34816);
    LAS float* hbuf = (LAS float*)(F.lds + 1024);
    LAS unsigned char* CL = F.lds + 73728;
#define MLC_FRAG(f) ((f) * 1024 + ((f) >= 56 ? 1024 : 0))
    const float kscale = 0.08838834764831845f;
    const int qb2 = w >> 2, dq = w & 3;
    v4u xq[2], xk[2], xv[4]; v2u ogw[8]; float gli = 0.f, glf = 0.f, nv_r = 0.f, mst_r = 0.f;
#define MLC_LOAD_X(IT) do { const int it_ = (IT), h_ = (it_ >> 6) & 7, t0_ = (it_ >> 9) * SEQ + (it_ & 63) * ML_L; \
        _Pragma("unroll") for (int i = 0; i < 2; ++i) { const int q = tid + 512 * i, s = q >> 4, c8 = q & 15; const bf16* rowp = QKVO + (size_t)(t0_ + s) * 6144 + h_ * 128 + 8 * c8; xq[i] = *(const v4u*)rowp; xk[i] = *(const v4u*)(rowp + 1024); } \
        { const bf16* rowp = QKVO + (size_t)(t0_ + lane) * 6144 + 2048 + h_ * 256; _Pragma("unroll") for (int i = 0; i < 4; ++i) xv[i] = *(const v4u*)(rowp + 8 * (w + 8 * i)); } \
        if (w == 0) { const float* blg = (const float*)(ws + 12 * MiB); gli = blg[(size_t)(t0_ + lane) * 16 + h_]; glf = blg[(size_t)(t0_ + lane) * 16 + 8 + h_]; } \
        if (tid < 128) nv_r = NV[(size_t)it_ * 128 + tid]; \
        mst_r = MST[it_]; } while (0)
#define MLC_LOAD_C(IT) do { const bf16* Cg = UC + (size_t)(IT) * 32768;        \
        _Pragma("unroll") for (int s4 = 0; s4 < 4; ++s4) _Pragma("unroll") for (int db = 0; db < 2; ++db) { const int s = 4 * qb2 + s4; \
            __builtin_amdgcn_global_load_lds((const unsigned*)(Cg + (64 * dq + 32 * db + r) * 128 + 16 * s + 8 * hh), (LAS unsigned*)(CL + MLC_FRAG((dq * 8 + s) * 2 + db)), 16, 0, 0); } } while (0)
#define MLC_LOAD_O(IT) do { const int it_ = (IT), h_ = (it_ >> 6) & 7, t0_ = (it_ >> 9) * SEQ + (it_ & 63) * ML_L; \
        _Pragma("unroll") for (int i = 0; i < 8; ++i) ogw[i] = *(const v2u*)(QKVO + (size_t)(t0_ + 8 * w + i) * 6144 + 4096 + h_ * 256 + 4 * lane); } while (0)
    if (F.bid < ML_ITEMS) { MLC_LOAD_X(F.bid); MLC_LOAD_C(F.bid); MLC_LOAD_O(F.bid); }
    for (int it = F.bid; it < ML_ITEMS; it += F.G) {
        const int b = it >> 9, h = (it >> 6) & 7, c = it & 63, tok0 = b * SEQ + c * ML_L; const int nit = it + F.G; const bool has = nit < ML_ITEMS;
        if (w == 0) { bb[lane] = gli; lis[lane] = glf; }
        if (tid < 128) nvs[tid] = nv_r;
#pragma unroll
        for (int i = 0; i < 2; ++i) { const int q = tid + 512 * i, s = q >> 4, c8 = q & 15;
            *(LAS v4u*)(Qs + s * 136 + 8 * c8) = xq[i];
            const v4u x = xk[i]; v4u y;
#pragma unroll
            for (int e = 0; e < 4; ++e) y[e] = pk2(bflo(x[e]) * kscale, bfhi(x[e]) * kscale);
            *(LAS v4u*)(Ks + s * 136 + 8 * c8) = y; }
        {
#pragma unroll
            for (int i = 0; i < 4; ++i) { const int c8 = w + 8 * i; const v4u x = xv[i];
#pragma unroll
                for (int e = 0; e < 4; ++e) { Vt[(8 * c8 + 2 * e) * 72 + lane] = (bf16)(x[e] & 0xffffu); Vt[(8 * c8 + 2 * e + 1) * 72 + lane] = (bf16)(x[e] >> 16); } } }
        const float mst = mst_r;
        asm volatile("s_waitcnt vmcnt(0) lgkmcnt(0)" ::: "memory"); __builtin_amdgcn_s_barrier(); asm volatile("" ::: "memory");
        if (has) MLC_LOAD_X(nit);
        const int t = 32 * qb2 + r; const float bt = bb[t];
        bf16x8 Qf[8]; f32x4 blv[2][4];
#pragma unroll
        for (int s = 0; s < 8; ++s) Qf[s] = *(const LAS bf16x8*)(Qs + t * 136 + 16 * s + 8 * hh);
#pragma unroll
        for (int kb = 0; kb < 2; ++kb) if (kb <= qb2) {
#pragma unroll
            for (int g = 0; g < 4; ++g) blv[kb][g] = *(const LAS f32x4*)(lis + 32 * kb + 8 * g + 4 * hh); }
        f32x16 accs[2];
#pragma unroll
        for (int kb = 0; kb < 2; ++kb)
#pragma unroll
            for (int i = 0; i < 16; ++i) accs[kb][i] = 0.f;
#pragma unroll
        for (int kb = 0; kb < 2; ++kb) if (kb <= qb2) { bf16x8 kf[8];
#pragma unroll
            for (int s = 0; s < 8; ++s) kf[s] = *(const LAS bf16x8*)(Ks + (32 * kb + r) * 136 + 16 * s + 8 * hh);
            asm volatile("" : "+v"(kf[0]), "+v"(kf[1]), "+v"(kf[2]), "+v"(kf[3]), "+v"(kf[4]), "+v"(kf[5]), "+v"(kf[6]), "+v"(kf[7]));
#pragma unroll
            for (int s = 0; s < 8; ++s) accs[kb] = MFMA32(kf[s], Qf[s], accs[kb]); }
        float mi = -INFINITY;
#pragma unroll
        for (int kb = 0; kb < 2; ++kb) if (kb <= qb2) {
#pragma unroll
            for (int i = 0; i < 16; ++i) { const int sp = 32 * kb + crow(i, hh); const float ld = bt + blv[kb][i >> 2][i & 3]; mi = fmaxf(mi, sp <= t ? ld : -INFINITY); } }
        mi = fmaxf(mi, __shfl_xor(mi, 32));
        const float mout = fmaxf(bt + mst, mi); float den = 0.f;
#pragma unroll
        for (int kb = 0; kb < 2; ++kb) if (kb <= qb2) {
#pragma unroll
            for (int i = 0; i < 16; ++i) { const int sp = 32 * kb + crow(i, hh); const float ex = __expf(bt + blv[kb][i >> 2][i & 3] - mout); const float d = (sp <= t) ? ex : 0.f; const float sv = accs[kb][i] * d; accs[kb][i] = sv; den += sv; } }
        den += __shfl_xor(den, 32);
        const float winter = __expf(bt + mst - mout);
        f32x16 accn[2];
#pragma unroll
        for (int db = 0; db < 2; ++db)
#pragma unroll
            for (int i = 0; i < 16; ++i) accn[db][i] = 0.f;
#pragma unroll
        for (int s = 0; s < 8; ++s)
#pragma unroll
            for (int db = 0; db < 2; ++db) accn[db] = MFMA32(*(const LAS bf16x8*)(CL + MLC_FRAG((dq * 8 + s) * 2 + db) + lane * 16), Qf[s], accn[db]);
#pragma unroll
        for (int db = 0; db < 2; ++db)
#pragma unroll
            for (int i = 0; i < 16; ++i) accn[db][i] *= winter;
#pragma unroll
        for (int kb = 0; kb < 2; ++kb) if (kb <= qb2) {
#pragma unroll
            for (int s2 = 0; s2 < 2; ++s2) {
                v4u pw;
#pragma unroll
                for (int e = 0; e < 4; ++e) pw[e] = pk2(accs[kb][8 * s2 + 2 * e], accs[kb][8 * s2 + 2 * e + 1]);
                const bf16x8 pf = __builtin_bit_cast(bf16x8, pw);
#pragma unroll
                for (int db = 0; db < 2; ++db) { const LAS bf16* vp = Vt + (64 * dq + 32 * db + r) * 72 + 32 * kb + 16 * s2 + 4 * hh;
                    const v2u lo = *(const LAS v2u*)vp, hi = *(const LAS v2u*)(vp + 8); v4u vw; vw.x = lo.x; vw.y = lo.y; vw.z = hi.x; vw.w = hi.y;
                    accn[db] = MFMA32(__builtin_bit_cast(bf16x8, vw), pf, accn[db]); } } }
        float dn = 0.f;
#pragma unroll
        for (int s0 = 0; s0 < 8; s0 += 4) { f32x4 nva[4], nvb[4];
#pragma unroll
            for (int s = 0; s < 4; ++s) { nva[s] = *(const LAS f32x4*)(nvs + 16 * (s0 + s) + 8 * hh); nvb[s] = *(const LAS f32x4*)(nvs + 16 * (s0 + s) + 8 * hh + 4); }
#pragma unroll
            for (int s = 0; s < 4; ++s) { const v4u qw = __builtin_bit_cast(v4u, Qf[s0 + s]);
                dn += (bflo(qw[0]) * nva[s].x + bfhi(qw[0]) * nva[s].y) + (bflo(qw[1]) * nva[s].z + bfhi(qw[1]) * nva[s].w) + (bflo(qw[2]) * nvb[s].x + bfhi(qw[2]) * nvb[s].y) + (bflo(qw[3]) * nvb[s].z + bfhi(qw[3]) * nvb[s].w); } }
        dn += __shfl_xor(dn, 32);
        den += winter * dn;
        const float inv = 1.0f / fmaxf(fabsf(den), __expf(-mout));
        WG_BAR();
        if (has) MLC_LOAD_C(nit);
#pragma unroll
        for (int db = 0; db < 2; ++db)
#pragma unroll
            for (int g4 = 0; g4 < 4; ++g4) { f32x4 o; o.x = accn[db][4 * g4] * inv; o.y = accn[db][4 * g4 + 1] * inv; o.z = accn[db][4 * g4 + 2] * inv; o.w = accn[db][4 * g4 + 3] * inv;
                *(LAS f32x4*)(hbuf + t * 260 + 64 * dq + 32 * db + 8 * g4 + 4 * hh) = o; }
        WG_BAR();
        const f32x4 gn = *(const f32x4*)(hgain + h * ML_DV + 4 * lane);
#pragma unroll
        for (int i = 0; i < 8; ++i) { const int tt = 8 * w + i; const f32x4 v = *(const LAS f32x4*)(hbuf + tt * 260 + 4 * lane);
            const float ss = wave_sum((v.x * v.x + v.y * v.y) + (v.z * v.z + v.w * v.w)); const float rstd = 1.0f / sqrtf(ss * (1.0f / ML_DV) + NORM_EPS);
            const v2u ow = ogw[i];
            f32x4 y = v * rstd * gn; y.x *= pg8::fast_sigmoid(bflo(ow.x)); y.y *= pg8::fast_sigmoid(bfhi(ow.x)); y.z *= pg8::fast_sigmoid(bflo(ow.y)); y.w *= pg8::fast_sigmoid(bfhi(ow.y));
            v2u o; o.x = pk2(y.x, y.y); o.y = pk2(y.z, y.w);
            *(v2u*)(HS + (size_t)(tok0 + tt) * DM + h * 256 + 4 * lane) = o; }
        if (has) MLC_LOAD_O(nit);
        WG_BAR();
    }
#undef MLC_LOAD_X
#undef MLC_LOAD_C
#undef MLC_FRAG
#undef MLC_LOAD_O
}
template <class AT_>
__device__ __forceinline__ void attn_phase(const AT_& a, Frame& F, int j) {
    unsigned char* ws = a.ws; const int tid = F.tid, lane = F.lane, w = F.wave, r = lane & 31, hh = lane >> 5;
    const bf16* QKV = (const bf16*)(ws + WS_BIG); const float* ROPE = (const float*)(ws + WS_ROPE); bf16* O = (bf16*)(ws + WS_XN);
    const float* qg = a.in[I_ATQG] + j * 64; const float* kg = a.in[I_ATKG] + j * 64; const float* sinks = a.in[I_ATSINK] + j * 32;
    LAS bf16* Ks = (LAS bf16*)F.lds; LAS bf16* Vt = (LAS bf16*)(F.lds + 36864);
    for (int u = F.bid; u < AT_UNITS; u += F.G) {
        const int b = u >> 7, qb = (u >> 2) & 31, hk = u & 3, tok0 = b * SEQ + qb * AT_BLK, kt0 = tok0 - AT_BLK;
        if (tid < 256) {
            const int J = tid; const bool valid = (qb > 0) || (J >= AT_BLK);
            float v[64];
            if (valid) {
                const v4u* rp = (const v4u*)(QKV + (size_t)(kt0 + J) * AT_COLS + 2048 + hk * 64); float ss = 0.f;
#pragma unroll
                for (int q = 0; q < 8; ++q) { const v4u x = rp[q];
#pragma unroll
                    for (int e = 0; e < 4; ++e) { v[8 * q + 2 * e] = bflo(x[e]); v[8 * q + 2 * e + 1] = bfhi(x[e]); } }
#pragma unroll
                for (int d = 0; d < 64; ++d) ss += v[d] * v[d];
                const float rstd = 1.0f / sqrtf(ss * (1.0f / 64.0f) + NORM_EPS);
#pragma unroll
                for (int d = 0; d < 64; ++d) v[d] = v[d] * rstd * kg[d];
                const float* rp2 = ROPE + (size_t)(kt0 + J) * 16;
#pragma unroll
                for (int i = 0; i < 8; ++i) { const float cs = rp2[i], sn = rp2[8 + i], x1 = v[i], x2 = v[8 + i]; v[i] = x1 * cs - x2 * sn; v[8 + i] = x2 * cs + x1 * sn; }
            } else {
#pragma unroll
                for (int d = 0; d < 64; ++d) v[d] = 0.f;
            }
#pragma unroll
            for (int q = 0; q < 8; ++q) { v4u y;
#pragma unroll
                for (int e = 0; e < 4; ++e) y[e] = pk2(v[8 * q + 2 * e], v[8 * q + 2 * e + 1]);
                *(LAS v4u*)(Ks + J * 72 + 8 * q) = y; }
        } else {
            const int J = tid - 256; const bool valid = (qb > 0) || (J >= AT_BLK);
            const v4u* rp = (const v4u*)(QKV + (size_t)(valid ? kt0 + J : tok0) * AT_COLS + 2304 + hk * 64);
            v4u xr[8];
#pragma unroll
            for (int q = 0; q < 8; ++q) xr[q] = rp[q];
#pragma unroll
            for (int q = 0; q < 8; ++q) { const v4u x = valid ? xr[q] : (v4u){0u, 0u, 0u, 0u};
#pragma unroll
                for (int e = 0; e < 4; ++e) { Vt[(8 * q + 2 * e) * 264 + J] = (bf16)(x[e] & 0xffffu); Vt[(8 * q + 2 * e + 1) * 264 + J] = (bf16)(x[e] >> 16); } }
        }
        __syncthreads();
        const int hq = hk * 8 + w; const float sink = sinks[hq];
        for (int qi = 0; qi < 4; ++qi) {
            const int I = 32 * qi + r, tq = tok0 + I;
            float qv[4][8]; float ss = 0.f;
#pragma unroll
            for (int s = 0; s < 4; ++s) { const v4u x = *(const v4u*)(QKV + (size_t)tq * AT_COLS + hq * 64 + 16 * s + 8 * hh);
#pragma unroll
                for (int e = 0; e < 4; ++e) { qv[s][2 * e] = bflo(x[e]); qv[s][2 * e + 1] = bfhi(x[e]); } }
#pragma unroll
            for (int s = 0; s < 4; ++s)
#pragma unroll
                for (int e = 0; e < 8; ++e) ss += qv[s][e] * qv[s][e];
            ss += __shfl_xor(ss, 32);
            const float rstd = 0.125f / sqrtf(ss * (1.0f / 64.0f) + NORM_EPS);
#pragma unroll
            for (int s = 0; s < 4; ++s)
#pragma unroll
                for (int e = 0; e < 8; ++e) qv[s][e] = qv[s][e] * rstd * qg[16 * s + 8 * hh + e];
            {   const float* rp2 = ROPE + (size_t)tq * 16;
#pragma unroll
                for (int e = 0; e < 8; ++e) { const float mine = qv[0][e], other = __shfl_xor(mine, 32), cs = rp2[e], sn = rp2[8 + e];
                    qv[0][e] = (hh == 0) ? (mine * cs - other * sn) : (mine * cs + other * sn); } }
            bf16x8 Qf[4];
#pragma unroll
            for (int s = 0; s < 4; ++s) { v4u y;
#pragma unroll
                for (int e = 0; e < 4; ++e) y[e] = pk2(qv[s][2 * e], qv[s][2 * e + 1]);
                Qf[s] = __builtin_bit_cast(bf16x8, y); }
            f32x16 accs[5];
#pragma unroll
            for (int c = 0; c < 5; ++c) {
#pragma unroll
                for (int i = 0; i < 16; ++i) accs[c][i] = 0.f;
                const int kj = qi + c;
#pragma unroll
                for (int s = 0; s < 4; ++s) { const bf16x8 kf = *(const LAS bf16x8*)(Ks + (32 * kj + r) * 72 + 16 * s + 8 * hh); accs[c] = MFMA32(kf, Qf[s], accs[c]); } }
            float mx = sink;
#pragma unroll
            for (int c = 0; c < 5; ++c)
#pragma unroll
                for (int i = 0; i < 16; ++i) { const int J = 32 * (qi + c) + crow(i, hh); const bool ok = (J > I) && (J <= I + AT_BLK) && (qb > 0 || J >= AT_BLK); if (ok) mx = fmaxf(mx, accs[c][i]); }
            mx = fmaxf(mx, __shfl_xor(mx, 32));
            float sum = 0.f;
#pragma unroll
            for (int c = 0; c < 5; ++c)
#pragma unroll
                for (int i = 0; i < 16; ++i) { const int J = 32 * (qi + c) + crow(i, hh); const bool ok = (J > I) && (J <= I + AT_BLK) && (qb > 0 || J >= AT_BLK);
                    const float p = ok ? __expf(accs[c][i] - mx) : 0.f; accs[c][i] = p; sum += p; }
            sum += __shfl_xor(sum, 32);
            const float inv = 1.0f / (sum + __expf(sink - mx));
            f32x16 acco[2];
#pragma unroll
            for (int db = 0; db < 2; ++db)
#pragma unroll
                for (int i = 0; i < 16; ++i) acco[db][i] = 0.f;
#pragma unroll
            for (int c = 0; c < 5; ++c)
#pragma unroll
                for (int s2 = 0; s2 < 2; ++s2) { v4u pw;
#pragma unroll
                    for (int e = 0; e < 4; ++e) pw[e] = pk2(accs[c][8 * s2 + 2 * e], accs[c][8 * s2 + 2 * e + 1]);
                    const bf16x8 pf = __builtin_bit_cast(bf16x8, pw);
#pragma unroll
                    for (int db = 0; db < 2; ++db) { const LAS bf16* vp = Vt + (32 * db + r) * 264 + 32 * (qi + c) + 16 * s2 + 4 * hh;
                        const v2u lo = *(const LAS v2u*)vp, hi = *(const LAS v2u*)(vp + 8); v4u vw; vw.x = lo.x; vw.y = lo.y; vw.z = hi.x; vw.w = hi.y;
                        acco[db] = MFMA32(__builtin_bit_cast(bf16x8, vw), pf, acco[db]); } }
            bf16* orow = O + (size_t)tq * DM + hq * 64;
#pragma unroll
            for (int db = 0; db < 2; ++db)
#pragma unroll
                for (int g4 = 0; g4 < 4; ++g4) { v2u o; o.x = pk2(acco[db][4 * g4] * inv, acco[db][4 * g4 + 1] * inv); o.y = pk2(acco[db][4 * g4 + 2] * inv, acco[db][4 * g4 + 3] * inv);
                    *(v2u*)(orow + 32 * db + 8 * g4 + 4 * hh) = o; }
        }
        __syncthreads();
    }
}

template <int CTRL> __device__ __forceinline__ float dpp_f(float x) { return __builtin_bit_cast(float, __builtin_amdgcn_mov_dpp(__builtin_bit_cast(int, x), CTRL, 0xf, 0xf, true)); }
__device__ __forceinline__ float row8_allsum(float x) { x += dpp_f<0xB1>(x); x += dpp_f<0x4E>(x); x += dpp_f<0x141>(x); return x; }
struct RwOps { f32x4 a0, a1, r0, r1, w0, w1, b0, b1, k0, k1; f32x2 v, sc; };
template <class AT_>
__device__ __forceinline__ void rwkv_scan_phase(const AT_& a, Frame& F, int j) {
    unsigned char* ws = a.ws; const int lane = F.lane, w = F.wave;
    const bf16* RKV = (const bf16*)(ws + WS_BIG + 768 * MiB); const float* DEC = (const float*)(ws + WS_BIG);
    const bf16* AG = (const bf16*)(ws + WS_BIG + 256 * MiB); const bf16* GG = (const bf16*)(ws + WS_BIG + 384 * MiB); bf16* YG = (bf16*)(ws + WS_XN);
    const float* k_k = a.in[I_RWKK] + (size_t)j * DM; const float* k_a = a.in[I_RWKA] + (size_t)j * DM; const float* r_k = a.in[I_RWRK] + (size_t)j * DM;
    const float* ln_w = a.in[I_RWLNW] + (size_t)j * DM; const float* ln_b = a.in[I_RWLNB] + (size_t)j * DM;
    constexpr int OPB = 6 * RW_T * 64 * 4 + RW_T * 16;
    LAS float* Ybase = (LAS float*)(F.lds + 2 * OPB);
    const int vg = lane >> 3, kg = lane & 7, v0 = 16 * (w & 3) + 2 * vg;
    for (int bh = F.bid; bh < NBATCH * RW_H; bh += F.G) {
        const int b = bh >> 5, h = bh & 31, col = h * 64 + lane; const size_t tokb = (size_t)b * SEQ;
        const float kkc = k_k[col], kac = k_a[col], rkc = r_k[col], lnw = ln_w[col], lnb = ln_b[col];
        f32x2 S0[4], S1[4];
#pragma unroll
        for (int i = 0; i < 4; ++i) { S0[i] = (f32x2){0.f, 0.f}; S1[i] = (f32x2){0.f, 0.f}; }
        for (int blk = -1; blk <= RW_NBLK; ++blk) {
            if (w < 4) {
                if (blk >= 0 && blk < RW_NBLK) {
                    const LAS float* ob = (const LAS float*)(F.lds + (blk & 1) * OPB); LAS float* Yb = Ybase + (blk & 1) * (RW_T * 64);
                    auto ld = [&](int t) { RwOps o; const LAS float* p = ob + t * 64 + 8 * kg;
                        o.a0 = *(const LAS f32x4*)p; o.a1 = *(const LAS f32x4*)(p + 4); p += RW_T * 64; o.r0 = *(const LAS f32x4*)p; o.r1 = *(const LAS f32x4*)(p + 4); p += RW_T * 64;
                        o.w0 = *(const LAS f32x4*)p; o.w1 = *(const LAS f32x4*)(p + 4); p += RW_T * 64; o.b0 = *(const LAS f32x4*)p; o.b1 = *(const LAS f32x4*)(p + 4); p += RW_T * 64;
                        o.k0 = *(const LAS f32x4*)p; o.k1 = *(const LAS f32x4*)(p + 4);
                        o.v = *(const LAS f32x2*)(ob + 5 * RW_T * 64 + t * 64 + v0); o.sc = *(const LAS f32x2*)(ob + 6 * RW_T * 64 + t * 4); return o; };
                    auto step = [&](const RwOps& cur, int t) {
                        const f32x2 a01 = {cur.a0.x, cur.a0.y}, a23 = {cur.a0.z, cur.a0.w}, a45 = {cur.a1.x, cur.a1.y}, a67 = {cur.a1.z, cur.a1.w};
                        const f32x2 r01 = {cur.r0.x, cur.r0.y}, r23 = {cur.r0.z, cur.r0.w}, r45 = {cur.r1.x, cur.r1.y}, r67 = {cur.r1.z, cur.r1.w};
                        f32x2 sA0 = S0[0] * a01, sA1 = S1[0] * a01, sY0 = S0[0] * r01, sY1 = S1[0] * r01;
                        sA0 = S0[1] * a23 + sA0; sA1 = S1[1] * a23 + sA1; sY0 = S0[1] * r23 + sY0; sY1 = S1[1] * r23 + sY1;
                        sA0 = S0[2] * a45 + sA0; sA1 = S1[2] * a45 + sA1; sY0 = S0[2] * r45 + sY0; sY1 = S1[2] * r45 + sY1;
                        sA0 = S0[3] * a67 + sA0; sA1 = S1[3] * a67 + sA1; sY0 = S0[3] * r67 + sY0; sY1 = S1[3] * r67 + sY1;
                        const float sa0 = row8_allsum(sA0.x + sA0.y), sa1 = row8_allsum(sA1.x + sA1.y), yy0 = row8_allsum(sY0.x + sY0.y), yy1 = row8_allsum(sY1.x + sY1.y);
                        if (kg == 0) { f32x2 yo; yo.x = yy0 + sa0 * cur.sc.x + cur.v.x * cur.sc.y; yo.y = yy1 + sa1 * cur.sc.x + cur.v.y * cur.sc.y; *(LAS f32x2*)(Yb + t * 64 + v0) = yo; }
                        const f32x2 w01 = {cur.w0.x, cur.w0.y}, w23 = {cur.w0.z, cur.w0.w}, w45 = {cur.w1.x, cur.w1.y}, w67 = {cur.w1.z, cur.w1.w};
                        const f32x2 b01 = {cur.b0.x, cur.b0.y}, b23 = {cur.b0.z, cur.b0.w}, b45 = {cur.b1.x, cur.b1.y}, b67 = {cur.b1.z, cur.b1.w};
                        const f32x2 k01 = {cur.k0.x, cur.k0.y}, k23 = {cur.k0.z, cur.k0.w}, k45 = {cur.k1.x, cur.k1.y}, k67 = {cur.k1.z, cur.k1.w};
                        const f32x2 s0 = {sa0, sa0}, s1 = {sa1, sa1}, x0 = {cur.v.x, cur.v.x}, x1 = {cur.v.y, cur.v.y};
                        S0[0] = S0[0] * w01 + (s0 * b01 + x0 * k01); S0[1] = S0[1] * w23 + (s0 * b23 + x0 * k23); S0[2] = S0[2] * w45 + (s0 * b45 + x0 * k45); S0[3] = S0[3] * w67 + (s0 * b67 + x0 * k67);
                        S1[0] = S1[0] * w01 + (s1 * b01 + x1 * k01); S1[1] = S1[1] * w23 + (s1 * b23 + x1 * k23); S1[2] = S1[2] * w45 + (s1 * b45 + x1 * k45); S1[3] = S1[3] * w67 + (s1 * b67 + x1 * k67);
                    };
                    RwOps oa = ld(0);
                    for (int t = 0; t < RW_T; t += 2) {
                        const RwOps ob2 = ld(t + 1);
                        step(oa, t);
                        oa = ld(t + 2 < RW_T ? t + 2 : t + 1);
                        step(ob2, t + 1);
                    }
                }
            } else {
                const int tw = w - 4; const bool do_post = blk >= 1, do_prep = blk + 1 < RW_NBLK;
                float pr[8], pk[8], pv[8], pd[8], pa[8], pg[8];
#pragma unroll
                for (int i = 0; i < 8; ++i) { pr[i] = 0.f; pk[i] = 0.f; pv[i] = 0.f; pd[i] = 0.f; pa[i] = 0.f; pg[i] = 0.f; }
                if (do_prep) {
#pragma unroll
                    for (int i = 0; i < 8; ++i) { const size_t off = (tokb + (size_t)(blk + 1) * RW_T + tw + 4 * i) * DM + col;
                        pr[i] = bf2f(RKV[off]); pk[i] = bf2f(RKV[(size_t)MTOK * DM + off]); pv[i] = bf2f(RKV[(size_t)2 * MTOK * DM + off]); pd[i] = DEC[off]; pa[i] = bf2f(AG[off]); } }
                if (do_post) {
#pragma unroll
                    for (int i = 0; i < 8; ++i) pg[i] = bf2f(GG[(tokb + (size_t)(blk - 1) * RW_T + tw + 4 * i) * DM + col]); }
                if (do_post) {
                    const int pb = blk - 1; const LAS float* ob = (const LAS float*)(F.lds + (pb & 1) * OPB); const LAS float* Yb = Ybase + (pb & 1) * (RW_T * 64);
#pragma unroll
                    for (int i = 0; i < 8; ++i) { const int t = tw + 4 * i; const size_t tok = tokb + (size_t)pb * RW_T + t;
                        const float y = Yb[t * 64 + lane], vv = ob[5 * RW_T * 64 + t * 64 + lane], bon = ob[6 * RW_T * 64 + t * 4 + 2];
                        const float mu = wave_sum_dpp(y) * (1.0f / 64.0f), dlt = y - mu, var = wave_sum_dpp(dlt * dlt) * (1.0f / 64.0f);
                        const float yn = dlt * __builtin_amdgcn_rsqf(var + RW_LN_EPS) * lnw + lnb + bon * vv;
                        YG[tok * DM + col] = f2bf(yn * pg[i]); }
                }
                if (do_prep) {
                    LAS float* ob = (LAS float*)(F.lds + ((blk + 1) & 1) * OPB);
#pragma unroll
                    for (int i = 0; i < 8; ++i) { const int t = tw + 4 * i; const float rr = pr[i], kk0 = pk[i], vv = pv[i];
                        const float dec = __expf(-0.6065306597f * pg8::fast_sigmoid(pd[i])), ag = pg8::fast_sigmoid(pa[i]);
                        float kkv = kk0 * kkc; kkv = kkv * __builtin_amdgcn_rsqf(fmaxf(wave_sum_dpp(kkv * kkv), 1e-24f));
                        const float kp = kk0 * (1.0f + (ag - 1.0f) * kac); const float bv = kkv * ag;
                        ob[t * 64 + lane] = -kkv; ob[RW_T * 64 + t * 64 + lane] = dec * rr; ob[2 * RW_T * 64 + t * 64 + lane] = dec;
                        ob[3 * RW_T * 64 + t * 64 + lane] = bv; ob[4 * RW_T * 64 + t * 64 + lane] = kp; ob[5 * RW_T * 64 + t * 64 + lane] = vv;
                        const float br = wave_sum_dpp(bv * rr), kr = wave_sum_dpp(kp * rr), bon = wave_sum_dpp(rr * kp * rkc);
                        if (lane == 0) { ob[6 * RW_T * 64 + t * 4] = br; ob[6 * RW_T * 64 + t * 4 + 1] = kr; ob[6 * RW_T * 64 + t * 4 + 2] = bon; } }
                }
            }
            __syncthreads();
        }
    }
}
constexpr int RING_BYTES = 131072, MISC_OFF = RING_BYTES + 320, LDS_BYTES = 147456;
#ifndef MK_PER_PHASE
#define MK_PER_PHASE 0
#endif
constexpr int N_PHASES_MAX = 64;
#ifndef REP_CONV
#define REP_CONV 1
#endif
#ifndef REP_NORM
#define REP_NORM 1
#endif
#ifndef REP_GU
#define REP_GU 1
#endif
#ifndef REP_MIXG
#define REP_MIXG 1
#endif
#ifndef REP_MLA
#define REP_MLA 1
#endif
#ifndef REP_MLC
#define REP_MLC 1
#endif
#ifndef REP_ATTN
#define REP_ATTN 1
#endif
#ifndef REP_SCAN
#define REP_SCAN 1
#endif
template <int N> __device__ __forceinline__ int nrep() { if (N == 1) return 1; int v = N; asm volatile("" : "+s"(v)); return v; }
#define PH_REP(N) for (int rep_ = 0, nrep_ = nrep<N>(); rep_ < nrep_; ++rep_)
typedef const __attribute__((address_space(4))) Args CArgs;
__device__ __forceinline__ CArgs* kargs() { CArgs* p = (CArgs*)__builtin_amdgcn_kernarg_segment_ptr(); asm volatile("" : "+s"(p)); return p; }
struct Ctx { XcdBarrier bar; int lo, hi; };
#define PH_BEGIN if (ph >= C.lo && ph < C.hi) { CArgs& a = *kargs(); unsigned char* ws = a.ws; Frame F; { int t_ = threadIdx.x, g_ = gridDim.x, b_ = blockIdx.x; asm volatile("" : "+v"(t_), "+s"(g_), "+s"(b_)); \
                 unsigned lb_ = 0u; asm volatile("" : "+s"(lb_)); F.lds = (LAS unsigned char*)(size_t)lb_ + (size_t)(LAS unsigned char*)lds_raw; F.tid = t_; F.lane = t_ & 63; F.wave = __builtin_amdgcn_readfirstlane(t_ >> 6); F.G = g_; F.bid = b_; } \
                 bf16* XN = (bf16*)(ws + WS_XN); bf16* BIG = (bf16*)(ws + WS_BIG); bf16* WMA = (bf16*)(ws + WS_WMIX); bf16* WMO = (bf16*)(ws + WS_WMIX + 26 * MiB); (void)XN; (void)BIG; (void)WMA; (void)WMO;
#define PH_END   if (ph + 1 < C.hi) { XcdBarrier b2_ = C.bar; asm volatile("" : "+s"(b2_.bar)); xcd_barrier(b2_); } } ++ph;
#define XS0 ((bf16*)a.out)
#define XS1 ((bf16*)(ws + WS_BIG + 512 * MiB))

#ifndef GU_WGM
#define GU_WGM 8
#endif
#ifndef DN_WGM
#define DN_WGM 4
#endif
#ifndef I8_MIX_MASK
#define I8_MIX_MASK 0x2
#endif
#ifndef I8_GU_MASK
#define I8_GU_MASK 0xFF
#endif
#ifndef FP8_GU_MASK
#define FP8_GU_MASK 0x00
#endif
#ifndef FP8_DN_MASK
#define FP8_DN_MASK 0xC0
#endif
constexpr int RT_TAGS_OFF = RING_BYTES + 512, RT_TAB_OFF = RING_BYTES + 1024;
template <class Sched>
__device__ __forceinline__ pg8::RowTab build_row_tab(Frame& F, const Sched& S, const float* rowq, float wstep) {
    LAS int* tags = (LAS int*)(F.lds + RT_TAGS_OFF); LAS float* tab = (LAS float*)(F.lds + RT_TAB_OFF);
    if (F.tid == 0) { int n = 0;
        for (int k = 0; k < 8; ++k) tags[k] = -1;
        pg8::Unit u;
        for (int i = 0; S.next(i, u); ++i) { bool seen = false; for (int k = 0; k < n; ++k) seen = seen || (tags[k] == u.pm); if (!seen && n < 8) tags[n++] = u.pm; } }
    __syncthreads();
    for (int k = F.tid >> 8; k < 8; k += 2) { const int pm = tags[k]; if (pm >= 0) tab[k * 256 + (F.tid & 255)] = rowq[(size_t)pm * 256 + (F.tid & 255)] * wstep; }
    __syncthreads();
    return pg8::RowTab{tab, tags};
}
template <int L, int FI>
__device__ __forceinline__ void run_ffn(unsigned char* lds_raw, const Ctx& C, int& ph) {
    constexpr bool FIRST = (L == 0 && FI == 0), LAST = (L == DEPTH - 1 && FI == 1);
    constexpr bool F8 = ((FP8_DN_MASK >> (2 * L + FI)) & 1) != 0, I8G = ((I8_GU_MASK >> (2 * L + FI)) & 1) != 0, F8G = !I8G && ((FP8_GU_MASK >> (2 * L + FI)) & 1) != 0;
    constexpr int GDT = I8G ? 2 : (F8G ? 1 : 0);
    PH_BEGIN PH_REP(REP_NORM) { if (FIRST) norm_phase<0, false, GDT>(a, F, a.in[I_X], a.in[FI ? I_F2N : I_F1N] + (size_t)L * DM, 0);
                                else norm_phase<0, true, GDT>(a, F, LAST ? XS1 : XS0, a.in[FI ? I_F2N : I_F1N] + (size_t)L * DM, 0); } PH_END
    PH_BEGIN { bf16* WGU = (bf16*)(ws + (FI ? WS_WGU2 : WS_WGU1)); constexpr int KG = GDT ? DM / 2 : DM;
               pg8::Gemm g{XN, WGU, KG, KG, KG}; pg8::StaticOrder S; S.init(MTOK, 2 * FF, F.G, F.bid, GU_WGM);
               pg8::RowTab rt{nullptr, nullptr};
               if (I8G) rt = build_row_tab(F, S, (const float*)(ws + WS_ROWQ), 1.0f);
               pg8::EpiSwiGLU<F8, I8G> E{BIG, FF, F8G ? 1.0f / (pg8::X8_SCALE * pg8::W8_SCALE) : 1.0f, rt, (const float*)(ws + WS_CSTEP) + (2 * L + FI) * 2 * FF};
               PH_REP(REP_GU) { pg8::gemm_phase<pg8::EpiSwiGLU<F8, I8G>, pg8::StaticOrder, true, true, GDT>(F.lds, g, S, E, F.tid); } } PH_END
    PH_BEGIN { bf16* WDN = (bf16*)(ws + (FI ? WS_WDN2 : WS_WDN1));
               constexpr int KE = F8 ? FF / 2 : FF;
               constexpr float SC = F8 ? 0.5f / (pg8::H8_SCALE * pg8::W8_SCALE) : 0.5f;
               pg8::Gemm g{BIG, WDN, KE, KE, KE}; pg8::StaticOrder S; S.init(MTOK, DM, F.G, F.bid, DN_WGM);
               if (FIRST) { pg8::EpiResid<false, true> E{a.in[I_X], XS0, DM, SC}; pg8::gemm_phase<pg8::EpiResid<false, true>, pg8::StaticOrder, true, true, F8 ? 1 : 0>(F.lds, g, S, E, F.tid); }
               else if (LAST) { pg8::EpiResid<true, false> E{XS1, a.out, DM, SC}; pg8::gemm_phase<pg8::EpiResid<true, false>, pg8::StaticOrder, true, true, F8 ? 1 : 0>(F.lds, g, S, E, F.tid); }
               else { pg8::EpiResid<true, true> E{XS0, XS0, DM, SC}; pg8::gemm_phase<pg8::EpiResid<true, true>, pg8::StaticOrder, true, true, F8 ? 1 : 0>(F.lds, g, S, E, F.tid); } } PH_END
}
template <int L>
__device__ __forceinline__ void run_layer(unsigned char* lds_raw, const Ctx& C, int& ph) {
    constexpr int kind = L % 3, j = L / 3;
    constexpr bool I8A = ((I8_GU_MASK >> (2 * L)) & 1) != 0, I8B = ((I8_GU_MASK >> (2 * L + 1)) & 1) != 0, I8M = kind != 2 && ((I8_MIX_MASK >> L) & 1) != 0;
    if constexpr (I8A || I8B || I8M) {
        PH_BEGIN { if (I8A) colmax_wide(F, a.in[I_F1GU] + (size_t)L * DM * 2 * FF, DM, 2 * FF, (unsigned*)(ws + WS_CTL) + CW_CMAX + (2 * L) * 2 * FF);
                   if (I8B) colmax_wide(F, a.in[I_F2GU] + (size_t)L * DM * 2 * FF, DM, 2 * FF, (unsigned*)(ws + WS_CTL) + CW_CMAX + (2 * L + 1) * 2 * FF);
                   if (I8M && kind == 0) { colmax_wide(F, a.in[I_MLWIN] + (size_t)j * DM * ML_INCOLS, DM, 6144, (unsigned*)(ws + WS_CTL) + CW_CMAX2 + 6400 * L, ML_INCOLS);
                                          colmax_pass(F, a.in[I_MLWIN] + (size_t)j * DM * ML_INCOLS + 6144, DM, 16, ML_INCOLS, (unsigned*)(ws + WS_CTL) + CW_CMAX2 + 6400 * L + 6144); }
                   if (I8M && kind == 1) colmax_wide(F, a.in[I_ATQKV] + (size_t)j * DM * AT_COLS, DM, AT_COLS, (unsigned*)(ws + WS_CTL) + CW_CMAX2 + 6400 * L); } PH_END
    }
    PH_BEGIN PH_REP(REP_CONV) { conv_phase(a, F, L, ((FP8_DN_MASK >> (2 * L)) & 1) != 0, ((FP8_DN_MASK >> (2 * L + 1)) & 1) != 0, ((FP8_GU_MASK >> (2 * L)) & 1) != 0, ((FP8_GU_MASK >> (2 * L + 1)) & 1) != 0, I8A, I8B, I8M); } PH_END
    run_ffn<L, 0>(lds_raw, C, ph);
    if constexpr (kind == 0) {
        PH_BEGIN PH_REP(REP_NORM) { norm_phase<0, true, I8M ? 2 : 0>(a, F, XS0, a.in[I_MN] + (size_t)L * DM, j); } PH_END
        PH_BEGIN { constexpr int KM = I8M ? DM / 2 : DM; pg8::Gemm g{XN, WMA, KM, KM, KM}; pg8::StaticOrder S; S.init(MTOK, ML_NPAD, F.G, F.bid);
                   pg8::RowTab rt{nullptr, nullptr}; if (I8M) rt = build_row_tab(F, S, (const float*)(ws + WS_ROWQ), 1.0f);
                   pg8::EpiStore<I8M> E{BIG, 6144, 24, (float*)(ws + WS_GATES), rt, (const float*)(ws + WS_CSTEP2) + 6400 * L};
                   PH_REP(REP_MIXG) { pg8::gemm_phase<pg8::EpiStore<I8M>, pg8::StaticOrder, true, true, I8M ? 2 : 0>(F.lds, g, S, E, F.tid); } } PH_END
        PH_BEGIN PH_REP(REP_MLA) { mlstm_phase_ab(a, F, j); } PH_END
        PH_BEGIN PH_REP(REP_MLC) { mlstm_phase_c(a, F, j); } PH_END
    } else if constexpr (kind == 1) {
        PH_BEGIN PH_REP(REP_NORM) { norm_phase<1, true, I8M ? 2 : 0>(a, F, XS0, a.in[I_MN] + (size_t)L * DM, j); } PH_END
        PH_BEGIN { constexpr int KM = I8M ? DM / 2 : DM; pg8::Gemm g{XN, WMA, KM, KM, KM}; pg8::StaticOrder S; S.init(MTOK, AT_COLS, F.G, F.bid);
                   pg8::RowTab rt{nullptr, nullptr}; if (I8M) rt = build_row_tab(F, S, (const float*)(ws + WS_ROWQ), 1.0f);
                   pg8::EpiStore<I8M> E{BIG, AT_COLS, 1 << 30, nullptr, rt, (const float*)(ws + WS_CSTEP2) + 6400 * L};
                   PH_REP(REP_MIXG) { pg8::gemm_phase<pg8::EpiStore<I8M>, pg8::StaticOrder, true, true, I8M ? 2 : 0>(F.lds, g, S, E, F.tid); } } PH_END
        PH_BEGIN PH_REP(REP_ATTN) { attn_phase(a, F, j); } PH_END
    } else {
        PH_BEGIN PH_REP(REP_NORM) { norm_phase<2, true>(a, F, XS0, a.in[I_MN] + (size_t)L * DM, j); } PH_END
        PH_BEGIN { pg8::Gemm g{BIG, WMA, DM, DM, DM}; pg8::RwkvOrder1 S; S.b.init(MTOK, 27 * 256, F.G, F.bid);
                   pg8::EpiRwkv1 E{BIG + (size_t)384 * MiB, XN, MTOK};
                   PH_REP(REP_MIXG) { pg8::gemm_phase<pg8::EpiRwkv1, pg8::RwkvOrder1, true, true>(F.lds, g, S, E, F.tid); } } PH_END
        PH_BEGIN { pg8::Gemm g{XN, (bf16*)(ws + WS_WMIX + 28 * MiB), 256, 256, 256}; pg8::RwkvOrder2 S; S.b.init(MTOK, 24 * 256, F.G, F.bid);
                   pg8::EpiRwkv2 E{(float*)(ws + WS_BIG), (bf16*)(ws + WS_BIG + 256 * MiB), (bf16*)(ws + WS_BIG + 384 * MiB), a.in[I_RWW0] + (size_t)j * DM, a.in[I_RWA0] + (size_t)j * DM};
                   PH_REP(REP_MIXG) { pg8::gemm_phase<pg8::EpiRwkv2, pg8::RwkvOrder2, true, true>(F.lds, g, S, E, F.tid); } } PH_END
        PH_BEGIN PH_REP(REP_SCAN) { rwkv_scan_phase(a, F, j); } PH_END
    }
    PH_BEGIN { pg8::Gemm g{XN, kind == 2 ? (bf16*)(ws + WS_WMIX + 32 * MiB) : WMO, DM, DM, DM}; pg8::StaticOrder S; S.init(MTOK, DM, F.G, F.bid, DN_WGM);
               pg8::EpiResid<true, true> E{XS0, L == DEPTH - 1 ? XS1 : XS0, DM, 1.0f};
               pg8::gemm_phase<pg8::EpiResid<true, true>, pg8::StaticOrder, true, true>(F.lds, g, S, E, F.tid); } PH_END
    run_ffn<L, 1>(lds_raw, C, ph);
}
#undef PH_BEGIN
#undef PH_END

__global__ void __launch_bounds__(NTHREADS, 2) hybrid_fwd(Args a_unused) {
    extern __shared__ __attribute__((aligned(16))) unsigned char lds_raw[];
    volatile LAS unsigned* MISC = (volatile LAS unsigned*)((LAS unsigned char*)lds_raw + MISC_OFF);
    if (threadIdx.x < 32) MISC[threadIdx.x] = 0u;
    __syncthreads();
    Ctx C; C.bar = xcd_barrier_post((unsigned*)(kargs()->ws + WS_CTL) + CW_BAR, MISC + 8);
    C.lo = kargs()->ph_lo; C.hi = kargs()->ph_hi; int ph = 0;
    run_layer<0>(lds_raw, C, ph);
    run_layer<1>(lds_raw, C, ph);
    run_layer<2>(lds_raw, C, ph);
    run_layer<3>(lds_raw, C, ph);
}

extern "C" void kernel_launch(void* const* d_in, const int* in_sizes, int n_in, void* d_out, int out_size, void* d_ws, size_t ws_size, hipStream_t stream) {
    static int grid = 0;
    if (grid == 0) {
        if (n_in != N_IN || in_sizes[0] != MTOK * DM || out_size != MTOK * DM || ws_size < WS_END) {
            fprintf(stderr, "kernel_launch: unexpected shapes (n_in %d, in0 %d, out %d, ws %zu < %zu); nothing launched\n", n_in, n_in > 0 ? in_sizes[0] : -1, out_size, ws_size, (size_t)WS_END); grid = -1; return; }
        int dev = 0, cus = 0, per_cu = 0;
        if (hipGetDevice(&dev) != hipSuccess || hipDeviceGetAttribute(&cus, hipDeviceAttributeMultiprocessorCount, dev) != hipSuccess) { grid = -1; return; }
        if (hipFuncSetAttribute((const void*)hybrid_fwd, hipFuncAttributeMaxDynamicSharedMemorySize, LDS_BYTES) != hipSuccess) { fprintf(stderr, "kernel_launch: hipFuncSetAttribute failed\n"); grid = -1; return; }
        if (hipOccupancyMaxActiveBlocksPerMultiprocessor(&per_cu, (const void*)hybrid_fwd, NTHREADS, LDS_BYTES) != hipSuccess || per_cu < 1) { fprintf(stderr, "kernel_launch: occupancy query says %d blocks per CU\n", per_cu); }
        (void)hipGetLastError();
        grid = cus;
    }
    if (grid < 0) return;
    if (hipMemsetAsync((char*)d_ws + WS_CTL, 0, CTL_ZERO_BYTES, stream) != hipSuccess) return;
    Args a{};
    for (int i = 0; i < N_IN; ++i) a.in[i] = (const float*)d_in[i];
    a.out = (float*)d_out; a.ws = (unsigned char*)d_ws;
#if MK_PER_PHASE
    for (int p = 0; p < N_PHASES_MAX; ++p) { a.ph_lo = p; a.ph_hi = p + 1; hipLaunchKernelGGL(hybrid_fwd, dim3(grid), dim3(NTHREADS), LDS_BYTES, stream, a); }
#else
    a.ph_lo = 0; a.ph_hi = 1 << 30;
    hipLaunchKernelGGL(hybrid_fwd, dim3(grid), dim3(NTHREADS), LDS_BYTES, stream, a);
#endif
    const hipError_t le = hipPeekAtLastError();
    if (le != hipSuccess) fprintf(stderr, "kernel_launch: launch failed: %s\n", hipGetErrorName(le));
}
```
